# Optimizing an MI355X kernel written in HIP

```python
import math
import jax, jax.numpy as jnp
from jax import lax
import numpy as np

D_MODEL = 2048
BATCH = 4
SEQ = 4096
DEPTH = 1

N_META = 16
BLOCK = 128
N_HEADS = 8
HEAD_DIM = 128
ATTN_WIDTH = N_HEADS * HEAD_DIM
CONV_CH = D_MODEL // 2
CONV_K = 3
N_EXPERTS = 32
TOP_K = 4
D_FF = D_MODEL
SWIGLU_LIMIT = 7.0
SWIGLU_ALPHA = 1.702
RMS_EPS = 1e-5
SPLIT_SIZES = (CONV_CH, CONV_CH, CONV_CH, ATTN_WIDTH, ATTN_WIDTH, ATTN_WIDTH, D_MODEL, D_MODEL)
IN_WIDTH = sum(SPLIT_SIZES)
SPLIT_POINTS = tuple(int(s) for s in np.cumsum(SPLIT_SIZES)[:-1])

kernel_name = "hybrid_conv_stickbreak_moe_block"


def rmsnorm(x, g):
    xf = x.astype(jnp.float32)
    y = xf * lax.rsqrt(jnp.mean(xf * xf, axis=-1, keepdims=True) + RMS_EPS)
    return (y * g.astype(jnp.float32)).astype(x.dtype)


def causal_depthwise_conv(u, w):
    l = u.shape[1]
    up = jnp.pad(u, ((0, 0), (CONV_K - 1, 0), (0, 0)))
    y = up[:, 0:l] * w[0]
    for j in range(1, CONV_K):
        y = y + up[:, j:j + l] * w[j]
    return y


def stick_breaking_attention(q, k, v):
    b, l, h, dh = q.shape
    pad = BLOCK - N_META

    def prep(t):
        return jnp.pad(t, ((0, 0), (pad, 0), (0, 0), (0, 0))).transpose(0, 2, 1, 3)

    qp, kp, vp = prep(q), prep(k), prep(v)
    lp = l + pad
    n_blocks = lp // BLOCK
    key_pos = jnp.arange(lp)
    key_valid = key_pos >= pad
    scale = 1.0 / math.sqrt(dh)

    def one_block(i):
        q_blk = lax.dynamic_slice_in_dim(qp, i * BLOCK, BLOCK, axis=2)
        z = jnp.einsum('bhqd,bhkd->bhqk', q_blk, kp).astype(jnp.float32) * scale
        q_pos = i * BLOCK + jnp.arange(BLOCK)
        mask = (key_pos[None, :] < q_pos[:, None]) & key_valid[None, :]
        log_beta = jax.nn.log_sigmoid(z)
        log_rest = jnp.where(mask, jax.nn.log_sigmoid(-z), 0.0)
        later = lax.cumsum(log_rest, axis=3, reverse=True) - log_rest
        weights = jnp.where(mask, jnp.exp(log_beta + later), 0.0)
        return jnp.einsum('bhqk,bhkd->bhqd', weights.astype(vp.dtype), vp)

    o = lax.map(one_block, jnp.arange(n_blocks))
    o = o.transpose(1, 0, 3, 2, 4).reshape(b, lp, h, dh)
    return o[:, pad:]


def clamped_swiglu(gate, up):
    gate = jnp.minimum(gate, SWIGLU_LIMIT)
    up = jnp.clip(up, -SWIGLU_LIMIT, SWIGLU_LIMIT)
    return (up + 1.0) * (gate * jax.nn.sigmoid(SWIGLU_ALPHA * gate))


def moe(h, w_router, b_router, w_gate, b_gate, w_up, b_up, w_down, b_down):
    bsz, l, d = h.shape
    n = h.reshape(bsz * l, d)
    logits = (n @ w_router + b_router).astype(jnp.float32)
    top_v, top_i = lax.top_k(logits, TOP_K)
    top_w = jax.nn.softmax(top_v, axis=-1)
    combine = jnp.einsum('nk,nke->ne', top_w, jax.nn.one_hot(top_i, N_EXPERTS, dtype=jnp.float32))
    combine = combine.astype(n.dtype)
    out = jnp.zeros_like(n)
    for e in range(N_EXPERTS):
        act = clamped_swiglu(n @ w_gate[e] + b_gate[e], n @ w_up[e] + b_up[e])
        out = out + combine[:, e:e + 1] * (act @ w_down[e] + b_down[e])
    return out.reshape(bsz, l, d)


def setup_inputs(seed: int = 0) -> dict:
    key = jax.random.key(seed)
    ks = jax.random.split(key, 20)
    f32 = jnp.float32
    nrm = lambda k, shape, s: jax.random.normal(k, shape, f32) * s
    D, L = D_MODEL, DEPTH
    return {
        "x": nrm(ks[0], (BATCH, SEQ, D), 1.0),
        "meta_tokens": nrm(ks[1], (N_META, D), 1.0),
        "g_mix": 1.0 + nrm(ks[2], (L, D), 0.02),
        "w_in": nrm(ks[3], (L, D, IN_WIDTH), D ** -0.5),
        "conv_w": nrm(ks[4], (L, CONV_K, CONV_CH), CONV_K ** -0.5),
        "w_conv_out": nrm(ks[5], (L, CONV_CH, D), CONV_CH ** -0.5),
        "w_attn_out": nrm(ks[6], (L, ATTN_WIDTH, D), ATTN_WIDTH ** -0.5),
        "w_o": nrm(ks[7], (L, D, D), D ** -0.5),
        "g_ffn": 1.0 + nrm(ks[8], (L, D), 0.02),
        "w_router": nrm(ks[9], (L, D, N_EXPERTS), D ** -0.5),
        "b_router": nrm(ks[10], (L, N_EXPERTS), 0.01),
        "w_gate": nrm(ks[11], (L, N_EXPERTS, D, D_FF), D ** -0.5),
        "b_gate": nrm(ks[12], (L, N_EXPERTS, D_FF), 0.01),
        "w_up": nrm(ks[13], (L, N_EXPERTS, D, D_FF), D ** -0.5),
        "b_up": nrm(ks[14], (L, N_EXPERTS, D_FF), 0.01),
        "w_down": nrm(ks[15], (L, N_EXPERTS, D_FF, D), D_FF ** -0.5),
        "b_down": nrm(ks[16], (L, N_EXPERTS, D), 0.01),
        "g_final": 1.0 + nrm(ks[17], (D,), 0.02),
    }


def reference(x, meta_tokens, g_mix, w_in, conv_w, w_conv_out, w_attn_out, w_o,
              g_ffn, w_router, b_router, w_gate, b_gate, w_up, b_up, w_down, b_down, g_final):
    bsz = x.shape[0]
    meta = jnp.broadcast_to(meta_tokens[None].astype(x.dtype), (bsz, N_META, D_MODEL))
    h_res = jnp.concatenate([meta, x], axis=1)
    l = h_res.shape[1]
    for layer in range(DEPTH):
        h = rmsnorm(h_res, g_mix[layer])
        proj = h @ w_in[layer]
        u, b_post, c_pre, q, k, v, gate_c, gate_a = jnp.split(proj, SPLIT_POINTS, axis=-1)
        y_conv = (b_post * causal_depthwise_conv(c_pre * u, conv_w[layer])) @ w_conv_out[layer]
        o = stick_breaking_attention(
            q.reshape(bsz, l, N_HEADS, HEAD_DIM),
            k.reshape(bsz, l, N_HEADS, HEAD_DIM),
            v.reshape(bsz, l, N_HEADS, HEAD_DIM))
        y_attn = o.reshape(bsz, l, ATTN_WIDTH) @ w_attn_out[layer]
        merged = jax.nn.sigmoid(gate_c) * y_conv + jax.nn.sigmoid(gate_a) * y_attn
        h_res = h_res + merged @ w_o[layer]
        h_res = h_res + moe(rmsnorm(h_res, g_ffn[layer]), w_router[layer], b_router[layer],
                            w_gate[layer], b_gate[layer], w_up[layer], b_up[layer],
                            w_down[layer], b_down[layer])
    return rmsnorm(h_res, g_final)[:, N_META:]
```

```cpp
#include <hip/hip_runtime.h>
#include <cstdio>
#include <cstdint>

#define GAS __attribute__((address_space(1)))
#define GLD(T, p) (*(const GAS T*)(p))
__device__ __forceinline__ unsigned ror8(unsigned v) { return (unsigned)__builtin_amdgcn_mov_dpp((int)v, 0x128, 0xf, 0xf, true); }
#define LAS __attribute__((address_space(3)))
typedef unsigned short bf16;
typedef short bf16x8 __attribute__((ext_vector_type(8)));
typedef short s16x4 __attribute__((ext_vector_type(4)));
typedef float f32x4 __attribute__((ext_vector_type(4)));
typedef float f32x16 __attribute__((ext_vector_type(16)));
typedef unsigned u32x4 __attribute__((ext_vector_type(4)));
typedef unsigned u32x2 __attribute__((ext_vector_type(2)));

constexpr int D = 2048, BATCH = 4, SEQ = 4096, NMETA = 16, LTOT = SEQ + NMETA;
constexpr int MR = BATCH * SEQ;
constexpr int ROWS = BATCH * LTOT;
constexpr int NH = 8, HD = 128, AW = 1024, CC = 1024, NE = 32, TOPK = 4, DFF = 2048, INW = 10240;
constexpr int O_U = 0, O_B = 1024, O_C = 2048, O_Q = 3072, O_K = 4096, O_V = 5120, O_GC = 6144, O_GA = 8192;
constexpr float EPS = 1e-5f;
constexpr int SLOT_CAP = 16384;
constexpr int MAXT = MR * TOPK / 256 + NE;
constexpr int NPH = 9;

constexpr size_t MiB = 1u << 20;
constexpr size_t WS_CTL = 0, CTL_ZERO_BYTES = 1 * MiB;
constexpr size_t WS_WIN = 1 * MiB;
constexpr size_t WS_WCONV = WS_WIN + 40 * MiB;
constexpr size_t WS_WATTN = WS_WCONV + 4 * MiB;
constexpr size_t WS_WO = WS_WATTN + 4 * MiB;
constexpr size_t WS_WRF = WS_WO + 8 * MiB;
constexpr size_t WS_HM = WS_WRF + 1 * MiB;
constexpr size_t WS_WG = WS_HM + 1 * MiB;
constexpr size_t WS_WU = WS_WG + 256 * MiB;
constexpr size_t WS_WD = WS_WU + 256 * MiB;
constexpr size_t WS_HRES2 = WS_WD + 256 * MiB;
constexpr size_t WS_XB = WS_HRES2 + 64 * MiB;
constexpr size_t WS_HG = WS_HRES2 + 128 * MiB;
constexpr size_t WS_TOKOF = WS_HG + 64 * MiB;
constexpr size_t WS_RSTDOF = WS_TOKOF + 2 * MiB;
constexpr size_t WS_CWOF = WS_RSTDOF + 2 * MiB;
constexpr size_t WS_TOKSLOT = WS_CWOF + 2 * MiB;
constexpr size_t WS_Y = WS_TOKSLOT + 1 * MiB;
constexpr size_t WS_X = WS_Y + 288 * MiB;
constexpr size_t WS_HN = WS_X;
constexpr size_t WS_YCIN = WS_X, WS_O = WS_X + 32 * MiB;
constexpr size_t WS_CU = WS_X + 64 * MiB;
constexpr size_t WS_BP = WS_CU + 33 * MiB;
constexpr size_t WS_Q = WS_BP + 32 * MiB;
constexpr size_t WS_K = WS_Q + 32 * MiB;
constexpr size_t WS_V = WS_K + 33 * MiB;
constexpr size_t WS_GC = WS_V + 33 * MiB;
constexpr size_t WS_GA = WS_GC + 64 * MiB;
constexpr size_t WS_MERGED = WS_GA + 64 * MiB;
constexpr size_t WS_HN8 = WS_MERGED + 64 * MiB;
constexpr size_t WS_WIN8 = WS_HN8 + 32 * MiB;
constexpr size_t WS_X_END1 = WS_WIN8 + 8 * MiB;
constexpr size_t WS_ACT = WS_X;
constexpr size_t WS_X_END2 = WS_ACT + 288 * MiB;
constexpr size_t WS_END = WS_X_END1 > WS_X_END2 ? WS_X_END1 : WS_X_END2;
static_assert((size_t)MAXT * 256 * D * 2 <= 288 * MiB, "act/Y size");
constexpr int CW_BAR = 1024;
constexpr int CW_CNT = 8192;

constexpr int RING_BYTES = 131072;
constexpr int LDS_TBL = RING_BYTES;
constexpr int LDS_MISC = RING_BYTES + 1024;
constexpr int LDS_UNITS = RING_BYTES + 2048;
constexpr int LDS_CVRING = RING_BYTES + 4096;
constexpr int LDS_BYTES = 159744;

#define LDS_WAIT() asm volatile("s_waitcnt lgkmcnt(0)" ::: "memory")
#define VM_WAIT() asm volatile("s_waitcnt vmcnt(0)" ::: "memory")
__device__ __forceinline__ unsigned f2bf(float f) { unsigned u = __builtin_bit_cast(unsigned, f); return (u + 0x7fffu + ((u >> 16) & 1u)) >> 16; }

typedef float f32x2_t __attribute__((ext_vector_type(2)));
typedef __bf16 bf16x2_t __attribute__((ext_vector_type(2)));
__device__ __forceinline__ unsigned cvt_pk_bf16(float lo, float hi) { const f32x2_t v = {lo, hi}; return __builtin_bit_cast(unsigned, __builtin_convertvector(v, bf16x2_t)); }
__device__ __forceinline__ unsigned pk2(float lo, float hi) { return cvt_pk_bf16(lo, hi); }
__device__ __forceinline__ unsigned cvt4_fp8(float a, float b, float c, float d) { int p = __builtin_amdgcn_cvt_pk_fp8_f32(a, b, 0, false); p = __builtin_amdgcn_cvt_pk_fp8_f32(c, d, p, true); return (unsigned)p; }
__device__ __forceinline__ float bf_lo(unsigned w) { return __builtin_bit_cast(float, w << 16); }
__device__ __forceinline__ float bf_hi(unsigned w) { return __builtin_bit_cast(float, w & 0xffff0000u); }
__device__ __forceinline__ float wave_sum(float v) {
#pragma unroll
    for (int o = 1; o < 64; o <<= 1) v += __shfl_xor(v, o);
    return v;
}
__device__ __forceinline__ float fast_sigmoid(float x) { return __builtin_amdgcn_rcpf(1.f + __expf(-x)); }

#define XB_TMO      128
#define XB_XCNT(j)  (256  + 64 * (j))
#define XB_XSUB(j)  (1280 + 64 * (j))
#define XB_XGEN(j)  (2304 + 64 * (j))
#define XB_TOP      3328
#define XB_TOPGEN   3392
#define XCD_BAR_WORDS 3456
#define XB_SPIN_CAP (1u << 18)
__device__ __forceinline__ unsigned xb_ld(unsigned* p)              { return __hip_atomic_load(p, __ATOMIC_RELAXED, __HIP_MEMORY_SCOPE_AGENT); }
__device__ __forceinline__ unsigned xb_add(unsigned* p, unsigned v) { return __hip_atomic_fetch_add(p, v, __ATOMIC_RELAXED, __HIP_MEMORY_SCOPE_AGENT); }
__device__ __forceinline__ unsigned xb_xcc_id() { return (unsigned)__builtin_amdgcn_s_getreg((3 << 11) | 20) & 0xFu; }
#define XB_SPIN(cond, bar) do { unsigned _sp = 0; while (cond) { __builtin_amdgcn_s_sleep(1); \
    if ((++_sp & 255u) == 0u) { if (xb_ld(&(bar)[XB_TMO])) break; if (_sp > XB_SPIN_CAP) { atomicAdd(&(bar)[XB_TMO], 1u); break; } } } } while (0)
struct XcdBarrier { unsigned* bar; unsigned x; volatile LAS unsigned* st; };
__device__ __forceinline__ XcdBarrier xcd_barrier_post(unsigned* bar, volatile LAS unsigned* st) {
    XcdBarrier b; b.bar = bar; b.x = xb_xcc_id(); b.st = st;
    if (threadIdx.x == 0) (void)xb_add(&bar[XB_XCNT(b.x)], 1u);
    return b;
}
__device__ __forceinline__ void xcd_barrier_complete(unsigned* bar, unsigned x, unsigned& nloc, unsigned& nx) {
    const unsigned G = gridDim.x * gridDim.y * gridDim.z;
    unsigned sum, cnt, mine, sp = 0u;
    for (;;) {
        sum = 0u; cnt = 0u; mine = 0u;
#pragma unroll
        for (unsigned j = 0; j < 16; ++j) { const unsigned c = xb_ld(&bar[XB_XCNT(j)]); sum += c; cnt += (c > 0u) ? 1u : 0u; mine = (j == x) ? c : mine; }
        if (sum == G) break;
        __builtin_amdgcn_s_sleep(1);
        if ((++sp & 255u) == 0u) { if (xb_ld(&bar[XB_TMO])) break; if (sp > XB_SPIN_CAP) { atomicAdd(&bar[XB_TMO], 1u); break; } }
    }
    nloc = mine > 0u ? mine : 1u; nx = cnt > 0u ? cnt : 1u;
}
__device__ __forceinline__ void xcd_barrier(const XcdBarrier& b) {
    asm volatile("s_waitcnt vmcnt(0)" ::: "memory");
    __syncthreads();
    if (threadIdx.x == 0) {
        unsigned* bar = b.bar;
        __builtin_amdgcn_s_waitcnt(0);
        unsigned nloc = b.st[0], nx = b.st[1];
        if (nloc == 0u) { xcd_barrier_complete(bar, b.x, nloc, nx); b.st[0] = nloc; b.st[1] = nx; }
        const unsigned old = xb_add(&bar[XB_XSUB(b.x)], 1u);
        const unsigned gen = old / nloc;
        if (old + 1u == (gen + 1u) * nloc) {
            __builtin_amdgcn_fence(__ATOMIC_RELEASE, "agent");
            asm volatile("s_waitcnt vmcnt(0)" ::: "memory");
            const unsigned og = xb_add(&bar[XB_TOP], 1u);
            const unsigned tg = og / nx;
            if (og + 1u == (tg + 1u) * nx) xb_add(&bar[XB_TOPGEN], 1u);
            else XB_SPIN(xb_ld(&bar[XB_TOPGEN]) == tg, bar);
            __builtin_amdgcn_fence(__ATOMIC_ACQUIRE, "agent");
            xb_add(&bar[XB_XGEN(b.x)], 1u);
            asm volatile("s_waitcnt vmcnt(0)" ::: "memory");
        } else {
            XB_SPIN(xb_ld(&bar[XB_XGEN(b.x)]) == gen, bar);
            __builtin_amdgcn_fence(__ATOMIC_ACQUIRE, "agent");
            asm volatile("s_waitcnt vmcnt(0)" ::: "memory");
        }
    }
    __syncthreads();
}

namespace pg8 {
constexpr int BM = 256, BK = 64, HALF = 128, HTB = HALF * BK * 2, STAGE_BYTES = 8 * HTB, NXCD = 8, WGM = 4;
__host__ __device__ __forceinline__ int lds_byte(int r, int c) { const int st = (r >> 4) * 2 + (c >> 5), rr = r & 15, cc = c & 31, ob = rr * 64 + cc * 2; return st * 1024 + (ob ^ (((ob >> 9) & 1) << 5)); }
__host__ __device__ __forceinline__ void stage_rc(int b, int& R, int& C) { const int st = b / 1024, sb = b % 1024, swz = sb ^ (((sb >> 9) & 1) << 5); R = (st >> 1) * 16 + swz / 64; C = (st & 1) * 32 + (swz % 64) / 2; }
__host__ __device__ __forceinline__ int perm32(int rho) { const int n = rho >> 4, i = rho & 15; return 8 * (i >> 2) + 4 * n + (i & 3); }
__host__ __device__ __forceinline__ int perm32w(int rho) { const int n = rho >> 4, i = rho & 15; return 16 * ((i >> 2) & 1) + 8 * (i >> 3) + 4 * n + (i & 3); }
template <class E, class = void> struct epi_wide { static constexpr bool value = false; };
template <class E> struct epi_wide<E, decltype((void)E::WIDE)> { static constexpr bool value = E::WIDE; };
template <class E, class = void> struct epi_adj { static constexpr bool value = false; };
template <class E> struct epi_adj<E, decltype((void)E::ADJ)> { static constexpr bool value = E::ADJ; };
template <class E, class = void> struct epi_relax { static constexpr bool value = false; };
template <class E> struct epi_relax<E, decltype((void)E::RELAX)> { static constexpr bool value = E::RELAX; };

struct Unit {
    int pm, pn;
    int kind, e, nrow, aux;
    const char* A;
    const char* B0;
    const char* B1;
    char* dst; int ld;
};
__device__ __forceinline__ bool static_tile(int L, int nM, int nN, int& pm, int& pn, const int WGM = pg8::WGM) {
    const int nwg = nM * nN; if (L >= nwg) return false;
    int wgid = L; { const int q = nwg / NXCD, r = nwg % NXCD, xcd = wgid % NXCD, off = wgid / NXCD; wgid = (xcd < r ? xcd * (q + 1) : r * (q + 1) + (xcd - r) * q) + off; }
    const int nig = WGM * nN, gid = wgid / nig, fm = gid * WGM, gsz = (nM - fm) < WGM ? (nM - fm) : WGM;
    pm = fm + ((wgid % nig) % gsz); pn = (wgid % nig) / gsz; return true;
}

typedef int v8i32 __attribute__((ext_vector_type(8)));
typedef int v4i32 __attribute__((ext_vector_type(4)));
template <bool FP8> struct Frag;
template <> struct Frag<false> { bf16x8 k[2]; };
template <> struct Frag<true> { v8i32 v; };
__device__ __forceinline__ void load_frag(Frag<false>& f, const LAS unsigned char* p) { f.k[0] = *(const LAS bf16x8*)p; f.k[1] = *(const LAS bf16x8*)(p + 1024); }
__device__ __forceinline__ void load_frag(Frag<true>& f, const LAS unsigned char* p) { const v4i32 lo = *(const LAS v4i32*)p, hi = *(const LAS v4i32*)(p + 1024); f.v = __builtin_shufflevector(lo, hi, 0, 1, 2, 3, 4, 5, 6, 7); }
__device__ __forceinline__ void mma_frag(f32x4& c, const Frag<false>& b, const Frag<false>& a) {
    c = __builtin_amdgcn_mfma_f32_16x16x32_bf16(b.k[0], a.k[0], c, 0, 0, 0); c = __builtin_amdgcn_mfma_f32_16x16x32_bf16(b.k[1], a.k[1], c, 0, 0, 0); }
__device__ __forceinline__ void mma_block(f32x4 (&c)[4][2], const Frag<false> (&a)[4], const Frag<false> (&b)[2]) {
#pragma unroll
    for (int m = 0; m < 4; ++m)
#pragma unroll
        for (int n = 0; n < 2; ++n) { c[m][n] = __builtin_amdgcn_mfma_f32_16x16x32_bf16(b[n].k[0], a[m].k[0], c[m][n], 0, 0, 0); c[m][n] = __builtin_amdgcn_mfma_f32_16x16x32_bf16(b[n].k[1], a[m].k[1], c[m][n], 0, 0, 0); }
}
__device__ __forceinline__ void mma_block(f32x4 (&c)[4][2], const Frag<true> (&a)[4], const Frag<true> (&b)[2]) {
#if defined(__HIP_DEVICE_COMPILE__)
    const int sc = 0x7c7c7c7c;
    asm volatile("s_nop 1\n\t"
                 "v_mfma_scale_f32_16x16x128_f8f6f4 %0, %12, %8, %0, %14, %14 op_sel_hi:[0,0,0]\n\t"
                 "v_mfma_scale_f32_16x16x128_f8f6f4 %1, %13, %8, %1, %14, %14 op_sel_hi:[0,0,0]\n\t"
                 "v_mfma_scale_f32_16x16x128_f8f6f4 %2, %12, %9, %2, %14, %14 op_sel_hi:[0,0,0]\n\t"
                 "v_mfma_scale_f32_16x16x128_f8f6f4 %3, %13, %9, %3, %14, %14 op_sel_hi:[0,0,0]\n\t"
                 "v_mfma_scale_f32_16x16x128_f8f6f4 %4, %12, %10, %4, %14, %14 op_sel_hi:[0,0,0]\n\t"
                 "v_mfma_scale_f32_16x16x128_f8f6f4 %5, %13, %10, %5, %14, %14 op_sel_hi:[0,0,0]\n\t"
                 "v_mfma_scale_f32_16x16x128_f8f6f4 %6, %12, %11, %6, %14, %14 op_sel_hi:[0,0,0]\n\t"
                 "v_mfma_scale_f32_16x16x128_f8f6f4 %7, %13, %11, %7, %14, %14 op_sel_hi:[0,0,0]"
                 : "+v"(c[0][0]), "+v"(c[0][1]), "+v"(c[1][0]), "+v"(c[1][1]), "+v"(c[2][0]), "+v"(c[2][1]), "+v"(c[3][0]), "+v"(c[3][1])
                 : "v"(a[0].v), "v"(a[1].v), "v"(a[2].v), "v"(a[3].v), "v"(b[0].v), "v"(b[1].v), "v"(sc));
#endif
}
__device__ __forceinline__ void mma_frag(f32x4& c, const Frag<true>& b, const Frag<true>& a) {
    c = __builtin_amdgcn_mfma_scale_f32_16x16x128_f8f6f4(b.v, a.v, c, 0, 0, 0, 0x79797979, 0, 0x7f7f7f7f); }
struct NoConv { static constexpr int MODE = 0; __device__ __forceinline__ void prime() {} __device__ __forceinline__ void issue() {} __device__ __forceinline__ void reads() {} __device__ __forceinline__ void pack() {} template <int J> __device__ __forceinline__ void store() {} __device__ __forceinline__ void drain() {} };
template <class Epi, class Sched, bool ALIGN_EPI, bool SP2, bool FP8 = false, class Conv = NoConv>
__device__ __forceinline__ void gemm_phase(LAS unsigned char* lds, const int K, const Sched& S, const Epi& E, Conv cv = Conv()) {
    const int tid = threadIdx.x, wid = __builtin_amdgcn_readfirstlane(tid >> 6), lane = tid & 63, wr = wid >> 2, wc = wid & 3, fr = lane & 15, fq = lane >> 4;
    const int nt = FP8 ? K / 128 : K / BK;
    int Rr[2], Cc[2]; unsigned voffB[2];
#pragma unroll
    for (int i = 0; i < 2; ++i) { stage_rc(tid * 16 + i * 8192, Rr[i], Cc[i]); const int Rb = Epi::PERM ? ((epi_adj<Epi>::value ? (Rr[i] >> 5) * 64 : (Rr[i] & ~31)) + (epi_wide<Epi>::value ? perm32w(Rr[i] & 31) : perm32(Rr[i] & 31))) : Rr[i]; voffB[i] = FP8 ? (unsigned)(Rb * K) + (unsigned)Cc[i] * 2u : (unsigned)(Rb * K + Cc[i]) * 2u; }
    const size_t kstep = (size_t)(BK * 2);
    const unsigned ldsw = (unsigned)wid * 1024u;
    const int aoff = lds_byte(wr * 64 + fr, fq * 8), boff = lds_byte(wc * 32 + fr, fq * 8);
#define PG8_SA(b, h) (((b) * 2 + (h)) * HTB)
#define PG8_SB(b, h) ((4 + (b) * 2 + (h)) * HTB)
#define PG8_STAGE(bufoff, gbase, voff) do { _Pragma("unroll") for (int _i = 0; _i < 2; ++_i) \
        __builtin_amdgcn_global_load_lds((const unsigned*)((const char*)(gbase) + (voff)[_i]), (LAS unsigned*)(lds + (bufoff) + ldsw + _i * 8192), 16, 0, 0); } while (0)
#define PG8_LDA(dst, b, h) do { _Pragma("unroll") for (int m = 0; m < 4; ++m) load_frag(dst[m], lds + PG8_SA(b, h) + aoff + m * 2048); } while (0)
#define PG8_LDB(dst, b, h) do { _Pragma("unroll") for (int n = 0; n < 2; ++n) load_frag(dst[n], lds + PG8_SB(b, h) + boff + n * 2048); } while (0)
#define PG8_MMA(ai, bj, At, Bt) do { __builtin_amdgcn_s_setprio(1); mma_block(acc[ai][bj], At, Bt); __builtin_amdgcn_s_setprio(0); } while (0)
#define PG8_WAIT_V(n) asm volatile("s_waitcnt vmcnt(" #n ")" ::: "memory")
#define PG8_WAIT_L(n) asm volatile("s_waitcnt lgkmcnt(" #n ")" ::: "memory")
#define PG8_WAIT_K() do { if constexpr (Conv::MODE == 0) PG8_WAIT_V(8); else if constexpr (Conv::MODE == 1) PG8_WAIT_V(9); else PG8_WAIT_V(10); } while (0)
#define PG8_BAR __builtin_amdgcn_s_barrier()
#define PG8_SCHED __builtin_amdgcn_sched_barrier(0)
    constexpr bool GATHER = Sched::AROW_LOADS;
    constexpr bool RELAX = SP2 && Conv::MODE == 0 && epi_relax<Epi>::value;
#define PG8_AOFFS(dst, u) do { if constexpr (GATHER) { _Pragma("unroll") for (int _h = 0; _h < 2; ++_h) _Pragma("unroll") for (int _i = 0; _i < 2; ++_i) dst[_h][_i] = S.arow(u, _h * HALF + Rr[_i]) + (unsigned)Cc[_i] * 2u; \
        asm volatile("" : "+v"(dst[0][0]), "+v"(dst[0][1]), "+v"(dst[1][0]), "+v"(dst[1][1])); } } while (0)
#define PG8_STAGE_A(bufoff, gbase, h, offs) do { if constexpr (GATHER) { PG8_STAGE(bufoff, gbase, (offs)[h]); } else { PG8_STAGE(bufoff, (gbase) + (h) * hstepA, voffA); } } while (0)
    int ui = 0;
    Unit cur;
    if (!S.next(0, cur)) return;
    f32x4 acc[2][2][4][2];
#pragma unroll
    for (int a = 0; a < 2; ++a)
#pragma unroll
        for (int b = 0; b < 2; ++b)
#pragma unroll
            for (int m = 0; m < 4; ++m)
#pragma unroll
                for (int n = 0; n < 2; ++n) acc[a][b][m][n] = (f32x4){0.f, 0.f, 0.f, 0.f};
    Frag<FP8> At[4], B0[2], B1[2];
    unsigned oA[2][2], oAn[2][2], voffA[2];
    const size_t hstepA = GATHER ? 0 : (size_t)S.hstepA();
#pragma unroll
    for (int i = 0; i < 2; ++i) { voffA[i] = GATHER ? 0u : S.arow(cur, Rr[i]) + (unsigned)Cc[i] * 2u; oA[0][i] = oA[1][i] = oAn[0][i] = oAn[1][i] = 0u; }
    PG8_AOFFS(oA, cur);
    const char* cA = cur.A; const char* cB0 = cur.B0; const char* cB1 = cur.B1;
    cv.prime();
    if constexpr (SP2) {
        PG8_STAGE(PG8_SB(0, 0), cB0, voffB); PG8_STAGE(PG8_SB(0, 1), cB1, voffB); PG8_STAGE_A(PG8_SA(0, 0), cA, 0, oA); PG8_STAGE_A(PG8_SA(0, 1), cA, 1, oA);
        if (wr == 1) PG8_BAR;
        PG8_WAIT_V(2); PG8_BAR;
        PG8_STAGE(PG8_SB(1, 0), cB0 + kstep, voffB); PG8_STAGE_A(PG8_SA(1, 0), cA + kstep, 0, oA); PG8_STAGE(PG8_SB(1, 1), cB1 + kstep, voffB);
        PG8_WAIT_V(6); PG8_BAR;
    } else {
        PG8_STAGE(PG8_SB(0, 0), cB0, voffB); PG8_STAGE_A(PG8_SA(0, 0), cA, 0, oA); PG8_STAGE(PG8_SB(0, 1), cB1, voffB); PG8_STAGE_A(PG8_SA(0, 1), cA, 1, oA);
        if (wr == 1) PG8_BAR;
        PG8_WAIT_V(4); PG8_BAR;
        PG8_STAGE(PG8_SB(1, 0), cB0 + kstep, voffB); PG8_STAGE_A(PG8_SA(1, 0), cA + kstep, 0, oA); PG8_STAGE(PG8_SB(1, 1), cB1 + kstep, voffB);
        PG8_WAIT_V(6); PG8_BAR;
    }
    for (;;) {
        bool has_next = false; const char* nA = cA; const char* nB0 = cB0; const char* nB1 = cB1;
#define PG8_NEXT_UNIT() do { if (t == 0) { Unit nxt; has_next = S.next(ui + 1, nxt); if (has_next) { nA = nxt.A; nB0 = nxt.B0; nB1 = nxt.B1; PG8_AOFFS(oAn, nxt); } else { \
            _Pragma("unroll") for (int _h = 0; _h < 2; ++_h) _Pragma("unroll") for (int _i = 0; _i < 2; ++_i) oAn[_h][_i] = oA[_h][_i]; } } } while (0)
        { const int t = 0; PG8_NEXT_UNIT(); }
        for (int t = 0; t < nt; t += 2) {
            const bool last = (t == nt - 2);
            const char* a1 = cA + (size_t)(t + 1) * kstep;
            const char* a2 = last ? nA : cA + (size_t)(t + 2) * kstep;
            const char* b20 = last ? nB0 : cB0 + (size_t)(t + 2) * kstep; const char* b21 = last ? nB1 : cB1 + (size_t)(t + 2) * kstep;
            const char* a3 = a2 + kstep; const char* b30 = b20 + kstep; const char* b31 = b21 + kstep;
            unsigned s2[2][2];
#pragma unroll
            for (int h = 0; h < 2; ++h)
#pragma unroll
                for (int i = 0; i < 2; ++i) s2[h][i] = last ? oAn[h][i] : oA[h][i];
            if constexpr (SP2) {
            const bool relaxed = RELAX && ui > 0 && t == 0;
            cv.issue(); PG8_LDB(B0, 0, 0); PG8_LDB(B1, 0, 1); PG8_SCHED; PG8_LDA(At, 0, 0); if (!relaxed) PG8_STAGE_A(PG8_SA(1, 1), a1, 1, oA); cv.reads();
            if (!relaxed) PG8_WAIT_K(); PG8_WAIT_L(0); PG8_BAR; PG8_MMA(0, 0, At, B0); PG8_MMA(0, 1, At, B1); cv.template store<0>(); PG8_BAR; PG8_SCHED;
            cv.issue(); PG8_LDA(At, 0, 1); PG8_STAGE(PG8_SB(0, 0), b20, voffB); PG8_STAGE(PG8_SB(0, 1), b21, voffB); PG8_STAGE_A(PG8_SA(0, 0), a2, 0, s2); cv.reads();
            if (!relaxed) PG8_WAIT_K(); PG8_WAIT_L(0); PG8_BAR; PG8_MMA(1, 0, At, B0); PG8_MMA(1, 1, At, B1); cv.template store<1>(); PG8_BAR; PG8_SCHED;
            cv.issue(); PG8_LDB(B0, 1, 0); PG8_LDB(B1, 1, 1); PG8_SCHED; PG8_LDA(At, 1, 0); PG8_STAGE_A(PG8_SA(0, 1), a2, 1, s2); cv.reads();
            if (!relaxed) PG8_WAIT_K(); PG8_WAIT_L(0); PG8_BAR; PG8_MMA(0, 0, At, B0); PG8_MMA(0, 1, At, B1); cv.template store<2>(); PG8_BAR; PG8_SCHED;
            cv.issue(); PG8_LDA(At, 1, 1); PG8_STAGE(PG8_SB(1, 0), b30, voffB); PG8_STAGE(PG8_SB(1, 1), b31, voffB); PG8_STAGE_A(PG8_SA(1, 0), a3, 0, s2); cv.reads();
            PG8_WAIT_K(); PG8_WAIT_L(0); PG8_BAR; PG8_MMA(1, 0, At, B0); PG8_MMA(1, 1, At, B1); cv.template store<3>(); PG8_BAR; PG8_SCHED;
            } else {
            PG8_LDB(B0, 0, 0); PG8_SCHED; PG8_LDA(At, 0, 0); PG8_STAGE_A(PG8_SA(1, 1), a1, 1, oA);
            PG8_WAIT_L(8); PG8_BAR; PG8_WAIT_L(0); PG8_MMA(0, 0, At, B0); PG8_BAR; PG8_SCHED;
            PG8_LDB(B1, 0, 1); PG8_STAGE(PG8_SB(0, 0), b20, voffB);
            PG8_BAR; PG8_WAIT_L(0); PG8_MMA(0, 1, At, B1); PG8_BAR;
            PG8_LDA(At, 0, 1); PG8_STAGE_A(PG8_SA(0, 0), a2, 0, s2);
            PG8_BAR; PG8_WAIT_L(0); PG8_MMA(1, 0, At, B0); PG8_BAR; PG8_SCHED;
            PG8_STAGE(PG8_SB(0, 1), b21, voffB);
            PG8_WAIT_V(6); PG8_BAR; PG8_MMA(1, 1, At, B1); PG8_BAR;
            PG8_LDB(B0, 1, 0); PG8_SCHED; PG8_LDA(At, 1, 0); PG8_STAGE_A(PG8_SA(0, 1), a2, 1, s2);
            PG8_WAIT_L(8); PG8_BAR; PG8_WAIT_L(0); PG8_MMA(0, 0, At, B0); PG8_BAR; PG8_SCHED;
            PG8_LDB(B1, 1, 1); PG8_STAGE(PG8_SB(1, 0), b30, voffB);
            PG8_BAR; PG8_WAIT_L(0); PG8_MMA(0, 1, At, B1); PG8_BAR;
            PG8_LDA(At, 1, 1); PG8_STAGE_A(PG8_SA(1, 0), a3, 0, s2);
            PG8_BAR; PG8_WAIT_L(0); PG8_MMA(1, 0, At, B0); PG8_BAR; PG8_SCHED;
            PG8_STAGE(PG8_SB(1, 1), b31, voffB);
            PG8_WAIT_V(6); PG8_BAR; PG8_MMA(1, 1, At, B1); PG8_BAR;
            }
        }
        if constexpr (RELAX) { if (has_next) PG8_STAGE_A(PG8_SA(1, 1), nA + kstep, 1, oAn); }
        if constexpr (ALIGN_EPI) { if (wr == 0) PG8_BAR; }
        if constexpr (FP8) asm volatile("s_nop 15\n\ts_nop 7" ::: "memory");
        bool chained = false;
        { Unit eu; (void)S.next(ui, eu);
          if constexpr (Epi::CHAIN) { if (eu.kind == 0) { E.mid(acc, eu, wr, wc, fr, fq); chained = true; } else E(acc, eu, wr, wc, fr, fq); }
          else E(acc, eu, wr, wc, fr, fq); }
        if (!has_next) break;
        if (!chained) {
#pragma unroll
        for (int a = 0; a < 2; ++a)
#pragma unroll
            for (int b = 0; b < 2; ++b)
#pragma unroll
                for (int m = 0; m < 4; ++m)
#pragma unroll
                    for (int n = 0; n < 2; ++n) acc[a][b][m][n] = (f32x4){0.f, 0.f, 0.f, 0.f};
        }
        cA = nA; cB0 = nB0; cB1 = nB1; ++ui;
#pragma unroll
        for (int h = 0; h < 2; ++h)
#pragma unroll
            for (int i = 0; i < 2; ++i) oA[h][i] = oAn[h][i];
        if constexpr (ALIGN_EPI) { if (wr == 1) PG8_BAR; }
    }
    PG8_WAIT_V(0);
    if constexpr (!ALIGN_EPI) { if (wr == 0) PG8_BAR; }
    PG8_BAR;
    cv.drain();
#undef PG8_SA
#undef PG8_SB
#undef PG8_STAGE
#undef PG8_LDA
#undef PG8_LDB
#undef PG8_MMA
#undef PG8_WAIT_V
#undef PG8_WAIT_L
#undef PG8_WAIT_K
#undef PG8_BAR
#undef PG8_SCHED
#undef PG8_AOFFS
#undef PG8_NEXT_UNIT
#undef PG8_STAGE_A
}
}
using pg8::Unit;

struct Args { const float* in[18]; float* out; unsigned char* ws; int ph_lo, ph_hi; };
struct Frame {
    LAS unsigned char* lds;
    int tid, lane, wave, vcu, G;
    const float *x, *meta, *g_mix, *w_in, *conv_w, *w_conv_out, *w_attn_out, *w_o, *g_ffn, *w_router, *b_router, *w_gate, *b_gate, *w_up, *b_up, *w_down, *b_down, *g_final;
    float* out; unsigned char* ws; unsigned* ctl;
};
#define WSP(T, off) ((T*)(F.ws + (off)))

__device__ __forceinline__ void p0_item_load(const float* W, int N, int item, int lane, f32x4 (&v)[8], int ldn = 0) {
    const int nblk = N / 32, kb = item / nblk, nb = item % nblk, k0 = 64 * kb, n0 = 32 * nb; const int ld = ldn ? ldn : N;
#pragma unroll
    for (int i = 0; i < 8; ++i) { const int p = 64 * i + lane; v[i] = *(const GAS f32x4*)(W + (size_t)(k0 + (p >> 3)) * ld + n0 + 4 * (p & 7)); }
}
__device__ __forceinline__ void p0_item_finish(const f32x4 (&v)[8], int K, int N, bf16* WT, LAS float* scr, int item, int lane) {
    const int nblk = N / 32, kb = item / nblk, nb = item % nblk, k0 = 64 * kb, n0 = 32 * nb;
#pragma unroll
    for (int i = 0; i < 8; ++i) { const int p = 64 * i + lane; LAS float* d = scr + (p >> 3) * 33 + 4 * (p & 7); d[0] = v[i][0]; d[1] = v[i][1]; d[2] = v[i][2]; d[3] = v[i][3]; }
    LDS_WAIT(); asm volatile("" ::: "memory");
    const int c = lane & 7;
#pragma unroll
    for (int j = 0; j < 4; ++j) { const int n = (lane >> 3) + 8 * j; const LAS float* s = scr + (8 * c) * 33 + n;
        u32x4 o; o.x = pk2(s[0 * 33], s[1 * 33]); o.y = pk2(s[2 * 33], s[3 * 33]); o.z = pk2(s[4 * 33], s[5 * 33]); o.w = pk2(s[6 * 33], s[7 * 33]);
        *(GAS u32x4*)(WT + (size_t)(n0 + n) * K + k0 + 8 * c) = o; }
    LDS_WAIT(); asm volatile("" ::: "memory");
}
__device__ __forceinline__ void p0_item_finish_fp8(const f32x4 (&v)[8], int K, int N, unsigned char* WT8, LAS float* scr, int item, int lane) {
    const int nblk = N / 32, kb = item / nblk, nb = item % nblk, k0 = 64 * kb, n0 = 32 * nb;
#pragma unroll
    for (int i = 0; i < 8; ++i) { const int p = 64 * i + lane; LAS float* d = scr + (p >> 3) * 33 + 4 * (p & 7); d[0] = v[i][0]; d[1] = v[i][1]; d[2] = v[i][2]; d[3] = v[i][3]; }
    LDS_WAIT(); asm volatile("" ::: "memory");
    const int c = lane & 3;
#pragma unroll
    for (int j = 0; j < 2; ++j) { const int n = (lane >> 2) + 16 * j; const LAS float* s = scr + (16 * c) * 33 + n;
        u32x4 o;
        o.x = cvt4_fp8(64.f * s[0 * 33], 64.f * s[1 * 33], 64.f * s[2 * 33], 64.f * s[3 * 33]);   o.y = cvt4_fp8(64.f * s[4 * 33], 64.f * s[5 * 33], 64.f * s[6 * 33], 64.f * s[7 * 33]);
        o.z = cvt4_fp8(64.f * s[8 * 33], 64.f * s[9 * 33], 64.f * s[10 * 33], 64.f * s[11 * 33]); o.w = cvt4_fp8(64.f * s[12 * 33], 64.f * s[13 * 33], 64.f * s[14 * 33], 64.f * s[15 * 33]);
        *(GAS u32x4*)(WT8 + (size_t)(n0 + n) * K + k0 + 16 * c) = o; }
    LDS_WAIT(); asm volatile("" ::: "memory");
}
__device__ __forceinline__ void p0_transpose_item(const float* W, int K, int N, bf16* WT, int row_off, LAS float* scr, int item, int lane) {
    f32x4 v[8]; p0_item_load(W, N, item, lane, v); p0_item_finish(v, K, N, WT + (size_t)row_off * K, scr, item, lane);
}
template <bool FP8>
__device__ __forceinline__ void p0_transpose_stream(const float* W, bf16* WT, int K, int N, int nmat, int gw, int NGW, LAS float* scr, int lane, int ldn = 0) {
    const int ipm = (K / 64) * (N / 32), total = nmat * ipm; const size_t msz = (size_t)K * N;
    for (int it = gw; it < total; it += 3 * NGW) {
        const int i1 = it + NGW, i2 = it + 2 * NGW;
        f32x4 va[8], vb[8], vc[8];
        p0_item_load(W + (size_t)(it / ipm) * msz, N, it % ipm, lane, va, ldn);
        if (i1 < total) p0_item_load(W + (size_t)(i1 / ipm) * msz, N, i1 % ipm, lane, vb, ldn);
        if (i2 < total) p0_item_load(W + (size_t)(i2 / ipm) * msz, N, i2 % ipm, lane, vc, ldn);
        if constexpr (FP8) p0_item_finish_fp8(va, K, N, (unsigned char*)WT + (size_t)(it / ipm) * msz, scr, it % ipm, lane); else p0_item_finish(va, K, N, WT + (size_t)(it / ipm) * msz, scr, it % ipm, lane);
        if (i1 < total) { if constexpr (FP8) p0_item_finish_fp8(vb, K, N, (unsigned char*)WT + (size_t)(i1 / ipm) * msz, scr, i1 % ipm, lane); else p0_item_finish(vb, K, N, WT + (size_t)(i1 / ipm) * msz, scr, i1 % ipm, lane); }
        if (i2 < total) { if constexpr (FP8) p0_item_finish_fp8(vc, K, N, (unsigned char*)WT + (size_t)(i2 / ipm) * msz, scr, i2 % ipm, lane); else p0_item_finish(vc, K, N, WT + (size_t)(i2 / ipm) * msz, scr, i2 % ipm, lane); }
    }
}
__device__ __forceinline__ void rms_row_to_bf16(const float* xrow, const float* g, bf16* orow, int lane, unsigned char* orow8 = nullptr, bf16* xbrow = nullptr) {
    const GAS f32x4* xr = (const GAS f32x4*)xrow + lane; const GAS f32x4* gr = (const GAS f32x4*)g + lane;
    f32x4 v[8]; float s = 0.f;
#pragma unroll
    for (int j = 0; j < 8; ++j) { v[j] = xr[64 * j]; s += (v[j].x * v[j].x + v[j].y * v[j].y) + (v[j].z * v[j].z + v[j].w * v[j].w); }
    if (xbrow) { GAS u32x2* xb8 = (GAS u32x2*)xbrow + lane;
#pragma unroll
        for (int j = 0; j < 8; ++j) { u32x2 w; w.x = pk2(v[j].x, v[j].y); w.y = pk2(v[j].z, v[j].w); xb8[64 * j] = w; } }
    const float rstd = rsqrtf(wave_sum(s) * (1.f / D) + EPS);
    GAS u32x2* o8 = (GAS u32x2*)orow + lane;
#pragma unroll
    for (int j = 0; j < 8; ++j) { const f32x4 gg = gr[64 * j]; const f32x4 y = {v[j].x * rstd * gg.x, v[j].y * rstd * gg.y, v[j].z * rstd * gg.z, v[j].w * rstd * gg.w};
        u32x2 w; w.x = pk2(y.x, y.y); w.y = pk2(y.z, y.w); o8[64 * j] = w;
        if (orow8) ((GAS unsigned*)orow8)[lane + 64 * j] = cvt4_fp8(y.x, y.y, y.z, y.w); }
}
__device__ __forceinline__ void p0_prologue(Frame& F, bool ride) {
    LAS float* scr = (LAS float*)(F.lds + F.wave * 16384);
    const int gw = F.vcu * 8 + F.wave, NGW = F.G * 8;
    if (!ride) {
    p0_transpose_stream<true>(F.w_gate, WSP(bf16, WS_WG), D, DFF, NE, gw, NGW, scr, F.lane);
    p0_transpose_stream<true>(F.w_up, WSP(bf16, WS_WU), D, DFF, NE, gw, NGW, scr, F.lane);
    p0_transpose_stream<true>(F.w_down, WSP(bf16, WS_WD), DFF, D, NE, gw, NGW, scr, F.lane);
    }
    p0_transpose_stream<false>(F.w_in, WSP(bf16, WS_WIN), D, O_GC, 1, gw, NGW, scr, F.lane, INW);
    p0_transpose_stream<true>(F.w_in + O_GC, WSP(bf16, WS_WIN8), D, INW - O_GC, 1, gw, NGW, scr, F.lane, INW);
    p0_transpose_stream<false>(F.w_conv_out, WSP(bf16, WS_WCONV), CC, D, 1, gw, NGW, scr, F.lane);
    p0_transpose_stream<false>(F.w_attn_out, WSP(bf16, WS_WATTN), AW, D, 1, gw, NGW, scr, F.lane);
    p0_transpose_stream<false>(F.w_o, WSP(bf16, WS_WO), D, D, 1, gw, NGW, scr, F.lane);
#ifdef PROBE_STREAM
    {
        f32x4 acc4 = {0.f, 0.f, 0.f, 0.f};
        const size_t n4 = (size_t)NE * D * DFF / 4;
        for (int w3 = 0; w3 < 3; ++w3) { const GAS f32x4* p = (const GAS f32x4*)(w3 == 0 ? F.w_gate : w3 == 1 ? F.w_up : F.w_down);
            for (size_t i = (size_t)gw * 64 + F.lane; i < n4; i += (size_t)NGW * 64 * 32) {
#pragma unroll
                for (int u = 0; u < 32; ++u) { const size_t j = i + (size_t)u * NGW * 64; if (j < n4) acc4 += p[j]; } } }
        if (acc4[0] + acc4[1] + acc4[2] + acc4[3] == 123456.789f) WSP(float, WS_HM)[1024 * 1024 / 4 - 1] = 1.f;
    }
#endif
    for (int m = gw; m < MR; m += NGW) rms_row_to_bf16(F.x + (size_t)m * D, F.g_mix, WSP(bf16, WS_HN) + (size_t)m * D, F.lane, WSP(unsigned char, WS_HN8) + (size_t)m * D, WSP(bf16, WS_XB) + (size_t)m * D);
    if (gw < NMETA) rms_row_to_bf16(F.meta + (size_t)gw * D, F.g_mix, WSP(bf16, WS_HM) + (size_t)gw * D, F.lane);
    for (int c = blockIdx.x * 512 + F.tid; c < 64 * 2 * 64; c += F.G * 512) {
        const int ln = c & 63, eb = (c >> 6) & 1, ks = c >> 7; const float* w = F.w_router + (size_t)(32 * ks + 8 * (ln >> 4)) * NE + 16 * eb + (ln & 15);
        u32x4 o; o.x = pk2(w[0], w[NE]); o.y = pk2(w[2 * NE], w[3 * NE]); o.z = pk2(w[4 * NE], w[5 * NE]); o.w = pk2(w[6 * NE], w[7 * NE]);
        *(WSP(u32x4, WS_WRF) + c) = o;
    }
}

template <class S> __device__ __forceinline__ void build_units(const S& sch, LAS int* ut) {
    const int lt = (int)__builtin_amdgcn_mbcnt_hi(~0u, __builtin_amdgcn_mbcnt_lo(~0u, 0u));
    if (__builtin_amdgcn_readfirstlane((int)threadIdx.x) < 64) { int f[8]; f[7] = 0; sch.coords(lt, f);
#pragma unroll
        for (int k = 0; k < 8; ++k) ut[8 * lt + k] = f[k]; }
    __syncthreads();
}
__device__ __forceinline__ bool read_unit(const LAS int* ut, int i, Unit& u) {
    if (i >= 64) return false;
    const LAS int* p = ut + 8 * i;
    if (__builtin_amdgcn_readfirstlane(p[0]) == 0) return false;
    u.pm = __builtin_amdgcn_readfirstlane(p[1]); u.pn = __builtin_amdgcn_readfirstlane(p[2]); u.kind = __builtin_amdgcn_readfirstlane(p[3]);
    u.e = __builtin_amdgcn_readfirstlane(p[4]); u.aux = __builtin_amdgcn_readfirstlane(p[5]); u.nrow = __builtin_amdgcn_readfirstlane(p[6]);
    return true;
}

template <int NB>
struct ConvW {
    static_assert(NB == 8, "one batch size");
    static constexpr int MODE = 1;
    const float* wg; const float* wu; const float* wd; unsigned char* w8; LAS unsigned char* ring; int gw, s_iss, s_con, s_end; unsigned voff; float x[4]; unsigned d[NB];
    __device__ __forceinline__ unsigned rdoff() const { int l = (int)__builtin_amdgcn_mbcnt_hi(~0u, __builtin_amdgcn_mbcnt_lo(~0u, 0u)); asm volatile("" : "+v"(l)); return (unsigned)((l >> 4) * 256 + (l & 15) * 4); }
    __device__ __forceinline__ unsigned dstoff() const { int l = (int)__builtin_amdgcn_mbcnt_hi(~0u, __builtin_amdgcn_mbcnt_lo(~0u, 0u)); asm volatile("" : "+v"(l)); return (unsigned)((l & 15) * 2048 + (l >> 4) * 32); }
    __device__ __forceinline__ void one() {
        const int strip = (s_iss >> 7) * 2048 + gw, kg = s_iss & 127, mat = strip >> 7, nb = strip & 127;
        const float* W = (mat < 32 ? wg : mat < 64 ? wu : wd) + (size_t)(mat & 31) * D * DFF;
        const char* src = (const char*)W + (size_t)kg * (16 * 8192) + nb * 64;
        __builtin_amdgcn_global_load_lds((const unsigned*)(src + voff), (LAS unsigned*)(ring + (s_iss % 3) * 1024), 16, 0, 0);
        ++s_iss;
    }
    __device__ __forceinline__ void prime() { if (s_iss < s_end) one(); if (s_iss < s_end) one(); }
    __device__ __forceinline__ void issue() { if (s_iss < s_end) one(); }
    __device__ __forceinline__ void reads() { if (s_con < s_end) { const LAS float* p = (const LAS float*)(ring + (s_con % 3) * 1024 + rdoff()); x[0] = p[0]; x[1] = p[16]; x[2] = p[32]; x[3] = p[48]; } }
    template <int J> __device__ __forceinline__ void store() { if (s_con < s_end) {
        const unsigned v = cvt4_fp8(64.f * x[0], 64.f * x[1], 64.f * x[2], 64.f * x[3]);
        const bool par = (s_con >> 2) & 1;
        if (par) d[4 + J] = v; else d[J] = v;
        if (J == 3 && par) {
            const int s0 = s_con - 7, strip = (s0 >> 7) * 2048 + gw, kg = s0 & 127, mat = strip >> 7, nb = strip & 127;
            unsigned char* dst = w8 + (size_t)(mat >> 5) * (256 * MiB) + (size_t)(mat & 31) * D * DFF + (size_t)nb * 16 * 2048 + kg * 16;
            const auto a0 = __builtin_amdgcn_permlane32_swap(d[0], d[4], false, false), a1 = __builtin_amdgcn_permlane32_swap(d[1], d[5], false, false);
            const auto a2 = __builtin_amdgcn_permlane32_swap(d[2], d[6], false, false), a3 = __builtin_amdgcn_permlane32_swap(d[3], d[7], false, false);
            const auto va0 = __builtin_amdgcn_permlane16_swap(a0[0], a2[0], false, false), va1 = __builtin_amdgcn_permlane16_swap(a1[0], a3[0], false, false);
            const auto vb0 = __builtin_amdgcn_permlane16_swap(a0[1], a2[1], false, false), vb1 = __builtin_amdgcn_permlane16_swap(a1[1], a3[1], false, false);
            u32x4 o0, o1; o0.x = va0[0]; o0.y = va0[1]; o0.z = vb0[0]; o0.w = vb0[1]; o1.x = va1[0]; o1.y = va1[1]; o1.z = vb1[0]; o1.w = vb1[1];
            const unsigned do_ = dstoff(); *(GAS u32x4*)(dst + do_) = o0; *(GAS u32x4*)(dst + do_ + 16) = o1; }
        ++s_con; } }
    __device__ __forceinline__ void drain() {}
};

struct ConvProbe {
    static constexpr int MODE = 1;
    const float* wg; const float* wu; const float* wd; LAS unsigned char* ring; int gw; unsigned voff; int s;
    __device__ __forceinline__ void one() {
        const int strip = gw * 3 + (s >> 8), kg = s & 255, mat = strip >> 6, nb = strip & 63;
        const float* W = (mat < 32 ? wg : mat < 64 ? wu : wd) + (size_t)(mat & 31) * D * DFF;
        const char* src = (const char*)W + (size_t)kg * 65536 + nb * 128;
        __builtin_amdgcn_global_load_lds((const unsigned*)(src + voff), (LAS unsigned*)(ring + (s % 3) * 1024), 16, 0, 0);
        ++s;
    }
    __device__ __forceinline__ void prime() { one(); one(); }
    __device__ __forceinline__ void issue() { if (s < 768) one(); else { const char* src = (const char*)wg; __builtin_amdgcn_global_load_lds((const unsigned*)(src + voff), (LAS unsigned*)(ring + (s % 3) * 1024), 16, 0, 0); ++s; } }
    __device__ __forceinline__ void reads() {} __device__ __forceinline__ void pack() {} template <int J> __device__ __forceinline__ void store() {} __device__ __forceinline__ void drain() {}
};

__device__ __forceinline__ void p1_meta(Frame& F) {
    const int fr = F.lane & 15, fq = F.lane >> 4;
    LAS f32x4* part = (LAS f32x4*)F.lds;
    for (int j = blockIdx.x; j < 192; j += F.G) {
        const int cb = j & 63, sp = j >> 6;
        const int c0 = 16 * cb;
        const bf16* hm = WSP(bf16, WS_HM) + (size_t)fr * D + 8 * fq + 256 * F.wave;
        const bf16* w0 = WSP(bf16, WS_WIN) + (size_t)((sp == 0 ? O_U : sp == 1 ? O_K : O_V) + c0 + fr) * D + 8 * fq + 256 * F.wave;
        const bf16* w1 = WSP(bf16, WS_WIN) + (size_t)(O_C + c0 + fr) * D + 8 * fq + 256 * F.wave;
        f32x4 a0 = {0.f, 0.f, 0.f, 0.f}, a1 = {0.f, 0.f, 0.f, 0.f};
        const bf16* w1p = sp == 0 ? w1 : w0;
        bf16x8 af[8], b0[8], b1[8];
#pragma unroll
        for (int s = 0; s < 8; ++s) { af[s] = *(const bf16x8*)(hm + 32 * s); b0[s] = *(const bf16x8*)(w0 + 32 * s); b1[s] = *(const bf16x8*)(w1p + 32 * s); }
#pragma unroll
        for (int s = 0; s < 8; ++s) { a0 = __builtin_amdgcn_mfma_f32_16x16x32_bf16(af[s], b0[s], a0, 0, 0, 0); a1 = __builtin_amdgcn_mfma_f32_16x16x32_bf16(af[s], b1[s], a1, 0, 0, 0); }
        part[(F.wave * 2 + 0) * 64 + F.lane] = a0; part[(F.wave * 2 + 1) * 64 + F.lane] = a1;
        __syncthreads();
        if (F.wave == 0) {
            a0 = part[F.lane]; a1 = part[64 + F.lane];
#pragma unroll
            for (int w = 1; w < 8; ++w) { a0 += part[(w * 2 + 0) * 64 + F.lane]; a1 += part[(w * 2 + 1) * 64 + F.lane]; }
            bf16* dst = WSP(bf16, sp == 0 ? WS_CU : sp == 1 ? WS_K : WS_V);
#pragma unroll
            for (int jj = 0; jj < 4; ++jj) { const int tok = 4 * fq + jj; const float v = sp == 0 ? a0[jj] * a1[jj] : a0[jj];
#pragma unroll
                for (int b = 0; b < BATCH; ++b) dst[(size_t)(b * LTOT + tok) * 1024 + c0 + fr] = (bf16)f2bf(v); }
        }
        __syncthreads();
    }
}
struct Sched1 {
    static constexpr bool AROW_LOADS = false;
    int G, c; unsigned char* ws; const LAS int* ut;
    __device__ __forceinline__ void coords(int i, int (&f)[8]) const { int pm = 0, pn = 0; f[0] = pg8::static_tile(i * G + c, MR / 256, 24, pm, pn) ? 1 : 0; f[1] = pm; f[2] = pn; f[3] = 0; f[4] = 0; f[5] = 0; f[6] = 256; }
    __device__ __forceinline__ bool next(int i, Unit& u) const {
        if (!read_unit(ut, i, u)) return false;
        const char* W = (const char*)(ws + WS_WIN);
        u.A = (const char*)(ws + WS_HN) + (size_t)u.pm * 256 * D * 2; u.e = 0; u.nrow = 256; u.aux = 0;
        if (u.pn < 8) { const int cb = 256 * (u.pn >> 1) + 32 * (u.pn & 1);
            u.kind = 0; u.B0 = W + (size_t)(O_U + cb) * D * 2; u.B1 = W + (size_t)(O_C + cb) * D * 2; u.dst = (char*)(ws + WS_CU) + 2 * cb; u.ld = 1024; u.aux = 1; }
        else {
            const int col0 = u.pn < 12 ? O_B + (u.pn - 8) * 256 : O_Q + (u.pn - 12) * 256;
            u.B0 = W + (size_t)col0 * D * 2; u.B1 = u.B0 + (size_t)32 * D * 2; u.kind = 1;
            if (col0 < O_C) { u.dst = (char*)(ws + WS_BP) + (col0 - O_B) * 2; u.ld = 1024; }
            else if (col0 < O_K) { u.dst = (char*)(ws + WS_Q) + (col0 - O_Q) * 2; u.ld = 1024; u.kind = 2; }
            else if (col0 < O_V) { u.dst = (char*)(ws + WS_K) + (col0 - O_K) * 2; u.ld = 1024; u.aux = 1; }
            else if (col0 < O_GC) { u.dst = (char*)(ws + WS_V) + (col0 - O_V) * 2; u.ld = 1024; u.aux = 1; }
            else if (col0 < O_GA) { u.dst = (char*)(ws + WS_GC) + (col0 - O_GC) * 2; u.ld = 2048; }
            else { u.dst = (char*)(ws + WS_GA) + (col0 - O_GA) * 2; u.ld = 2048; }
        }
        return true;
    }
    __device__ __forceinline__ unsigned arow(const Unit&, int r) const { return (unsigned)r * (unsigned)(D * 2); }
    __device__ __forceinline__ unsigned hstepA() const { return 128u * D * 2u; }
};
struct Sched1g {
    static constexpr bool AROW_LOADS = false;
    int G, c; unsigned char* ws; const LAS int* ut;
    __device__ __forceinline__ void coords(int i, int (&f)[8]) const { int pm = 0, pn = 0; f[0] = pg8::static_tile(i * G + c, MR / 256, 16, pm, pn) ? 1 : 0; f[1] = pm; f[2] = pn; f[3] = 1; f[4] = 0; f[5] = 0; f[6] = 256; }
    __device__ __forceinline__ bool next(int i, Unit& u) const {
        if (!read_unit(ut, i, u)) return false;
        u.A = (const char*)(ws + WS_HN8) + (size_t)u.pm * 256 * D; u.e = 0; u.nrow = 256; u.aux = 0; u.kind = 1;
        u.B0 = (const char*)(ws + WS_WIN8) + (size_t)(128 * u.pn) * D; u.B1 = u.B0 + (size_t)2048 * D;
        u.dst = (char*)(ws + WS_GC) + (size_t)(128 * u.pn) * 2; u.ld = 2048;
        return true;
    }
    __device__ __forceinline__ unsigned arow(const Unit&, int r) const { return (unsigned)r * (unsigned)D; }
    __device__ __forceinline__ unsigned hstepA() const { return 128u * D; }
};
struct Epi1 {
    static constexpr bool PERM = true; static constexpr bool CHAIN = false; static constexpr bool ADJ = true;
    __device__ __forceinline__ void operator()(const f32x4 (&acc)[2][2][4][2], const Unit& u, int wr, int wc, int fr, int fq) const {
        const int m0 = u.pm * 256 + wr * 64; const int radd = u.aux ? NMETA * (m0 / SEQ + 1) : 0;
        const float sc = u.kind == 2 ? 0.08838834764831845f : 1.f;
        const bool lo8 = fr < 8;
#pragma unroll
        for (int ai = 0; ai < 2; ++ai)
#pragma unroll
            for (int m = 0; m < 4; ++m) {
                bf16* tilep = (bf16*)u.dst + (size_t)(m0 + radd + ai * 128 + m * 16) * u.ld + wc * 64 + 8 * fq;
                if (u.kind == 0) { const f32x4 v0 = acc[ai][0][m][0] * acc[ai][1][m][0], v1 = acc[ai][0][m][1] * acc[ai][1][m][1];
                    u32x4 w; w.x = cvt_pk_bf16(v0[0], v0[1]); w.y = cvt_pk_bf16(v0[2], v0[3]); w.z = cvt_pk_bf16(v1[0], v1[1]); w.w = cvt_pk_bf16(v1[2], v1[3]);
                    *(u32x4*)(tilep + (size_t)fr * u.ld) = w; }
                else {
                    u32x4 P[2];
#pragma unroll
                    for (int bj = 0; bj < 2; ++bj) { const f32x4 v0 = acc[ai][bj][m][0] * sc, v1 = acc[ai][bj][m][1] * sc;
                        P[bj].x = cvt_pk_bf16(v0[0], v0[1]); P[bj].y = cvt_pk_bf16(v0[2], v0[3]); P[bj].z = cvt_pk_bf16(v1[0], v1[1]); P[bj].w = cvt_pk_bf16(v1[2], v1[3]); }
                    u32x4 S = lo8 ? P[1] : P[0], T; T.x = ror8(S.x); T.y = ror8(S.y); T.z = ror8(S.z); T.w = ror8(S.w);
                    bf16* ap = tilep + (size_t)(fr & 7) * u.ld + (lo8 ? 0 : 32);
                    *(u32x4*)ap = lo8 ? P[0] : T; *(u32x4*)(ap + (size_t)8 * u.ld) = lo8 ? T : P[1]; }
            }
    }
};

struct Epi1g {
    static constexpr bool PERM = true; static constexpr bool CHAIN = false;
    __device__ __forceinline__ void operator()(const f32x4 (&acc)[2][2][4][2], const Unit& u, int wr, int wc, int fr, int fq) const {
        const int m0 = u.pm * 256 + wr * 64 + fr;
#pragma unroll
        for (int ai = 0; ai < 2; ++ai)
#pragma unroll
            for (int m = 0; m < 4; ++m) {
                bf16* rowp = (bf16*)u.dst + (size_t)(m0 + ai * 128 + m * 16) * 2048 + wc * 32 + 8 * fq;
                float r[8], sg[8];
#pragma unroll
                for (int n = 0; n < 2; ++n)
#pragma unroll
                    for (int j = 0; j < 4; ++j) { const float ea = __expf(-acc[ai][1][m][n][j]), ec = __expf(-acc[ai][0][m][n][j]);
                        sg[4 * n + j] = __builtin_amdgcn_rcpf(1.f + ea); r[4 * n + j] = (1.f + ea) * __builtin_amdgcn_rcpf(1.f + ec); }
                u32x4 w; w.x = cvt_pk_bf16(r[0], r[1]); w.y = cvt_pk_bf16(r[2], r[3]); w.z = cvt_pk_bf16(r[4], r[5]); w.w = cvt_pk_bf16(r[6], r[7]);
                *(u32x4*)rowp = w;
                w.x = cvt_pk_bf16(sg[0], sg[1]); w.y = cvt_pk_bf16(sg[2], sg[3]); w.z = cvt_pk_bf16(sg[4], sg[5]); w.w = cvt_pk_bf16(sg[6], sg[7]);
                *(u32x4*)(rowp + (WS_GA - WS_GC) / 2) = w;
            }
    }
};

typedef short v4i16_t __attribute__((ext_vector_type(4)));
__device__ __forceinline__ s16x4 vtr(const LAS unsigned char* p) { return __builtin_bit_cast(s16x4, __builtin_amdgcn_ds_read_tr16_b64_v4i16((LAS v4i16_t*)p)); }
__device__ __forceinline__ int voff_b(int row, int ch) { return 256 * row + 16 * (ch ^ (((row & 3) << 2) | ((row >> 2) & 3))); }
__device__ __forceinline__ void p2_attn(Frame& F) {
    const int gw = F.vcu * 8 + F.wave, NGW = F.G * 8, lane = F.lane, r = lane & 31, hf = lane >> 5;
    LAS unsigned char* vl = F.lds + F.wave * 8192;
    const int gl = lane & 15, tq = gl >> 2, tp = gl & 3, cg = (lane >> 4) & 1;
    for (int item = gw; item < BATCH * NH * (SEQ / 32); item += NGW) {
        const int qb = item & 127, h = (item >> 7) & 7, b = item >> 10;
        const int m0 = b * SEQ + 32 * qb, p0 = NMETA + 32 * qb;
        bf16x8 qf[8];
        { const bf16* qp = WSP(bf16, WS_Q) + (size_t)(m0 + r) * 1024 + h * HD + 8 * hf;
#pragma unroll
          for (int kk = 0; kk < 8; ++kk) qf[kk] = *(const bf16x8*)(qp + 16 * kk); }
        f32x16 O[4];
#pragma unroll
        for (int d = 0; d < 4; ++d)
#pragma unroll
            for (int i = 0; i < 16; ++i) O[d][i] = 0.f;
        float carry = 0.f;
        const bf16* kbase = WSP(bf16, WS_K) + (size_t)(b * LTOT) * 1024 + h * HD;
        const bf16* vbase = WSP(bf16, WS_V) + (size_t)(b * LTOT) * 1024 + h * HD;
        bf16x8 kf[8];
        { int ks = p0 + r; ks = ks > LTOT - 1 ? LTOT - 1 : ks; const bf16* kp = kbase + (size_t)ks * 1024 + 8 * hf;
#pragma unroll
          for (int kk = 0; kk < 8; ++kk) kf[kk] = *(const bf16x8*)(kp + 16 * kk); }
        for (int s0 = p0; s0 > -32; s0 -= 32) {
            f32x16 S;
#pragma unroll
            for (int i = 0; i < 16; ++i) S[i] = 0.f;
#pragma unroll
            for (int kk = 0; kk < 8; ++kk) S = __builtin_amdgcn_mfma_f32_32x32x16_bf16(kf[kk], qf[kk], S, 0, 0, 0);
            __builtin_amdgcn_sched_barrier(0);
            unsigned vadj = 0u; asm volatile("" : "+v"(vadj) : "v"(S[15]));
#pragma unroll
            for (int i = 0; i < 8; ++i) { const int p = i * 64 + lane, row = p >> 4, ch = (p & 15) ^ (((row & 3) << 2) | ((row >> 2) & 3)); int vs = s0 + row; vs = vs < 0 ? 0 : (vs > LTOT - 1 ? LTOT - 1 : vs);
                __builtin_amdgcn_global_load_lds((const unsigned*)(vbase + (size_t)vs * 1024 + ch * 8 + vadj), (LAS unsigned*)(vl + i * 1024), 16, 0, 0); }
            { int ks = s0 - 32 + r; ks = ks < 0 ? 0 : (ks > LTOT - 1 ? LTOT - 1 : ks); const bf16* kp = kbase + (size_t)ks * 1024 + 8 * hf;
#pragma unroll
              for (int kk = 0; kk < 8; ++kk) kf[kk] = *(const bf16x8*)(kp + 16 * kk); }
            __builtin_amdgcn_sched_barrier(0);
            float lr[16], lb[16];
#pragma unroll
            for (int i = 0; i < 16; ++i) { const int s = s0 + (i & 3) + 8 * (i >> 2) + 4 * hf; const bool valid = (s < p0 + r) && (s >= 0); const float z = S[i];
                const float l = fminf(z, 0.f) - __logf(1.f + __expf(-fabsf(z)));
                lb[i] = valid ? l : -1e30f; lr[i] = valid ? l - z : 0.f; }
            float own[4], oth[4], suf[4];
#pragma unroll
            for (int c = 0; c < 4; ++c) { own[c] = (lr[4 * c] + lr[4 * c + 1]) + (lr[4 * c + 2] + lr[4 * c + 3]); oth[c] = __shfl_xor(own[c], 32); }
            float tail = 0.f;
#pragma unroll
            for (int c = 3; c >= 0; --c) { suf[c] = tail + (hf == 0 ? oth[c] : 0.f); tail += own[c] + oth[c]; }
            float w[16];
#pragma unroll
            for (int c = 0; c < 4; ++c) { float in = carry + suf[c];
#pragma unroll
                for (int j = 3; j >= 0; --j) { w[4 * c + j] = __expf(lb[4 * c + j] + in); in += lr[4 * c + j]; } }
            carry += tail;
            bf16x8 pf[2];
#pragma unroll
            for (int s = 0; s < 2; ++s) { u32x4 t; t.x = cvt_pk_bf16(w[8 * s], w[8 * s + 1]); t.y = cvt_pk_bf16(w[8 * s + 2], w[8 * s + 3]); t.z = cvt_pk_bf16(w[8 * s + 4], w[8 * s + 5]); t.w = cvt_pk_bf16(w[8 * s + 6], w[8 * s + 7]);
                pf[s] = __builtin_bit_cast(bf16x8, t); }
            asm volatile("s_waitcnt vmcnt(8)" ::: "memory");
            __builtin_amdgcn_sched_barrier(0);
#pragma unroll
            for (int db = 0; db < 4; ++db)
#pragma unroll
                for (int s = 0; s < 2; ++s) {
                    const int r0 = 16 * s + 4 * hf, c0 = 4 * db + 2 * cg;
                    const s16x4 lo = vtr(vl + voff_b(r0 + tq, c0 + (tp >> 1)) + 8 * (tp & 1));
                    const s16x4 hi = vtr(vl + voff_b(r0 + 8 + tq, c0 + (tp >> 1)) + 8 * (tp & 1));
                    bf16x8 vf; vf[0] = lo[0]; vf[1] = lo[1]; vf[2] = lo[2]; vf[3] = lo[3]; vf[4] = hi[0]; vf[5] = hi[1]; vf[6] = hi[2]; vf[7] = hi[3];
                    O[db] = __builtin_amdgcn_mfma_f32_32x32x16_bf16(vf, pf[s], O[db], 0, 0, 0);
                }
            if (__all(carry < -104.f)) break;
        }
        bf16* op = WSP(bf16, WS_O) + (size_t)(m0 + r) * 1024 + h * HD + 4 * hf;
#pragma unroll
        for (int db = 0; db < 4; ++db)
#pragma unroll
            for (int i4 = 0; i4 < 4; ++i4) { u32x2 t; t.x = cvt_pk_bf16(O[db][4 * i4], O[db][4 * i4 + 1]); t.y = cvt_pk_bf16(O[db][4 * i4 + 2], O[db][4 * i4 + 3]);
                *(u32x2*)(op + 32 * db + 8 * i4) = t; }
    }
}
__device__ __forceinline__ void p2_conv(Frame& F) {
    const int nth = F.G * 512, total = MR * (CC / 8);
    int c = blockIdx.x * 512 + F.tid;
    if (c >= total) return;
    const int c8 = (c & 127) * 8;
    const f32x4 w0a = GLD(f32x4, F.conv_w + c8), w0b = GLD(f32x4, F.conv_w + c8 + 4), w1a = GLD(f32x4, F.conv_w + CC + c8), w1b = GLD(f32x4, F.conv_w + CC + c8 + 4),
                w2a = GLD(f32x4, F.conv_w + 2 * CC + c8), w2b = GLD(f32x4, F.conv_w + 2 * CC + c8 + 4);
    const float W0[8] = {w0a[0], w0a[1], w0a[2], w0a[3], w0b[0], w0b[1], w0b[2], w0b[3]}, W1[8] = {w1a[0], w1a[1], w1a[2], w1a[3], w1b[0], w1b[1], w1b[2], w1b[3]},
                W2[8] = {w2a[0], w2a[1], w2a[2], w2a[3], w2b[0], w2b[1], w2b[2], w2b[3]};
    u32x4 x0, x1, x2, bp;
#define P2C_LD(cc, A0, A1, A2, AB) do { const int m_ = (cc) >> 7, b_ = m_ / SEQ; const size_t row_ = (size_t)m_ + NMETA * (b_ + 1); const bf16* cu_ = WSP(bf16, WS_CU) + row_ * 1024 + c8; \
        A0 = *(const u32x4*)(cu_ - 2048); A1 = *(const u32x4*)(cu_ - 1024); A2 = *(const u32x4*)cu_; AB = *(const u32x4*)(WSP(bf16, WS_BP) + (size_t)m_ * 1024 + c8); } while (0)
    P2C_LD(c, x0, x1, x2, bp);
    for (; c < total; c += nth) {
        u32x4 n0 = x0, n1 = x1, n2 = x2, nb = bp;
        if (c + nth < total) P2C_LD(c + nth, n0, n1, n2, nb);
        const int m = c >> 7;
        const unsigned X0[4] = {x0.x, x0.y, x0.z, x0.w}, X1[4] = {x1.x, x1.y, x1.z, x1.w}, X2[4] = {x2.x, x2.y, x2.z, x2.w}, BP[4] = {bp.x, bp.y, bp.z, bp.w};
        unsigned ow[4];
#pragma unroll
        for (int q = 0; q < 4; ++q) {
            const float lo = bf_lo(BP[q]) * (W0[2 * q] * bf_lo(X0[q]) + W1[2 * q] * bf_lo(X1[q]) + W2[2 * q] * bf_lo(X2[q]));
            const float hi = bf_hi(BP[q]) * (W0[2 * q + 1] * bf_hi(X0[q]) + W1[2 * q + 1] * bf_hi(X1[q]) + W2[2 * q + 1] * bf_hi(X2[q]));
            ow[q] = cvt_pk_bf16(lo, hi); }
        u32x4 o; o.x = ow[0]; o.y = ow[1]; o.z = ow[2]; o.w = ow[3];
        *(u32x4*)(WSP(bf16, WS_YCIN) + (size_t)m * 1024 + c8) = o;
        x0 = n0; x1 = n1; x2 = n2; bp = nb;
    }
#undef P2C_LD
}

struct Sched3 {
    static constexpr bool AROW_LOADS = false;
    int G, c; unsigned char* ws; const LAS int* ut;
    __device__ __forceinline__ void coords(int i, int (&f)[8]) const { int pm = 0, pn = 0; f[0] = pg8::static_tile((i >> 1) * G + c, MR / 256, D / 256, pm, pn) ? 1 : 0; f[1] = pm; f[2] = pn; f[3] = i & 1; f[4] = 0; f[5] = 0; f[6] = 256; }
    __device__ __forceinline__ bool next(int i, Unit& u) const {
        if (!read_unit(ut, i, u)) return false;
        const int sub = u.kind; u.e = 0; u.nrow = 256; u.aux = 0;
        u.A = (const char*)(ws + (sub ? WS_O : WS_YCIN)) + (size_t)u.pm * 256 * 2048;
        u.B0 = (const char*)(ws + (sub ? WS_WATTN : WS_WCONV)) + (size_t)(256 * u.pn) * 1024 * 2; u.B1 = u.B0 + (size_t)32 * 1024 * 2;
        u.dst = (char*)(ws + (sub ? WS_GA : WS_GC)); u.ld = D;
        return true;
    }
    __device__ __forceinline__ unsigned arow(const Unit&, int r) const { return (unsigned)r * 2048u; }
    __device__ __forceinline__ unsigned hstepA() const { return 128u * 2048u; }
};
struct Epi3 {
    static constexpr bool PERM = true; static constexpr bool CHAIN = true; static constexpr bool ADJ = true;
    const bf16* gr; const bf16* gs; bf16* merged;
    __device__ __forceinline__ void mid(f32x4 (&acc)[2][2][4][2], const Unit& u, int wr, int wc, int fr, int fq) const {
        const int m0 = u.pm * 256 + wr * 64 + fr, col0 = u.pn * 256 + wc * 64 + 8 * fq;
#pragma unroll
        for (int ai = 0; ai < 2; ++ai)
#pragma unroll
            for (int m = 0; m < 4; ++m) { const size_t off = (size_t)(m0 + ai * 128 + m * 16) * D + col0;
#pragma unroll
                for (int bj = 0; bj < 2; ++bj) {
                    const u32x4 g = *(const u32x4*)(gr + off + bj * 32);
                    f32x4& v0 = acc[ai][bj][m][0]; f32x4& v1 = acc[ai][bj][m][1];
                    v0[0] *= bf_lo(g.x); v0[1] *= bf_hi(g.x); v0[2] *= bf_lo(g.y); v0[3] *= bf_hi(g.y);
                    v1[0] *= bf_lo(g.z); v1[1] *= bf_hi(g.z); v1[2] *= bf_lo(g.w); v1[3] *= bf_hi(g.w); } }
    }
    __device__ __forceinline__ void operator()(const f32x4 (&acc)[2][2][4][2], const Unit& u, int wr, int wc, int fr, int fq) const {
        const int m0 = u.pm * 256 + wr * 64, col0 = u.pn * 256 + wc * 64 + 8 * fq; const bool lo8 = fr < 8;
        u32x4 gv[8][2];
#define EPI3_LD(g) do { const size_t off_ = (size_t)(m0 + fr + ((g) >> 2) * 128 + ((g) & 3) * 16) * D + col0; gv[g][0] = *(const u32x4*)(gs + off_); gv[g][1] = *(const u32x4*)(gs + off_ + 32); } while (0)
        EPI3_LD(0); EPI3_LD(1); EPI3_LD(2); EPI3_LD(3);
#pragma unroll
        for (int gi = 0; gi < 8; ++gi) { const int ai = gi >> 2, m = gi & 3;
            u32x4 P[2];
#pragma unroll
                for (int bj = 0; bj < 2; ++bj) {
                    const u32x4 g = gv[gi][bj];
                    f32x4 v0 = acc[ai][bj][m][0], v1 = acc[ai][bj][m][1];
                    v0[0] *= bf_lo(g.x); v0[1] *= bf_hi(g.x); v0[2] *= bf_lo(g.y); v0[3] *= bf_hi(g.y);
                    v1[0] *= bf_lo(g.z); v1[1] *= bf_hi(g.z); v1[2] *= bf_lo(g.w); v1[3] *= bf_hi(g.w);
                    P[bj].x = cvt_pk_bf16(v0[0], v0[1]); P[bj].y = cvt_pk_bf16(v0[2], v0[3]); P[bj].z = cvt_pk_bf16(v1[0], v1[1]); P[bj].w = cvt_pk_bf16(v1[2], v1[3]); }
            u32x4 S = lo8 ? P[1] : P[0], T; T.x = ror8(S.x); T.y = ror8(S.y); T.z = ror8(S.z); T.w = ror8(S.w);
            bf16* ap = merged + (size_t)(m0 + ai * 128 + m * 16 + (fr & 7)) * D + col0 + (lo8 ? 0 : 32);
            *(u32x4*)ap = lo8 ? P[0] : T; *(u32x4*)(ap + (size_t)8 * D) = lo8 ? T : P[1];
            if (gi + 4 < 8) EPI3_LD(gi + 4); }
#undef EPI3_LD
    }
};

struct Sched4 {
    static constexpr bool AROW_LOADS = false;
    int G, c; unsigned char* ws; const LAS int* ut;
    __device__ __forceinline__ void coords(int i, int (&f)[8]) const { int pm = 0, pn = 0; f[0] = pg8::static_tile(i * G + c, MR / 256, D / 256, pm, pn) ? 1 : 0; f[1] = pm; f[2] = pn; f[3] = 0; f[4] = 0; f[5] = 0; f[6] = 256; }
    __device__ __forceinline__ bool next(int i, Unit& u) const {
        if (!read_unit(ut, i, u)) return false;
        u.kind = 0; u.e = 0; u.nrow = 256; u.aux = 0; u.A = (const char*)(ws + WS_MERGED) + (size_t)u.pm * 256 * D * 2;
        u.B0 = (const char*)(ws + WS_WO) + (size_t)(256 * u.pn) * D * 2; u.B1 = u.B0 + (size_t)32 * D * 2; u.dst = nullptr; u.ld = D;
        return true;
    }
    __device__ __forceinline__ unsigned arow(const Unit&, int r) const { return (unsigned)r * (unsigned)(D * 2); }
    __device__ __forceinline__ unsigned hstepA() const { return 128u * D * 2u; }
};
struct Epi4 {
    static constexpr bool PERM = true; static constexpr bool CHAIN = false; static constexpr bool ADJ = true;
    const bf16* xb; bf16* hres2;
    __device__ __forceinline__ void operator()(const f32x4 (&acc)[2][2][4][2], const Unit& u, int wr, int wc, int fr, int fq) const {
        const int row0 = u.pm * 256 + wr * 64, col0 = u.pn * 256 + wc * 64 + 8 * fq; const bool lo8 = fr < 8;
        u32x4 xv[8][2];
#define EPI4_LD(g) do { const size_t off_ = (size_t)(row0 + fr + ((g) >> 2) * 128 + ((g) & 3) * 16) * D + col0; xv[g][0] = GLD(u32x4, xb + off_); xv[g][1] = GLD(u32x4, xb + off_ + 32); } while (0)
        EPI4_LD(0); EPI4_LD(1); EPI4_LD(2); EPI4_LD(3);
#pragma unroll
        for (int g = 0; g < 8; ++g) { const int ai = g >> 2, m = g & 3;
            u32x4 P[2];
#pragma unroll
            for (int bj = 0; bj < 2; ++bj) { const u32x4 xw = xv[g][bj];
                const f32x4 v0 = (f32x4){bf_lo(xw.x), bf_hi(xw.x), bf_lo(xw.y), bf_hi(xw.y)} + acc[ai][bj][m][0], v1 = (f32x4){bf_lo(xw.z), bf_hi(xw.z), bf_lo(xw.w), bf_hi(xw.w)} + acc[ai][bj][m][1];
                P[bj].x = cvt_pk_bf16(v0[0], v0[1]); P[bj].y = cvt_pk_bf16(v0[2], v0[3]); P[bj].z = cvt_pk_bf16(v1[0], v1[1]); P[bj].w = cvt_pk_bf16(v1[2], v1[3]); }
            u32x4 S = lo8 ? P[1] : P[0], T; T.x = ror8(S.x); T.y = ror8(S.y); T.z = ror8(S.z); T.w = ror8(S.w);
            bf16* ap = hres2 + (size_t)(row0 + ai * 128 + m * 16 + (fr & 7)) * D + col0 + (lo8 ? 0 : 32);
            *(u32x4*)ap = lo8 ? P[0] : T; *(u32x4*)(ap + (size_t)8 * D) = lo8 ? T : P[1];
            if (g + 4 < 8) EPI4_LD(g + 4); }
#undef EPI4_LD
    }
};

__device__ __forceinline__ void p5_route(Frame& F) {
    LAS float* part = (LAS float*)F.lds;
    LAS float* ssqp = part + 2 * 64 * 33;
    LAS int* lcnt = (LAS int*)(ssqp + 128);
    LAS int* gbase = lcnt + 32;
    const int lane = F.lane, fr = lane & 15, fq = lane >> 4, tg = F.wave & 3, kh = F.wave >> 2;
    const bf16* hres2 = WSP(bf16, WS_HRES2);
    for (int tb = blockIdx.x; tb < MR / 64; tb += F.G) {
        if (F.tid < 32) lcnt[F.tid] = 0;
        const int tok = tb * 64 + tg * 16 + fr;
        const bf16* xr = hres2 + (size_t)tok * D + kh * 1024 + 8 * fq;
        const float* gr = F.g_ffn + kh * 1024 + 8 * fq;
        unsigned char* hgw = WSP(unsigned char, WS_HG) + (size_t)tok * D + kh * 1024 + 8 * fq;
        const u32x4* wf = WSP(u32x4, WS_WRF) + (size_t)(kh * 32) * 128 + lane;
        f32x4 acc0 = {0.f, 0.f, 0.f, 0.f}, acc1 = {0.f, 0.f, 0.f, 0.f}; float ssq = 0.f;
#pragma unroll 4
        for (int s = 0; s < 32; ++s) {
            const u32x4 xw = *(const u32x4*)(xr + 32 * s);
            f32x4 x0 = {bf_lo(xw.x), bf_hi(xw.x), bf_lo(xw.y), bf_hi(xw.y)}, x1 = {bf_lo(xw.z), bf_hi(xw.z), bf_lo(xw.w), bf_hi(xw.w)};
            const f32x4 g0 = GLD(f32x4, gr + 32 * s), g1 = GLD(f32x4, gr + 32 * s + 4);
            ssq += (x0[0] * x0[0] + x0[1] * x0[1]) + (x0[2] * x0[2] + x0[3] * x0[3]) + (x1[0] * x1[0] + x1[1] * x1[1]) + (x1[2] * x1[2] + x1[3] * x1[3]);
            x0 *= g0; x1 *= g1;
            u32x4 t; t.x = cvt_pk_bf16(x0[0], x0[1]); t.y = cvt_pk_bf16(x0[2], x0[3]); t.z = cvt_pk_bf16(x1[0], x1[1]); t.w = cvt_pk_bf16(x1[2], x1[3]);
            { u32x2 h8; h8.x = cvt4_fp8(x0[0], x0[1], x0[2], x0[3]); h8.y = cvt4_fp8(x1[0], x1[1], x1[2], x1[3]); *(u32x2*)(hgw + 32 * s) = h8; }
            const bf16x8 bfr = __builtin_bit_cast(bf16x8, t);
            const bf16x8 a0 = __builtin_bit_cast(bf16x8, wf[(size_t)(2 * s) * 64]), a1 = __builtin_bit_cast(bf16x8, wf[(size_t)(2 * s + 1) * 64]);
            acc0 = __builtin_amdgcn_mfma_f32_16x16x32_bf16(a0, bfr, acc0, 0, 0, 0);
            acc1 = __builtin_amdgcn_mfma_f32_16x16x32_bf16(a1, bfr, acc1, 0, 0, 0);
        }
        ssq += __shfl_xor(ssq, 16); ssq += __shfl_xor(ssq, 32);
        { LAS float* pp = part + (kh * 64 + tg * 16 + fr) * 33 + 4 * fq;
#pragma unroll
          for (int j = 0; j < 4; ++j) { pp[j] = acc0[j]; pp[16 + j] = acc1[j]; }
          if (fq == 0) ssqp[kh * 64 + tg * 16 + fr] = ssq; }
        __syncthreads();
        if (F.wave == 0) {
            const int t = tb * 64 + lane;
            const float rstd = rsqrtf((ssqp[lane] + ssqp[64 + lane]) * (1.f / D) + EPS);
            float lg[NE];
#pragma unroll
            for (int e = 0; e < NE; ++e) lg[e] = rstd * (part[lane * 33 + e] + part[(64 + lane) * 33 + e]) + GLD(float, F.b_router + e);
            int ti[TOPK]; float tv[TOPK]; unsigned used = 0u;
#pragma unroll
            for (int k = 0; k < TOPK; ++k) { int bi = -1; float bv = 0.f;
#pragma unroll
                for (int e = 0; e < NE; ++e) { const bool take = !((used >> e) & 1u) && (bi < 0 || lg[e] > bv); bi = take ? e : bi; bv = take ? lg[e] : bv; }
                used |= 1u << bi; ti[k] = bi; tv[k] = bv; }
            float ex[TOPK], den = 0.f;
#pragma unroll
            for (int k = 0; k < TOPK; ++k) { ex[k] = __expf(tv[k] - tv[0]); den += ex[k]; }
            const float rden = 1.f / den;
            int lrk[TOPK];
#pragma unroll
            for (int k = 0; k < TOPK; ++k) lrk[k] = __hip_atomic_fetch_add(&lcnt[ti[k]], 1, __ATOMIC_RELAXED, __HIP_MEMORY_SCOPE_WORKGROUP);
            LDS_WAIT();
            if (lane < 32) { const int c = lcnt[lane]; int gb = 0; if (c) gb = (int)atomicAdd(F.ctl + CW_CNT + 64 * lane, (unsigned)c); gbase[lane] = gb; }
            LDS_WAIT();
#pragma unroll
            for (int k = 0; k < TOPK; ++k) { const int e = ti[k], sid = e * SLOT_CAP + gbase[e] + lrk[k];
                WSP(int, WS_TOKOF)[sid] = t; WSP(float, WS_RSTDOF)[sid] = rstd; WSP(float, WS_CWOF)[sid] = ex[k] * rden; WSP(int, WS_TOKSLOT)[t * TOPK + k] = sid; }
        }
        __syncthreads();
    }
}

__device__ __forceinline__ void moe_tables(Frame& F) {
    LAS int* tb = (LAS int*)(F.lds + LDS_TBL);
    if (F.wave == 0) {
        const int c = F.lane < NE ? (int)__hip_atomic_load(F.ctl + CW_CNT + 64 * (F.lane & 31), __ATOMIC_RELAXED, __HIP_MEMORY_SCOPE_AGENT) : 0;
        int t = (c + 255) >> 8, inc = t;
#pragma unroll
        for (int o = 1; o < 32; o <<= 1) { const int v = __shfl_up(inc, o); if ((F.lane & 31) >= o) inc += v; }
        if (F.lane < NE) { tb[F.lane] = c; tb[32 + F.lane + 1] = inc; }
        if (F.lane == 0) tb[32] = 0;
    }
    __syncthreads();
}
constexpr int ROT_UNITS = 24;
__device__ __forceinline__ void build_rowoffs(const LAS int* ut, LAS unsigned* rot, const unsigned char* ws, int wave) {
    int lt = (int)__builtin_amdgcn_mbcnt_hi(~0u, __builtin_amdgcn_mbcnt_lo(~0u, 0u)); asm volatile("" : "+v"(lt));
    const int tid = wave * 64 + lt;
    for (int idx = tid; idx < ROT_UNITS * 256; idx += 512) {
        const int i = idx >> 8, r = idx & 255; const LAS int* p = ut + 8 * i;
        unsigned off = 0u;
        if (p[0] != 0 && r < p[6]) off = (unsigned)((const GAS int*)(ws + WS_TOKOF))[p[4] * SLOT_CAP + p[5] * 256 + r] * (unsigned)D;
        rot[idx] = off;
    }
    __syncthreads();
}
template <bool SECOND> struct SchedMoe {
    static constexpr bool AROW_LOADS = !SECOND;
    static constexpr int second = SECOND ? 1 : 0;
    int G, c, nN; unsigned char* ws; const LAS int* tb; const LAS int* ut;
    __device__ __forceinline__ void coords(int i, int (&f)[8]) const {
        const int Mt = tb[32 + NE]; int gm = 0, pn = 0; f[0] = pg8::static_tile(i * G + c, Mt, nN, gm, pn, 8) ? 1 : 0;
        int e = 0;
        for (int j = 0; j < NE - 1; ++j) e += (tb[32 + j + 1] <= gm) ? 1 : 0;
        const int mt = gm - tb[32 + e], cnt = tb[e];
        f[1] = gm; f[2] = pn; f[3] = 0; f[4] = e; f[5] = mt; f[6] = (cnt - mt * 256) < 256 ? (cnt - mt * 256) : 256;
    }
    __device__ __forceinline__ bool next(int i, Unit& u) const {
        if (!read_unit(ut, i, u)) return false;
        const int gm = u.pm, pn = u.pn, e = u.e; u.ld = i; u.dst = nullptr;
        if (!second) { u.A = (const char*)(ws + WS_HG); u.B0 = (const char*)(ws + WS_WG) + ((size_t)e * DFF + 128 * pn) * D; u.B1 = (const char*)(ws + WS_WU) + ((size_t)e * DFF + 128 * pn) * D; }
        else { u.A = (const char*)(ws + WS_ACT) + (size_t)gm * 256 * DFF; u.B0 = (const char*)(ws + WS_WD) + ((size_t)e * D + 256 * pn) * DFF; u.B1 = u.B0 + (size_t)128 * DFF; }
        return true;
    }
    __device__ __forceinline__ unsigned arow(const Unit& u, int r) const {
        if (second) return (unsigned)r * (unsigned)DFF;
        const LAS unsigned* rot = (const LAS unsigned*)((const LAS unsigned char*)tb + (LDS_CVRING - LDS_TBL));
        return rot[u.ld * 256 + r];
    }
    __device__ __forceinline__ unsigned hstepA() const { return 128u * DFF; }
};
struct Epi6 {
    static constexpr bool PERM = true; static constexpr bool CHAIN = false; static constexpr bool WIDE = true; static constexpr bool RELAX = true;
    const float* b_gate; const float* b_up; const float* rstd_of; unsigned char* act;
    __device__ __forceinline__ void operator()(const f32x4 (&acc)[2][2][4][2], const Unit& u, int wr, int wc, int fr, int fq) const {
        const int colw = u.pn * 128 + wc * 32 + 16 * (fq & 1), col0 = colw + 8 * (fq >> 1), hi = fq >> 1;
        const f32x4 bg0 = GLD(f32x4, b_gate + u.e * DFF + col0), bg1 = GLD(f32x4, b_gate + u.e * DFF + col0 + 4), bu0 = GLD(f32x4, b_up + u.e * DFF + col0), bu1 = GLD(f32x4, b_up + u.e * DFF + col0 + 4);
        float rsv[8];
#pragma unroll
        for (int i = 0; i < 8; ++i) rsv[i] = rstd_of[u.e * SLOT_CAP + u.aux * 256 + (i >> 2) * 128 + wr * 64 + (i & 3) * 16 + fr];
        asm volatile("s_waitcnt vmcnt(0)" ::: "memory");
#pragma unroll
        for (int ai = 0; ai < 2; ++ai)
#pragma unroll
            for (int mp = 0; mp < 2; ++mp) { const int rl0 = ai * 128 + wr * 64 + mp * 32 + fr;
                u32x2 w[2];
#pragma unroll
                for (int q = 0; q < 2; ++q) { const int m = 2 * mp + q;
                    const float rs = rsv[ai * 4 + m];
                    f32x4 o[2];
#pragma unroll
                    for (int n = 0; n < 2; ++n) { const f32x4 g = acc[ai][0][m][n] * rs + (n ? bg1 : bg0), up = acc[ai][1][m][n] * rs + (n ? bu1 : bu0);
#pragma unroll
                        for (int j = 0; j < 4; ++j) { const float gt = fminf(g[j], 7.f), uu = fminf(fmaxf(up[j], -7.f), 7.f); o[n][j] = (uu + 1.f) * (gt * fast_sigmoid(1.702f * gt)); } }
                    w[q].x = cvt4_fp8(o[0][0], o[0][1], o[0][2], o[0][3]); w[q].y = cvt4_fp8(o[1][0], o[1][1], o[1][2], o[1][3]); }
                const auto rx = __builtin_amdgcn_permlane32_swap(w[0].x, w[1].x, false, false), ry = __builtin_amdgcn_permlane32_swap(w[0].y, w[1].y, false, false);
                const int rl = rl0 + 16 * hi;
                if (rl < u.nrow) { u32x4 v; v.x = rx[0]; v.y = ry[0]; v.z = rx[1]; v.w = ry[1];
                    *(u32x4*)(act + (size_t)(u.pm * 256 + rl) * DFF + colw) = v; } }
    }
};
struct Epi7 {
    static constexpr bool PERM = true; static constexpr bool CHAIN = false; static constexpr bool WIDE = true; static constexpr bool RELAX = true;
    const float* b_down; const float* cw_of; unsigned char* Y;
    __device__ __forceinline__ void operator()(const f32x4 (&acc)[2][2][4][2], const Unit& u, int wr, int wc, int fr, int fq) const {
        const int colw = u.pn * 256 + wc * 32 + 16 * (fq & 1), col0 = colw + 8 * (fq >> 1), hi = fq >> 1;
        f32x4 bv[2][2];
#pragma unroll
        for (int bj = 0; bj < 2; ++bj)
#pragma unroll
            for (int n = 0; n < 2; ++n) bv[bj][n] = GLD(f32x4, b_down + u.e * D + col0 + bj * 128 + 4 * n);
        float cwv[8];
#pragma unroll
        for (int i = 0; i < 8; ++i) cwv[i] = cw_of[u.e * SLOT_CAP + u.aux * 256 + (i >> 2) * 128 + wr * 64 + (i & 3) * 16 + fr];
        asm volatile("s_waitcnt vmcnt(0)" ::: "memory");
#pragma unroll
        for (int ai = 0; ai < 2; ++ai)
#pragma unroll
            for (int mp = 0; mp < 2; ++mp) { const int rl0 = ai * 128 + wr * 64 + mp * 32 + fr, rl = rl0 + 16 * hi;
                const float cw0 = cwv[ai * 4 + 2 * mp], cw1 = cwv[ai * 4 + 2 * mp + 1];
#pragma unroll
                for (int bj = 0; bj < 2; ++bj) { u32x2 w[2];
#pragma unroll
                    for (int q = 0; q < 2; ++q) { const float cw = q ? cw1 : cw0; const f32x4 v0 = (acc[ai][bj][2 * mp + q][0] + bv[bj][0]) * cw, v1 = (acc[ai][bj][2 * mp + q][1] + bv[bj][1]) * cw;
                        w[q].x = cvt4_fp8(v0[0], v0[1], v0[2], v0[3]); w[q].y = cvt4_fp8(v1[0], v1[1], v1[2], v1[3]); }
                    const auto rx = __builtin_amdgcn_permlane32_swap(w[0].x, w[1].x, false, false), ry = __builtin_amdgcn_permlane32_swap(w[0].y, w[1].y, false, false);
                    if (rl < u.nrow) { u32x4 v; v.x = rx[0]; v.y = ry[0]; v.z = rx[1]; v.w = ry[1];
                        *(u32x4*)(Y + (size_t)(u.pm * 256 + rl) * D + colw + bj * 128) = v; } } }
    }
};

struct EpiNull { static constexpr bool PERM = true; static constexpr bool CHAIN = false;
    __device__ __forceinline__ void operator()(const f32x4 (&acc)[2][2][4][2], const Unit& u, int, int, int, int) const {
        float s = 0.f;
#pragma unroll
        for (int a = 0; a < 2; ++a)
#pragma unroll
            for (int b = 0; b < 2; ++b)
#pragma unroll
                for (int m = 0; m < 4; ++m)
#pragma unroll
                    for (int n = 0; n < 2; ++n) s += acc[a][b][m][n][0] + acc[a][b][m][n][3];
        if (s == 1.2345e30f) ((float*)u.A)[0] = s; } };
__device__ __forceinline__ void p8_final(Frame& F) {
    const LAS int* tb = (const LAS int*)(F.lds + LDS_TBL);
    const int gw = F.vcu * 8 + F.wave, NGW = F.G * 8, lane = F.lane;
    const bf16* hres2 = WSP(bf16, WS_HRES2); const unsigned char* Y = WSP(unsigned char, WS_Y);
    for (int t = gw; t < MR; t += NGW) {
        const int* ts = WSP(int, WS_TOKSLOT) + t * TOPK;
        const unsigned char* yr[TOPK];
#pragma unroll
        for (int k = 0; k < TOPK; ++k) { const int sid = __builtin_amdgcn_readfirstlane(ts[k]); const int e = sid >> 14, r = sid & (SLOT_CAP - 1); yr[k] = Y + (size_t)(tb[32 + e] * 256 + r) * D + 16 * lane; }
        const bf16* xr = hres2 + (size_t)t * D + 16 * lane;
        float v[2][16]; float s = 0.f;
#pragma unroll
        for (int j = 0; j < 2; ++j) {
            const u32x4 xa = *(const u32x4*)(xr + 1024 * j), xb = *(const u32x4*)(xr + 1024 * j + 8);
            const unsigned xw[8] = {xa.x, xa.y, xa.z, xa.w, xb.x, xb.y, xb.z, xb.w};
#pragma unroll
            for (int q = 0; q < 8; ++q) { v[j][2 * q] = bf_lo(xw[q]); v[j][2 * q + 1] = bf_hi(xw[q]); }
#pragma unroll
            for (int k = 0; k < TOPK; ++k) { const u32x4 y = *(const u32x4*)(yr[k] + 1024 * j); const unsigned yw[4] = {y.x, y.y, y.z, y.w};
#pragma unroll
                for (int q = 0; q < 4; ++q) { const f32x2_t lo = __builtin_amdgcn_cvt_pk_f32_fp8((int)yw[q], false), hi = __builtin_amdgcn_cvt_pk_f32_fp8((int)yw[q], true);
                    v[j][4 * q] += lo[0]; v[j][4 * q + 1] += lo[1]; v[j][4 * q + 2] += hi[0]; v[j][4 * q + 3] += hi[1]; } }
#pragma unroll
            for (int q = 0; q < 16; ++q) s += v[j][q] * v[j][q];
        }
        const float rstd = rsqrtf(wave_sum(s) * (1.f / D) + EPS);
#pragma unroll
        for (int j = 0; j < 2; ++j) { f32x4* op = (f32x4*)(F.out + (size_t)t * D + 16 * lane + 1024 * j); const GAS f32x4* gp = (const GAS f32x4*)(F.g_final + 16 * lane + 1024 * j);
#pragma unroll
            for (int q = 0; q < 4; ++q) { const f32x4 g = gp[q]; f32x4 o; o[0] = v[j][4 * q] * rstd * g[0]; o[1] = v[j][4 * q + 1] * rstd * g[1]; o[2] = v[j][4 * q + 2] * rstd * g[2]; o[3] = v[j][4 * q + 3] * rstd * g[3]; op[q] = o; } }
    }
}

#ifndef DUP_PHASE
#define DUP_PHASE -1
#endif
#ifdef CV_DUMMY
constexpr size_t CV_DST = WS_Y;
#else
constexpr size_t CV_DST = WS_WG;
#endif
__global__ void __launch_bounds__(512, 2) mk_fwd(Args args) {
    extern __shared__ __attribute__((aligned(16))) unsigned char lds[];
    Frame F;
    F.lds = (LAS unsigned char*)lds;
    F.tid = threadIdx.x; F.lane = F.tid & 63; F.wave = __builtin_amdgcn_readfirstlane(F.tid >> 6);
    F.G = gridDim.x; { const int bx = blockIdx.x; F.vcu = (F.G % 8 == 0) ? (bx % 8) * (F.G / 8) + bx / 8 : bx; }
    F.x = args.in[0]; F.meta = args.in[1]; F.g_mix = args.in[2]; F.w_in = args.in[3]; F.conv_w = args.in[4]; F.w_conv_out = args.in[5]; F.w_attn_out = args.in[6]; F.w_o = args.in[7];
    F.g_ffn = args.in[8]; F.w_router = args.in[9]; F.b_router = args.in[10]; F.w_gate = args.in[11]; F.b_gate = args.in[12]; F.w_up = args.in[13]; F.b_up = args.in[14];
    F.w_down = args.in[15]; F.b_down = args.in[16]; F.g_final = args.in[17];
    F.out = args.out; F.ws = args.ws; F.ctl = (unsigned*)(args.ws + WS_CTL);
    for (int u = F.tid; u < (LDS_BYTES - RING_BYTES) / 4; u += 512) ((LAS unsigned*)(F.lds + RING_BYTES))[u] = 0u;
    __syncthreads();
    const int lo = args.ph_lo, hi = args.ph_hi;
    const bool multi = (hi - lo) > 1;
    XcdBarrier bar; bar.bar = F.ctl + CW_BAR; bar.x = 0; bar.st = nullptr;
    if (multi) bar = xcd_barrier_post(F.ctl + CW_BAR, (volatile LAS unsigned*)(F.lds + LDS_MISC));
#ifdef ONLY_PHASE
#define IN(k) ((k) == ONLY_PHASE)
#else
#define IN(k) (lo <= (k) && (k) < hi)
#endif
#define ARG(i) ([&]() { const float* p_ = args.in[i]; asm volatile("" : "+s"(p_)); return p_; }())
#define SEAM(k) do { if (IN(k) && IN((k) + 1)) xcd_barrier(bar); } while (0)
#ifdef CV_DUMMY
    const bool ride = false; const bool cvon = true;
#else
    const bool ride = (F.G == 256); const bool cvon = ride;
#endif
    if (IN(0)) { p0_prologue(F, ride); if (DUP_PHASE == 0) p0_prologue(F, ride); SEAM(0); }
    if (IN(1)) {
        F.w_gate = ARG(11); F.w_up = ARG(13); F.w_down = ARG(15);
        p1_meta(F);
        LAS int* ut = (LAS int*)(F.lds + LDS_UNITS);
        Sched1 S{F.G, (int)blockIdx.x, F.ws, ut}; Epi1 E; build_units(S, ut);
#define CVW(NB_, lo_, hi_) int cl_ = (int)__builtin_amdgcn_mbcnt_hi(~0u, __builtin_amdgcn_mbcnt_lo(~0u, 0u)); asm volatile("" : "+v"(cl_));     \
        ConvW<NB_> cvw{F.w_gate, F.w_up, F.w_down, F.ws + CV_DST, F.lds + LDS_CVRING + F.wave * 3072, F.vcu * 8 + F.wave, cvon ? (lo_) : 0, cvon ? (lo_) : 0, cvon ? (hi_) : 0, \
                    (unsigned)((cl_ >> 2) * 8192 + (cl_ & 3) * 16), {0.f, 0.f, 0.f, 0.f}, {}}
        { CVW(8, 0, 384); pg8::gemm_phase<Epi1, Sched1, true, true, false, ConvW<8>>(F.lds, D, S, E, cvw); }
        { Sched1g Sg{F.G, (int)blockIdx.x, F.ws, ut}; build_units(Sg, ut);
          CVW(8, 384, 512); Epi1g Eg; pg8::gemm_phase<Epi1g, Sched1g, true, true, true, ConvW<8>>(F.lds, D, Sg, Eg, cvw); }
        SEAM(1);
    }
    if (IN(2)) { F.conv_w = ARG(4); p2_attn(F); p2_conv(F); if (DUP_PHASE == 2) { p2_attn(F); p2_conv(F); } SEAM(2); }
    if (IN(3)) {
        F.w_gate = ARG(11); F.w_up = ARG(13); F.w_down = ARG(15);
        LAS int* ut = (LAS int*)(F.lds + LDS_UNITS);
        Sched3 S{F.G, (int)blockIdx.x, F.ws, ut}; Epi3 E{WSP(bf16, WS_GC), WSP(bf16, WS_GA), WSP(bf16, WS_MERGED)}; build_units(S, ut);
        { CVW(8, 512, 640); pg8::gemm_phase<Epi3, Sched3, true, true, false, ConvW<8>>(F.lds, 1024, S, E, cvw); }
        SEAM(3);
    }
    if (IN(4)) {
        F.w_gate = ARG(11); F.w_up = ARG(13); F.w_down = ARG(15); F.x = ARG(0);
        LAS int* ut = (LAS int*)(F.lds + LDS_UNITS);
        Sched4 S{F.G, (int)blockIdx.x, F.ws, ut}; Epi4 E{WSP(bf16, WS_XB), WSP(bf16, WS_HRES2)}; build_units(S, ut);
        { CVW(8, 640, 768); pg8::gemm_phase<Epi4, Sched4, true, true, false, ConvW<8>>(F.lds, D, S, E, cvw); }
        if (DUP_PHASE == 4) pg8::gemm_phase<Epi4, Sched4, true, true>(F.lds, D, S, E);
        if (DUP_PHASE == 14) { EpiNull EN; pg8::gemm_phase<EpiNull, Sched4, true, true>(F.lds, D, S, EN); }
        SEAM(4);
    }
    if (IN(5)) { F.g_ffn = ARG(8); F.b_router = ARG(10); p5_route(F); SEAM(5); }
    if (IN(6)) {
        F.b_gate = ARG(12); F.b_up = ARG(14);
        moe_tables(F);
        LAS int* ut = (LAS int*)(F.lds + LDS_UNITS);
        SchedMoe<false> S{F.G, (int)blockIdx.x, DFF / 128, F.ws, (const LAS int*)(F.lds + LDS_TBL), ut}; build_units(S, ut);
        build_rowoffs(ut, (LAS unsigned*)(F.lds + LDS_CVRING), F.ws, F.wave);
        Epi6 E{F.b_gate, F.b_up, WSP(float, WS_RSTDOF), WSP(unsigned char, WS_ACT)};
        pg8::gemm_phase<Epi6, SchedMoe<false>, true, true, true>(F.lds, D, S, E);
        if (DUP_PHASE == 6) pg8::gemm_phase<Epi6, SchedMoe<false>, true, true, true>(F.lds, D, S, E);
        if (DUP_PHASE == 16) { EpiNull EN; pg8::gemm_phase<EpiNull, SchedMoe<false>, true, true, true>(F.lds, D, S, EN); }
                SEAM(6);
    }
    if (IN(7)) {
        F.b_down = ARG(16);
        moe_tables(F);
        LAS int* ut = (LAS int*)(F.lds + LDS_UNITS);
        SchedMoe<true> S{F.G, (int)blockIdx.x, D / 256, F.ws, (const LAS int*)(F.lds + LDS_TBL), ut}; build_units(S, ut);
        Epi7 E{F.b_down, WSP(float, WS_CWOF), WSP(unsigned char, WS_Y)};
        pg8::gemm_phase<Epi7, SchedMoe<true>, true, true, true>(F.lds, DFF, S, E);
        if (DUP_PHASE == 7) pg8::gemm_phase<Epi7, SchedMoe<true>, true, true, true>(F.lds, DFF, S, E);
        if (DUP_PHASE == 17) { EpiNull EN; pg8::gemm_phase<EpiNull, SchedMoe<true>, true, true, true>(F.lds, DFF, S, EN); }
        SEAM(7);
    }
    if (IN(8)) { F.g_final = ARG(17); moe_tables(F); p8_final(F); if (DUP_PHASE == 8) p8_final(F); }
#undef IN
#undef SEAM
}

#ifndef DEBUG_HYBRID
#ifndef MK_ONE_LAUNCH
#define MK_ONE_LAUNCH 1
#endif
extern "C" void kernel_launch(void* const* d_in, const int* in_sizes, int n_in, void* d_out, int out_size, void* d_ws, size_t ws_size, hipStream_t stream) {
    static int grid = 0;
    if (grid == 0) {
        if (n_in != 18 || out_size != MR * D || ws_size < WS_END) { fprintf(stderr, "kernel_launch: unexpected problem (n_in %d, out %d, ws %zu, need %zu)\n", n_in, out_size, ws_size, (size_t)WS_END); grid = -1; return; }
        int dev = 0, cus = 0, per_cu = 0;
        if (hipGetDevice(&dev) != hipSuccess || hipDeviceGetAttribute(&cus, hipDeviceAttributeMultiprocessorCount, dev) != hipSuccess) { grid = -1; return; }
        if (hipFuncSetAttribute((const void*)mk_fwd, hipFuncAttributeMaxDynamicSharedMemorySize, LDS_BYTES) != hipSuccess) { fprintf(stderr, "kernel_launch: hipFuncSetAttribute failed\n"); grid = -1; return; }
        if (hipOccupancyMaxActiveBlocksPerMultiprocessor(&per_cu, (const void*)mk_fwd, 512, LDS_BYTES) != hipSuccess || per_cu < 1) { fprintf(stderr, "kernel_launch: occupancy query says %d\n", per_cu); }
        (void)hipGetLastError();
        grid = cus;
    }
    if (grid < 0) return;
    if (hipMemsetAsync((char*)d_ws + WS_CTL, 0, CTL_ZERO_BYTES, stream) != hipSuccess) return;
    Args a{};
    for (int i = 0; i < 18; ++i) a.in[i] = (const float*)d_in[i];
    a.out = (float*)d_out; a.ws = (unsigned char*)d_ws;
#if MK_ONE_LAUNCH
    a.ph_lo = 0; a.ph_hi = NPH;
    hipLaunchKernelGGL(mk_fwd, dim3(grid), dim3(512), LDS_BYTES, stream, a);
#else
    for (int p = 0; p < NPH; ++p) { a.ph_lo = p; a.ph_hi = p + 1; hipLaunchKernelGGL(mk_fwd, dim3(grid), dim3(512), LDS_BYTES, stream, a); }
#endif
}
#endif
```

```cpp
#include <hip/hip_runtime.h>
#include <cstdio>
#include <cstdint>

#define GAS __attribute__((address_space(1)))
#define GLD(T, p) (*(const GAS T*)(p))
#define LAS __attribute__((address_space(3)))
typedef unsigned short bf16;
typedef short bf16x8 __attribute__((ext_vector_type(8)));
typedef short s16x4 __attribute__((ext_vector_type(4)));
typedef float f32x4 __attribute__((ext_vector_type(4)));
typedef float f32x16 __attribute__((ext_vector_type(16)));
typedef unsigned u32x4 __attribute__((ext_vector_type(4)));
typedef unsigned u32x2 __attribute__((ext_vector_type(2)));

constexpr int D = 2048, BATCH = 4, SEQ = 4096, NMETA = 16, LTOT = SEQ + NMETA;
constexpr int MR = BATCH * SEQ;
constexpr int ROWS = BATCH * LTOT;
constexpr int NH = 8, HD = 128, AW = 1024, CC = 1024, NE = 32, TOPK = 4, DFF = 2048, INW = 10240;
constexpr int O_U = 0, O_B = 1024, O_C = 2048, O_Q = 3072, O_K = 4096, O_V = 5120, O_GC = 6144, O_GA = 8192;
constexpr float EPS = 1e-5f;
constexpr int SLOT_CAP = 16384;
constexpr int MAXT = MR * TOPK / 256 + NE;
constexpr int NPH = 9;

constexpr size_t MiB = 1u << 20;
constexpr size_t WS_CTL = 0, CTL_ZERO_BYTES = 1 * MiB;
constexpr size_t WS_WIN = 1 * MiB;
constexpr size_t WS_WCONV = WS_WIN + 40 * MiB;
constexpr size_t WS_WATTN = WS_WCONV + 4 * MiB;
constexpr size_t WS_WO = WS_WATTN + 4 * MiB;
constexpr size_t WS_WRF = WS_WO + 8 * MiB;
constexpr size_t WS_HM = WS_WRF + 1 * MiB;
constexpr size_t WS_WG = WS_HM + 1 * MiB;
constexpr size_t WS_WU = WS_WG + 256 * MiB;
constexpr size_t WS_WD = WS_WU + 256 * MiB;
constexpr size_t WS_HRES2 = WS_WD + 256 * MiB;
constexpr size_t WS_XB = WS_HRES2 + 64 * MiB;
constexpr size_t WS_HG = WS_HRES2 + 128 * MiB;
constexpr size_t WS_TOKOF = WS_HG + 64 * MiB;
constexpr size_t WS_RSTDOF = WS_TOKOF + 2 * MiB;
constexpr size_t WS_CWOF = WS_RSTDOF + 2 * MiB;
constexpr size_t WS_TOKSLOT = WS_CWOF + 2 * MiB;
constexpr size_t WS_Y = WS_TOKSLOT + 1 * MiB;
constexpr size_t WS_X = WS_Y + 288 * MiB;
constexpr size_t WS_HN = WS_X;
constexpr size_t WS_YCIN = WS_X, WS_O = WS_X + 32 * MiB;
constexpr size_t WS_CU = WS_X + 64 * MiB;
constexpr size_t WS_BP = WS_CU + 33 * MiB;
constexpr size_t WS_Q = WS_BP + 32 * MiB;
constexpr size_t WS_K = WS_Q + 32 * MiB;
constexpr size_t WS_V = WS_K + 33 * MiB;
constexpr size_t WS_GC = WS_V + 33 * MiB;
constexpr size_t WS_GA = WS_GC + 64 * MiB;
constexpr size_t WS_MERGED = WS_GA + 64 * MiB;
constexpr size_t WS_HN8 = WS_MERGED + 64 * MiB;
constexpr size_t WS_WIN8 = WS_HN8 + 32 * MiB;
constexpr size_t WS_X_END1 = WS_WIN8 + 8 * MiB;
constexpr size_t WS_ACT = WS_X;
constexpr size_t WS_X_END2 = WS_ACT + 288 * MiB;
constexpr size_t WS_END = WS_X_END1 > WS_X_END2 ? WS_X_END1 : WS_X_END2;
static_assert((size_t)MAXT * 256 * D * 2 <= 288 * MiB, "act/Y size");
constexpr int CW_BAR = 1024;
constexpr int CW_CNT = 8192;

constexpr int RING_BYTES = 131072;
constexpr int LDS_TBL = RING_BYTES;
constexpr int LDS_MISC = RING_BYTES + 1024;
constexpr int LDS_UNITS = RING_BYTES + 2048;
constexpr int LDS_CVRING = RING_BYTES + 4096;
constexpr int LDS_BYTES = 159744;

#define LDS_WAIT() asm volatile("s_waitcnt lgkmcnt(0)" ::: "memory")
#define VM_WAIT() asm volatile("s_waitcnt vmcnt(0)" ::: "memory")
__device__ __forceinline__ unsigned f2bf(float f) { unsigned u = __builtin_bit_cast(unsigned, f); return (u + 0x7fffu + ((u >> 16) & 1u)) >> 16; }

typedef float f32x2_t __attribute__((ext_vector_type(2)));
typedef __bf16 bf16x2_t __attribute__((ext_vector_type(2)));
__device__ __forceinline__ unsigned cvt_pk_bf16(float lo, float hi) { const f32x2_t v = {lo, hi}; return __builtin_bit_cast(unsigned, __builtin_convertvector(v, bf16x2_t)); }
__device__ __forceinline__ unsigned pk2(float lo, float hi) { return cvt_pk_bf16(lo, hi); }
__device__ __forceinline__ unsigned cvt4_fp8(float a, float b, float c, float d) { int p = __builtin_amdgcn_cvt_pk_fp8_f32(a, b, 0, false); p = __builtin_amdgcn_cvt_pk_fp8_f32(c, d, p, true); return (unsigned)p; }
__device__ __forceinline__ float bf_lo(unsigned w) { return __builtin_bit_cast(float, w << 16); }
__device__ __forceinline__ float bf_hi(unsigned w) { return __builtin_bit_cast(float, w & 0xffff0000u); }
__device__ __forceinline__ float wave_sum(float v) {
#pragma unroll
    for (int o = 1; o < 64; o <<= 1) v += __shfl_xor(v, o);
    return v;
}
__device__ __forceinline__ float fast_sigmoid(float x) { return __builtin_amdgcn_rcpf(1.f + __expf(-x)); }

#define XB_TMO      128
#define XB_XCNT(j)  (256  + 64 * (j))
#define XB_XSUB(j)  (1280 + 64 * (j))
#define XB_XGEN(j)  (2304 + 64 * (j))
#define XB_TOP      3328
#define XB_TOPGEN   3392
#define XCD_BAR_WORDS 3456
#define XB_SPIN_CAP (1u << 18)
__device__ __forceinline__ unsigned xb_ld(unsigned* p)              { return __hip_atomic_load(p, __ATOMIC_RELAXED, __HIP_MEMORY_SCOPE_AGENT); }
__device__ __forceinline__ unsigned xb_add(unsigned* p, unsigned v) { return __hip_atomic_fetch_add(p, v, __ATOMIC_RELAXED, __HIP_MEMORY_SCOPE_AGENT); }
__device__ __forceinline__ unsigned xb_xcc_id() { return (unsigned)__builtin_amdgcn_s_getreg((3 << 11) | 20) & 0xFu; }
#define XB_SPIN(cond, bar) do { unsigned _sp = 0; while (cond) { __builtin_amdgcn_s_sleep(1); \
    if ((++_sp & 255u) == 0u) { if (xb_ld(&(bar)[XB_TMO])) break; if (_sp > XB_SPIN_CAP) { atomicAdd(&(bar)[XB_TMO], 1u); break; } } } } while (0)
struct XcdBarrier { unsigned* bar; unsigned x; volatile LAS unsigned* st; };
__device__ __forceinline__ XcdBarrier xcd_barrier_post(unsigned* bar, volatile LAS unsigned* st) {
    XcdBarrier b; b.bar = bar; b.x = xb_xcc_id(); b.st = st;
    if (threadIdx.x == 0) (void)xb_add(&bar[XB_XCNT(b.x)], 1u);
    return b;
}
__device__ __forceinline__ void xcd_barrier_complete(unsigned* bar, unsigned x, unsigned& nloc, unsigned& nx) {
    const unsigned G = gridDim.x * gridDim.y * gridDim.z;
    unsigned sum, cnt, mine, sp = 0u;
    for (;;) {
        sum = 0u; cnt = 0u; mine = 0u;
#pragma unroll
        for (unsigned j = 0; j < 16; ++j) { const unsigned c = xb_ld(&bar[XB_XCNT(j)]); sum += c; cnt += (c > 0u) ? 1u : 0u; mine = (j == x) ? c : mine; }
        if (sum == G) break;
        __builtin_amdgcn_s_sleep(1);
        if ((++sp & 255u) == 0u) { if (xb_ld(&bar[XB_TMO])) break; if (sp > XB_SPIN_CAP) { atomicAdd(&bar[XB_TMO], 1u); break; } }
    }
    nloc = mine > 0u ? mine : 1u; nx = cnt > 0u ? cnt : 1u;
}
__device__ __forceinline__ void xcd_barrier(const XcdBarrier& b) {
    asm volatile("s_waitcnt vmcnt(0)" ::: "memory");
    __syncthreads();
    if (threadIdx.x == 0) {
        unsigned* bar = b.bar;
        __builtin_amdgcn_s_waitcnt(0);
        unsigned nloc = b.st[0], nx = b.st[1];
        if (nloc == 0u) { xcd_barrier_complete(bar, b.x, nloc, nx); b.st[0] = nloc; b.st[1] = nx; }
        const unsigned old = xb_add(&bar[XB_XSUB(b.x)], 1u);
        const unsigned gen = old / nloc;
        if (old + 1u == (gen + 1u) * nloc) {
            __builtin_amdgcn_fence(__ATOMIC_RELEASE, "agent");
            asm volatile("s_waitcnt vmcnt(0)" ::: "memory");
            const unsigned og = xb_add(&bar[XB_TOP], 1u);
            const unsigned tg = og / nx;
            if (og + 1u == (tg + 1u) * nx) xb_add(&bar[XB_TOPGEN], 1u);
            else XB_SPIN(xb_ld(&bar[XB_TOPGEN]) == tg, bar);
            __builtin_amdgcn_fence(__ATOMIC_ACQUIRE, "agent");
            xb_add(&bar[XB_XGEN(b.x)], 1u);
            asm volatile("s_waitcnt vmcnt(0)" ::: "memory");
        } else {
            XB_SPIN(xb_ld(&bar[XB_XGEN(b.x)]) == gen, bar);
            __builtin_amdgcn_fence(__ATOMIC_ACQUIRE, "agent");
            asm volatile("s_waitcnt vmcnt(0)" ::: "memory");
        }
    }
    __syncthreads();
}

namespace pg8 {
constexpr int BM = 256, BK = 64, HALF = 128, HTB = HALF * BK * 2, STAGE_BYTES = 8 * HTB, NXCD = 8, WGM = 4;
__host__ __device__ __forceinline__ int lds_byte(int r, int c) { const int st = (r >> 4) * 2 + (c >> 5), rr = r & 15, cc = c & 31, ob = rr * 64 + cc * 2; return st * 1024 + (ob ^ (((ob >> 9) & 1) << 5)); }
__host__ __device__ __forceinline__ void stage_rc(int b, int& R, int& C) { const int st = b / 1024, sb = b % 1024, swz = sb ^ (((sb >> 9) & 1) << 5); R = (st >> 1) * 16 + swz / 64; C = (st & 1) * 32 + (swz % 64) / 2; }
__host__ __device__ __forceinline__ int perm32(int rho) { const int n = rho >> 4, i = rho & 15; return 8 * (i >> 2) + 4 * n + (i & 3); }
__host__ __device__ __forceinline__ int perm32w(int rho) { const int n = rho >> 4, i = rho & 15; return 16 * ((i >> 2) & 1) + 8 * (i >> 3) + 4 * n + (i & 3); }
template <class E, class = void> struct epi_wide { static constexpr bool value = false; };
template <class E> struct epi_wide<E, decltype((void)E::WIDE)> { static constexpr bool value = E::WIDE; };
template <class E, class = void> struct epi_relax { static constexpr bool value = false; };
template <class E> struct epi_relax<E, decltype((void)E::RELAX)> { static constexpr bool value = E::RELAX; };

struct Unit {
    int pm, pn;
    int kind, e, nrow, aux;
    const char* A;
    const char* B0;
    const char* B1;
    char* dst; int ld;
};
__device__ __forceinline__ bool static_tile(int L, int nM, int nN, int& pm, int& pn, const int WGM = pg8::WGM) {
    const int nwg = nM * nN; if (L >= nwg) return false;
    int wgid = L; { const int q = nwg / NXCD, r = nwg % NXCD, xcd = wgid % NXCD, off = wgid / NXCD; wgid = (xcd < r ? xcd * (q + 1) : r * (q + 1) + (xcd - r) * q) + off; }
    const int nig = WGM * nN, gid = wgid / nig, fm = gid * WGM, gsz = (nM - fm) < WGM ? (nM - fm) : WGM;
    pm = fm + ((wgid % nig) % gsz); pn = (wgid % nig) / gsz; return true;
}

typedef int v8i32 __attribute__((ext_vector_type(8)));
typedef int v4i32 __attribute__((ext_vector_type(4)));
template <bool FP8> struct Frag;
template <> struct Frag<false> { bf16x8 k[2]; };
template <> struct Frag<true> { v8i32 v; };
__device__ __forceinline__ void load_frag(Frag<false>& f, const LAS unsigned char* p) { f.k[0] = *(const LAS bf16x8*)p; f.k[1] = *(const LAS bf16x8*)(p + 1024); }
__device__ __forceinline__ void load_frag(Frag<true>& f, const LAS unsigned char* p) { const v4i32 lo = *(const LAS v4i32*)p, hi = *(const LAS v4i32*)(p + 1024); f.v = __builtin_shufflevector(lo, hi, 0, 1, 2, 3, 4, 5, 6, 7); }
__device__ __forceinline__ void mma_frag(f32x4& c, const Frag<false>& b, const Frag<false>& a) {
    c = __builtin_amdgcn_mfma_f32_16x16x32_bf16(b.k[0], a.k[0], c, 0, 0, 0); c = __builtin_amdgcn_mfma_f32_16x16x32_bf16(b.k[1], a.k[1], c, 0, 0, 0); }
__device__ __forceinline__ void mma_block(f32x4 (&c)[4][2], const Frag<false> (&a)[4], const Frag<false> (&b)[2]) {
#pragma unroll
    for (int m = 0; m < 4; ++m)
#pragma unroll
        for (int n = 0; n < 2; ++n) { c[m][n] = __builtin_amdgcn_mfma_f32_16x16x32_bf16(b[n].k[0], a[m].k[0], c[m][n], 0, 0, 0); c[m][n] = __builtin_amdgcn_mfma_f32_16x16x32_bf16(b[n].k[1], a[m].k[1], c[m][n], 0, 0, 0); }
}
__device__ __forceinline__ void mma_block(f32x4 (&c)[4][2], const Frag<true> (&a)[4], const Frag<true> (&b)[2]) {
#if defined(__HIP_DEVICE_COMPILE__)
    const int sc = 0x7c7c7c7c;
    asm volatile("s_nop 1\n\t"
                 "v_mfma_scale_f32_16x16x128_f8f6f4 %0, %12, %8, %0, %14, %14 op_sel_hi:[0,0,0]\n\t"
                 "v_mfma_scale_f32_16x16x128_f8f6f4 %1, %13, %8, %1, %14, %14 op_sel_hi:[0,0,0]\n\t"
                 "v_mfma_scale_f32_16x16x128_f8f6f4 %2, %12, %9, %2, %14, %14 op_sel_hi:[0,0,0]\n\t"
                 "v_mfma_scale_f32_16x16x128_f8f6f4 %3, %13, %9, %3, %14, %14 op_sel_hi:[0,0,0]\n\t"
                 "v_mfma_scale_f32_16x16x128_f8f6f4 %4, %12, %10, %4, %14, %14 op_sel_hi:[0,0,0]\n\t"
                 "v_mfma_scale_f32_16x16x128_f8f6f4 %5, %13, %10, %5, %14, %14 op_sel_hi:[0,0,0]\n\t"
                 "v_mfma_scale_f32_16x16x128_f8f6f4 %6, %12, %11, %6, %14, %14 op_sel_hi:[0,0,0]\n\t"
                 "v_mfma_scale_f32_16x16x128_f8f6f4 %7, %13, %11, %7, %14, %14 op_sel_hi:[0,0,0]"
                 : "+v"(c[0][0]), "+v"(c[0][1]), "+v"(c[1][0]), "+v"(c[1][1]), "+v"(c[2][0]), "+v"(c[2][1]), "+v"(c[3][0]), "+v"(c[3][1])
                 : "v"(a[0].v), "v"(a[1].v), "v"(a[2].v), "v"(a[3].v), "v"(b[0].v), "v"(b[1].v), "v"(sc));
#endif
}
__device__ __forceinline__ void mma_frag(f32x4& c, const Frag<true>& b, const Frag<true>& a) {
    c = __builtin_amdgcn_mfma_scale_f32_16x16x128_f8f6f4(b.v, a.v, c, 0, 0, 0, 0x79797979, 0, 0x7f7f7f7f); }
struct NoConv { static constexpr int MODE = 0; __device__ __forceinline__ void prime() {} __device__ __forceinline__ void issue() {} __device__ __forceinline__ void reads() {} __device__ __forceinline__ void pack() {} template <int J> __device__ __forceinline__ void store() {} __device__ __forceinline__ void drain() {} };
template <class Epi, class Sched, bool ALIGN_EPI, bool SP2, bool FP8 = false, class Conv = NoConv>
__device__ __forceinline__ void gemm_phase(LAS unsigned char* lds, const int K, const Sched& S, const Epi& E, Conv cv = Conv()) {
    const int tid = threadIdx.x, wid = __builtin_amdgcn_readfirstlane(tid >> 6), lane = tid & 63, wr = wid >> 2, wc = wid & 3, fr = lane & 15, fq = lane >> 4;
    const int nt = FP8 ? K / 128 : K / BK;
    int Rr[2], Cc[2]; unsigned voffB[2];
#pragma unroll
    for (int i = 0; i < 2; ++i) { stage_rc(tid * 16 + i * 8192, Rr[i], Cc[i]); const int Rb = Epi::PERM ? ((Rr[i] & ~31) + (epi_wide<Epi>::value ? perm32w(Rr[i] & 31) : perm32(Rr[i] & 31))) : Rr[i]; voffB[i] = FP8 ? (unsigned)(Rb * K) + (unsigned)Cc[i] * 2u : (unsigned)(Rb * K + Cc[i]) * 2u; }
    const size_t kstep = (size_t)(BK * 2);
    const unsigned ldsw = (unsigned)wid * 1024u;
    const int aoff = lds_byte(wr * 64 + fr, fq * 8), boff = lds_byte(wc * 32 + fr, fq * 8);
#define PG8_SA(b, h) (((b) * 2 + (h)) * HTB)
#define PG8_SB(b, h) ((4 + (b) * 2 + (h)) * HTB)
#define PG8_STAGE(bufoff, gbase, voff) do { _Pragma("unroll") for (int _i = 0; _i < 2; ++_i) \
        __builtin_amdgcn_global_load_lds((const unsigned*)((const char*)(gbase) + (voff)[_i]), (LAS unsigned*)(lds + (bufoff) + ldsw + _i * 8192), 16, 0, 0); } while (0)
#define PG8_LDA(dst, b, h) do { _Pragma("unroll") for (int m = 0; m < 4; ++m) load_frag(dst[m], lds + PG8_SA(b, h) + aoff + m * 2048); } while (0)
#define PG8_LDB(dst, b, h) do { _Pragma("unroll") for (int n = 0; n < 2; ++n) load_frag(dst[n], lds + PG8_SB(b, h) + boff + n * 2048); } while (0)
#define PG8_MMA(ai, bj, At, Bt) do { __builtin_amdgcn_s_setprio(1); mma_block(acc[ai][bj], At, Bt); __builtin_amdgcn_s_setprio(0); } while (0)
#define PG8_WAIT_V(n) asm volatile("s_waitcnt vmcnt(" #n ")" ::: "memory")
#define PG8_WAIT_L(n) asm volatile("s_waitcnt lgkmcnt(" #n ")" ::: "memory")
#define PG8_WAIT_K() do { if constexpr (Conv::MODE == 0) PG8_WAIT_V(8); else if constexpr (Conv::MODE == 1) PG8_WAIT_V(9); else PG8_WAIT_V(10); } while (0)
#define PG8_BAR __builtin_amdgcn_s_barrier()
#define PG8_SCHED __builtin_amdgcn_sched_barrier(0)
    constexpr bool GATHER = Sched::AROW_LOADS;
    constexpr bool RELAX = SP2 && Conv::MODE == 0 && epi_relax<Epi>::value;
#define PG8_AOFFS(dst, u) do { if constexpr (GATHER) { _Pragma("unroll") for (int _h = 0; _h < 2; ++_h) _Pragma("unroll") for (int _i = 0; _i < 2; ++_i) dst[_h][_i] = S.arow(u, _h * HALF + Rr[_i]) + (unsigned)Cc[_i] * 2u; \
        asm volatile("" : "+v"(dst[0][0]), "+v"(dst[0][1]), "+v"(dst[1][0]), "+v"(dst[1][1])); } } while (0)
#define PG8_STAGE_A(bufoff, gbase, h, offs) do { if constexpr (GATHER) { PG8_STAGE(bufoff, gbase, (offs)[h]); } else { PG8_STAGE(bufoff, (gbase) + (h) * hstepA, voffA); } } while (0)
    int ui = 0;
    Unit cur;
    if (!S.next(0, cur)) return;
    f32x4 acc[2][2][4][2];
#pragma unroll
    for (int a = 0; a < 2; ++a)
#pragma unroll
        for (int b = 0; b < 2; ++b)
#pragma unroll
            for (int m = 0; m < 4; ++m)
#pragma unroll
                for (int n = 0; n < 2; ++n) acc[a][b][m][n] = (f32x4){0.f, 0.f, 0.f, 0.f};
    Frag<FP8> At[4], B0[2], B1[2];
    unsigned oA[2][2], oAn[2][2], voffA[2];
    const size_t hstepA = GATHER ? 0 : (size_t)S.hstepA();
#pragma unroll
    for (int i = 0; i < 2; ++i) { voffA[i] = GATHER ? 0u : S.arow(cur, Rr[i]) + (unsigned)Cc[i] * 2u; oA[0][i] = oA[1][i] = oAn[0][i] = oAn[1][i] = 0u; }
    PG8_AOFFS(oA, cur);
    const char* cA = cur.A; const char* cB0 = cur.B0; const char* cB1 = cur.B1;
    cv.prime();
    if constexpr (SP2) {
        PG8_STAGE(PG8_SB(0, 0), cB0, voffB); PG8_STAGE(PG8_SB(0, 1), cB1, voffB); PG8_STAGE_A(PG8_SA(0, 0), cA, 0, oA); PG8_STAGE_A(PG8_SA(0, 1), cA, 1, oA);
        if (wr == 1) PG8_BAR;
        PG8_WAIT_V(2); PG8_BAR;
        PG8_STAGE(PG8_SB(1, 0), cB0 + kstep, voffB); PG8_STAGE_A(PG8_SA(1, 0), cA + kstep, 0, oA); PG8_STAGE(PG8_SB(1, 1), cB1 + kstep, voffB);
        PG8_WAIT_V(6); PG8_BAR;
    } else {
        PG8_STAGE(PG8_SB(0, 0), cB0, voffB); PG8_STAGE_A(PG8_SA(0, 0), cA, 0, oA); PG8_STAGE(PG8_SB(0, 1), cB1, voffB); PG8_STAGE_A(PG8_SA(0, 1), cA, 1, oA);
        if (wr == 1) PG8_BAR;
        PG8_WAIT_V(4); PG8_BAR;
        PG8_STAGE(PG8_SB(1, 0), cB0 + kstep, voffB); PG8_STAGE_A(PG8_SA(1, 0), cA + kstep, 0, oA); PG8_STAGE(PG8_SB(1, 1), cB1 + kstep, voffB);
        PG8_WAIT_V(6); PG8_BAR;
    }
    for (;;) {
        bool has_next = false; const char* nA = cA; const char* nB0 = cB0; const char* nB1 = cB1;
#define PG8_NEXT_UNIT() do { if (t == 0) { Unit nxt; has_next = S.next(ui + 1, nxt); if (has_next) { nA = nxt.A; nB0 = nxt.B0; nB1 = nxt.B1; PG8_AOFFS(oAn, nxt); } else { \
            _Pragma("unroll") for (int _h = 0; _h < 2; ++_h) _Pragma("unroll") for (int _i = 0; _i < 2; ++_i) oAn[_h][_i] = oA[_h][_i]; } } } while (0)
        { const int t = 0; PG8_NEXT_UNIT(); }
        for (int t = 0; t < nt; t += 2) {
            const bool last = (t == nt - 2);
            const char* a1 = cA + (size_t)(t + 1) * kstep;
            const char* a2 = last ? nA : cA + (size_t)(t + 2) * kstep;
            const char* b20 = last ? nB0 : cB0 + (size_t)(t + 2) * kstep; const char* b21 = last ? nB1 : cB1 + (size_t)(t + 2) * kstep;
            const char* a3 = a2 + kstep; const char* b30 = b20 + kstep; const char* b31 = b21 + kstep;
            unsigned s2[2][2];
#pragma unroll
            for (int h = 0; h < 2; ++h)
#pragma unroll
                for (int i = 0; i < 2; ++i) s2[h][i] = last ? oAn[h][i] : oA[h][i];
            if constexpr (SP2) {
            const bool relaxed = RELAX && ui > 0 && t == 0;
            cv.issue(); PG8_LDB(B0, 0, 0); PG8_LDB(B1, 0, 1); PG8_SCHED; PG8_LDA(At, 0, 0); if (!relaxed) PG8_STAGE_A(PG8_SA(1, 1), a1, 1, oA); cv.reads();
            if (!relaxed) PG8_WAIT_K(); PG8_WAIT_L(0); PG8_BAR; PG8_MMA(0, 0, At, B0); PG8_MMA(0, 1, At, B1); cv.template store<0>(); PG8_BAR; PG8_SCHED;
            cv.issue(); PG8_LDA(At, 0, 1); PG8_STAGE(PG8_SB(0, 0), b20, voffB); PG8_STAGE(PG8_SB(0, 1), b21, voffB); PG8_STAGE_A(PG8_SA(0, 0), a2, 0, s2); cv.reads();
            if (!relaxed) PG8_WAIT_K(); PG8_WAIT_L(0); PG8_BAR; PG8_MMA(1, 0, At, B0); PG8_MMA(1, 1, At, B1); cv.template store<1>(); PG8_BAR; PG8_SCHED;
            cv.issue(); PG8_LDB(B0, 1, 0); PG8_LDB(B1, 1, 1); PG8_SCHED; PG8_LDA(At, 1, 0); PG8_STAGE_A(PG8_SA(0, 1), a2, 1, s2); cv.reads();
            if (!relaxed) PG8_WAIT_K(); PG8_WAIT_L(0); PG8_BAR; PG8_MMA(0, 0, At, B0); PG8_MMA(0, 1, At, B1); cv.template store<2>(); PG8_BAR; PG8_SCHED;
            cv.issue(); PG8_LDA(At, 1, 1); PG8_STAGE(PG8_SB(1, 0), b30, voffB); PG8_STAGE(PG8_SB(1, 1), b31, voffB); PG8_STAGE_A(PG8_SA(1, 0), a3, 0, s2); cv.reads();
            PG8_WAIT_K(); PG8_WAIT_L(0); PG8_BAR; PG8_MMA(1, 0, At, B0); PG8_MMA(1, 1, At, B1); cv.template store<3>(); PG8_BAR; PG8_SCHED;
            } else {
            PG8_LDB(B0, 0, 0); PG8_SCHED; PG8_LDA(At, 0, 0); PG8_STAGE_A(PG8_SA(1, 1), a1, 1, oA);
            PG8_WAIT_L(8); PG8_BAR; PG8_WAIT_L(0); PG8_MMA(0, 0, At, B0); PG8_BAR; PG8_SCHED;
            PG8_LDB(B1, 0, 1); PG8_STAGE(PG8_SB(0, 0), b20, voffB);
            PG8_BAR; PG8_WAIT_L(0); PG8_MMA(0, 1, At, B1); PG8_BAR;
            PG8_LDA(At, 0, 1); PG8_STAGE_A(PG8_SA(0, 0), a2, 0, s2);
            PG8_BAR; PG8_WAIT_L(0); PG8_MMA(1, 0, At, B0); PG8_BAR; PG8_SCHED;
            PG8_STAGE(PG8_SB(0, 1), b21, voffB);
            PG8_WAIT_V(6); PG8_BAR; PG8_MMA(1, 1, At, B1); PG8_BAR;
            PG8_LDB(B0, 1, 0); PG8_SCHED; PG8_LDA(At, 1, 0); PG8_STAGE_A(PG8_SA(0, 1), a2, 1, s2);
            PG8_WAIT_L(8); PG8_BAR; PG8_WAIT_L(0); PG8_MMA(0, 0, At, B0); PG8_BAR; PG8_SCHED;
            PG8_LDB(B1, 1, 1); PG8_STAGE(PG8_SB(1, 0), b30, voffB);
            PG8_BAR; PG8_WAIT_L(0); PG8_MMA(0, 1, At, B1); PG8_BAR;
            PG8_LDA(At, 1, 1); PG8_STAGE_A(PG8_SA(1, 0), a3, 0, s2);
            PG8_BAR; PG8_WAIT_L(0); PG8_MMA(1, 0, At, B0); PG8_BAR; PG8_SCHED;
            PG8_STAGE(PG8_SB(1, 1), b31, voffB);
            PG8_WAIT_V(6); PG8_BAR; PG8_MMA(1, 1, At, B1); PG8_BAR;
            }
        }
        if constexpr (RELAX) { if (has_next) PG8_STAGE_A(PG8_SA(1, 1), nA + kstep, 1, oAn); }
        if constexpr (ALIGN_EPI) { if (wr == 0) PG8_BAR; }
        if constexpr (FP8) asm volatile("s_nop 15\n\ts_nop 7" ::: "memory");
        bool chained = false;
        { Unit eu; (void)S.next(ui, eu);
          if constexpr (Epi::CHAIN) { if (eu.kind == 0) { E.mid(acc, eu, wr, wc, fr, fq); chained = true; } else E(acc, eu, wr, wc, fr, fq); }
          else E(acc, eu, wr, wc, fr, fq); }
        if (!has_next) break;
        if (!chained) {
#pragma unroll
        for (int a = 0; a < 2; ++a)
#pragma unroll
            for (int b = 0; b < 2; ++b)
#pragma unroll
                for (int m = 0; m < 4; ++m)
#pragma unroll
                    for (int n = 0; n < 2; ++n) acc[a][b][m][n] = (f32x4){0.f, 0.f, 0.f, 0.f};
        }
        cA = nA; cB0 = nB0; cB1 = nB1; ++ui;
#pragma unroll
        for (int h = 0; h < 2; ++h)
#pragma unroll
            for (int i = 0; i < 2; ++i) oA[h][i] = oAn[h][i];
        if constexpr (ALIGN_EPI) { if (wr == 1) PG8_BAR; }
    }
    PG8_WAIT_V(0);
    if constexpr (!ALIGN_EPI) { if (wr == 0) PG8_BAR; }
    PG8_BAR;
    cv.drain();
#undef PG8_SA
#undef PG8_SB
#undef PG8_STAGE
#undef PG8_LDA
#undef PG8_LDB
#undef PG8_MMA
#undef PG8_WAIT_V
#undef PG8_WAIT_L
#undef PG8_WAIT_K
#undef PG8_BAR
#undef PG8_SCHED
#undef PG8_AOFFS
#undef PG8_NEXT_UNIT
#undef PG8_STAGE_A
}
}
using pg8::Unit;

struct Args { const float* in[18]; float* out; unsigned char* ws; int ph_lo, ph_hi; };
struct Frame {
    LAS unsigned char* lds;
    int tid, lane, wave, vcu, G;
    const float *x, *meta, *g_mix, *w_in, *conv_w, *w_conv_out, *w_attn_out, *w_o, *g_ffn, *w_router, *b_router, *w_gate, *b_gate, *w_up, *b_up, *w_down, *b_down, *g_final;
    float* out; unsigned char* ws; unsigned* ctl;
};
#define WSP(T, off) ((T*)(F.ws + (off)))

__device__ __forceinline__ void p0_item_load(const float* W, int N, int item, int lane, f32x4 (&v)[8], int ldn = 0) {
    const int nblk = N / 32, kb = item / nblk, nb = item % nblk, k0 = 64 * kb, n0 = 32 * nb; const int ld = ldn ? ldn : N;
#pragma unroll
    for (int i = 0; i < 8; ++i) { const int p = 64 * i + lane; v[i] = *(const GAS f32x4*)(W + (size_t)(k0 + (p >> 3)) * ld + n0 + 4 * (p & 7)); }
}
__device__ __forceinline__ void p0_item_finish(const f32x4 (&v)[8], int K, int N, bf16* WT, LAS float* scr, int item, int lane) {
    const int nblk = N / 32, kb = item / nblk, nb = item % nblk, k0 = 64 * kb, n0 = 32 * nb;
#pragma unroll
    for (int i = 0; i < 8; ++i) { const int p = 64 * i + lane; LAS float* d = scr + (p >> 3) * 33 + 4 * (p & 7); d[0] = v[i][0]; d[1] = v[i][1]; d[2] = v[i][2]; d[3] = v[i][3]; }
    LDS_WAIT(); asm volatile("" ::: "memory");
    const int c = lane & 7;
#pragma unroll
    for (int j = 0; j < 4; ++j) { const int n = (lane >> 3) + 8 * j; const LAS float* s = scr + (8 * c) * 33 + n;
        u32x4 o; o.x = pk2(s[0 * 33], s[1 * 33]); o.y = pk2(s[2 * 33], s[3 * 33]); o.z = pk2(s[4 * 33], s[5 * 33]); o.w = pk2(s[6 * 33], s[7 * 33]);
        *(GAS u32x4*)(WT + (size_t)(n0 + n) * K + k0 + 8 * c) = o; }
    LDS_WAIT(); asm volatile("" ::: "memory");
}
__device__ __forceinline__ void p0_item_finish_fp8(const f32x4 (&v)[8], int K, int N, unsigned char* WT8, LAS float* scr, int item, int lane) {
    const int nblk = N / 32, kb = item / nblk, nb = item % nblk, k0 = 64 * kb, n0 = 32 * nb;
#pragma unroll
    for (int i = 0; i < 8; ++i) { const int p = 64 * i + lane; LAS float* d = scr + (p >> 3) * 33 + 4 * (p & 7); d[0] = v[i][0]; d[1] = v[i][1]; d[2] = v[i][2]; d[3] = v[i][3]; }
    LDS_WAIT(); asm volatile("" ::: "memory");
    const int c = lane & 3;
#pragma unroll
    for (int j = 0; j < 2; ++j) { const int n = (lane >> 2) + 16 * j; const LAS float* s = scr + (16 * c) * 33 + n;
        u32x4 o;
        o.x = cvt4_fp8(64.f * s[0 * 33], 64.f * s[1 * 33], 64.f * s[2 * 33], 64.f * s[3 * 33]);   o.y = cvt4_fp8(64.f * s[4 * 33], 64.f * s[5 * 33], 64.f * s[6 * 33], 64.f * s[7 * 33]);
        o.z = cvt4_fp8(64.f * s[8 * 33], 64.f * s[9 * 33], 64.f * s[10 * 33], 64.f * s[11 * 33]); o.w = cvt4_fp8(64.f * s[12 * 33], 64.f * s[13 * 33], 64.f * s[14 * 33], 64.f * s[15 * 33]);
        *(GAS u32x4*)(WT8 + (size_t)(n0 + n) * K + k0 + 16 * c) = o; }
    LDS_WAIT(); asm volatile("" ::: "memory");
}
__device__ __forceinline__ void p0_transpose_item(const float* W, int K, int N, bf16* WT, int row_off, LAS float* scr, int item, int lane) {
    f32x4 v[8]; p0_item_load(W, N, item, lane, v); p0_item_finish(v, K, N, WT + (size_t)row_off * K, scr, item, lane);
}
template <bool FP8>
__device__ __forceinline__ void p0_transpose_stream(const float* W, bf16* WT, int K, int N, int nmat, int gw, int NGW, LAS float* scr, int lane, int ldn = 0) {
    const int ipm = (K / 64) * (N / 32), total = nmat * ipm; const size_t msz = (size_t)K * N;
    for (int it = gw; it < total; it += 3 * NGW) {
        const int i1 = it + NGW, i2 = it + 2 * NGW;
        f32x4 va[8], vb[8], vc[8];
        p0_item_load(W + (size_t)(it / ipm) * msz, N, it % ipm, lane, va, ldn);
        if (i1 < total) p0_item_load(W + (size_t)(i1 / ipm) * msz, N, i1 % ipm, lane, vb, ldn);
        if (i2 < total) p0_item_load(W + (size_t)(i2 / ipm) * msz, N, i2 % ipm, lane, vc, ldn);
        if constexpr (FP8) p0_item_finish_fp8(va, K, N, (unsigned char*)WT + (size_t)(it / ipm) * msz, scr, it % ipm, lane); else p0_item_finish(va, K, N, WT + (size_t)(it / ipm) * msz, scr, it % ipm, lane);
        if (i1 < total) { if constexpr (FP8) p0_item_finish_fp8(vb, K, N, (unsigned char*)WT + (size_t)(i1 / ipm) * msz, scr, i1 % ipm, lane); else p0_item_finish(vb, K, N, WT + (size_t)(i1 / ipm) * msz, scr, i1 % ipm, lane); }
        if (i2 < total) { if constexpr (FP8) p0_item_finish_fp8(vc, K, N, (unsigned char*)WT + (size_t)(i2 / ipm) * msz, scr, i2 % ipm, lane); else p0_item_finish(vc, K, N, WT + (size_t)(i2 / ipm) * msz, scr, i2 % ipm, lane); }
    }
}
__device__ __forceinline__ void rms_row_to_bf16(const float* xrow, const float* g, bf16* orow, int lane, unsigned char* orow8 = nullptr, bf16* xbrow = nullptr) {
    const GAS f32x4* xr = (const GAS f32x4*)xrow + lane; const GAS f32x4* gr = (const GAS f32x4*)g + lane;
    f32x4 v[8]; float s = 0.f;
#pragma unroll
    for (int j = 0; j < 8; ++j) { v[j] = xr[64 * j]; s += (v[j].x * v[j].x + v[j].y * v[j].y) + (v[j].z * v[j].z + v[j].w * v[j].w); }
    if (xbrow) { GAS u32x2* xb8 = (GAS u32x2*)xbrow + lane;
#pragma unroll
        for (int j = 0; j < 8; ++j) { u32x2 w; w.x = pk2(v[j].x, v[j].y); w.y = pk2(v[j].z, v[j].w); xb8[64 * j] = w; } }
    const float rstd = rsqrtf(wave_sum(s) * (1.f / D) + EPS);
    GAS u32x2* o8 = (GAS u32x2*)orow + lane;
#pragma unroll
    for (int j = 0; j < 8; ++j) { const f32x4 gg = gr[64 * j]; const f32x4 y = {v[j].x * rstd * gg.x, v[j].y * rstd * gg.y, v[j].z * rstd * gg.z, v[j].w * rstd * gg.w};
        u32x2 w; w.x = pk2(y.x, y.y); w.y = pk2(y.z, y.w); o8[64 * j] = w;
        if (orow8) ((GAS unsigned*)orow8)[lane + 64 * j] = cvt4_fp8(y.x, y.y, y.z, y.w); }
}
__device__ __forceinline__ void p0_prologue(Frame& F, bool ride) {
    LAS float* scr = (LAS float*)(F.lds + F.wave * 16384);
    const int gw = F.vcu * 8 + F.wave, NGW = F.G * 8;
    if (!ride) {
    p0_transpose_stream<true>(F.w_gate, WSP(bf16, WS_WG), D, DFF, NE, gw, NGW, scr, F.lane);
    p0_transpose_stream<true>(F.w_up, WSP(bf16, WS_WU), D, DFF, NE, gw, NGW, scr, F.lane);
    p0_transpose_stream<true>(F.w_down, WSP(bf16, WS_WD), DFF, D, NE, gw, NGW, scr, F.lane);
    }
    p0_transpose_stream<false>(F.w_in, WSP(bf16, WS_WIN), D, O_GC, 1, gw, NGW, scr, F.lane, INW);
    p0_transpose_stream<true>(F.w_in + O_GC, WSP(bf16, WS_WIN8), D, INW - O_GC, 1, gw, NGW, scr, F.lane, INW);
    p0_transpose_stream<false>(F.w_conv_out, WSP(bf16, WS_WCONV), CC, D, 1, gw, NGW, scr, F.lane);
    p0_transpose_stream<false>(F.w_attn_out, WSP(bf16, WS_WATTN), AW, D, 1, gw, NGW, scr, F.lane);
    p0_transpose_stream<false>(F.w_o, WSP(bf16, WS_WO), D, D, 1, gw, NGW, scr, F.lane);
#ifdef PROBE_STREAM
    {
        f32x4 acc4 = {0.f, 0.f, 0.f, 0.f};
        const size_t n4 = (size_t)NE * D * DFF / 4;
        for (int w3 = 0; w3 < 3; ++w3) { const GAS f32x4* p = (const GAS f32x4*)(w3 == 0 ? F.w_gate : w3 == 1 ? F.w_up : F.w_down);
            for (size_t i = (size_t)gw * 64 + F.lane; i < n4; i += (size_t)NGW * 64 * 32) {
#pragma unroll
                for (int u = 0; u < 32; ++u) { const size_t j = i + (size_t)u * NGW * 64; if (j < n4) acc4 += p[j]; } } }
        if (acc4[0] + acc4[1] + acc4[2] + acc4[3] == 123456.789f) WSP(float, WS_HM)[1024 * 1024 / 4 - 1] = 1.f;
    }
#endif
    for (int m = gw; m < MR; m += NGW) rms_row_to_bf16(F.x + (size_t)m * D, F.g_mix, WSP(bf16, WS_HN) + (size_t)m * D, F.lane, WSP(unsigned char, WS_HN8) + (size_t)m * D, WSP(bf16, WS_XB) + (size_t)m * D);
    if (gw < NMETA) rms_row_to_bf16(F.meta + (size_t)gw * D, F.g_mix, WSP(bf16, WS_HM) + (size_t)gw * D, F.lane);
    for (int c = blockIdx.x * 512 + F.tid; c < 64 * 2 * 64; c += F.G * 512) {
        const int ln = c & 63, eb = (c >> 6) & 1, ks = c >> 7; const float* w = F.w_router + (size_t)(32 * ks + 8 * (ln >> 4)) * NE + 16 * eb + (ln & 15);
        u32x4 o; o.x = pk2(w[0], w[NE]); o.y = pk2(w[2 * NE], w[3 * NE]); o.z = pk2(w[4 * NE], w[5 * NE]); o.w = pk2(w[6 * NE], w[7 * NE]);
        *(WSP(u32x4, WS_WRF) + c) = o;
    }
}

template <class S> __device__ __forceinline__ void build_units(const S& sch, LAS int* ut) {
    const int lt = (int)__builtin_amdgcn_mbcnt_hi(~0u, __builtin_amdgcn_mbcnt_lo(~0u, 0u));
    if (__builtin_amdgcn_readfirstlane((int)threadIdx.x) < 64) { int f[8]; f[7] = 0; sch.coords(lt, f);
#pragma unroll
        for (int k = 0; k < 8; ++k) ut[8 * lt + k] = f[k]; }
    __syncthreads();
}
__device__ __forceinline__ bool read_unit(const LAS int* ut, int i, Unit& u) {
    if (i >= 64) return false;
    const LAS int* p = ut + 8 * i;
    if (__builtin_amdgcn_readfirstlane(p[0]) == 0) return false;
    u.pm = __builtin_amdgcn_readfirstlane(p[1]); u.pn = __builtin_amdgcn_readfirstlane(p[2]); u.kind = __builtin_amdgcn_readfirstlane(p[3]);
    u.e = __builtin_amdgcn_readfirstlane(p[4]); u.aux = __builtin_amdgcn_readfirstlane(p[5]); u.nrow = __builtin_amdgcn_readfirstlane(p[6]);
    return true;
}

template <int NB>
struct ConvW {
    static_assert(NB == 8, "one batch size");
    static constexpr int MODE = 1;
    const float* wg; const float* wu; const float* wd; unsigned char* w8; LAS unsigned char* ring; int gw, s_iss, s_con, s_end; unsigned voff, rdoff, dstoff; float x[4]; unsigned d[NB];
    __device__ __forceinline__ void one() {
        const int strip = (s_iss >> 7) * 2048 + gw, kg = s_iss & 127, mat = strip >> 7, nb = strip & 127;
        const float* W = (mat < 32 ? wg : mat < 64 ? wu : wd) + (size_t)(mat & 31) * D * DFF;
        const char* src = (const char*)W + (size_t)kg * (16 * 8192) + nb * 64;
        __builtin_amdgcn_global_load_lds((const unsigned*)(src + voff), (LAS unsigned*)(ring + (s_iss % 3) * 1024), 16, 0, 0);
        ++s_iss;
    }
    __device__ __forceinline__ void prime() { if (s_iss < s_end) one(); if (s_iss < s_end) one(); }
    __device__ __forceinline__ void issue() { if (s_iss < s_end) one(); }
    __device__ __forceinline__ void reads() { if (s_con < s_end) { const LAS float* p = (const LAS float*)(ring + (s_con % 3) * 1024 + rdoff); x[0] = p[0]; x[1] = p[16]; x[2] = p[32]; x[3] = p[48]; } }
    template <int J> __device__ __forceinline__ void store() { if (s_con < s_end) {
        const unsigned v = cvt4_fp8(64.f * x[0], 64.f * x[1], 64.f * x[2], 64.f * x[3]);
        const bool par = (s_con >> 2) & 1;
        if (par) d[4 + J] = v; else d[J] = v;
        if (J == 3 && par) {
            const int s0 = s_con - 7, strip = (s0 >> 7) * 2048 + gw, kg = s0 & 127, mat = strip >> 7, nb = strip & 127;
            unsigned char* dst = w8 + (size_t)(mat >> 5) * (256 * MiB) + (size_t)(mat & 31) * D * DFF + (size_t)nb * 16 * 2048 + kg * 16;
            const auto a0 = __builtin_amdgcn_permlane32_swap(d[0], d[2], false, false), a1 = __builtin_amdgcn_permlane32_swap(d[1], d[3], false, false);
            const auto a2 = __builtin_amdgcn_permlane32_swap(d[4], d[6], false, false), a3 = __builtin_amdgcn_permlane32_swap(d[5], d[7], false, false);
            const auto va0 = __builtin_amdgcn_permlane16_swap(a0[0], a1[0], false, false), vb0 = __builtin_amdgcn_permlane16_swap(a0[1], a1[1], false, false);
            const auto va1 = __builtin_amdgcn_permlane16_swap(a2[0], a3[0], false, false), vb1 = __builtin_amdgcn_permlane16_swap(a2[1], a3[1], false, false);
            u32x4 o0, o1; o0.x = va0[0]; o0.y = va0[1]; o0.z = vb0[0]; o0.w = vb0[1]; o1.x = va1[0]; o1.y = va1[1]; o1.z = vb1[0]; o1.w = vb1[1];
            *(GAS u32x4*)(dst + dstoff) = o0; *(GAS u32x4*)(dst + dstoff + 64) = o1; }
        ++s_con; } }
    __device__ __forceinline__ void drain() {}
};

struct ConvProbe {
    static constexpr int MODE = 1;
    const float* wg; const float* wu; const float* wd; LAS unsigned char* ring; int gw; unsigned voff; int s;
    __device__ __forceinline__ void one() {
        const int strip = gw * 3 + (s >> 8), kg = s & 255, mat = strip >> 6, nb = strip & 63;
        const float* W = (mat < 32 ? wg : mat < 64 ? wu : wd) + (size_t)(mat & 31) * D * DFF;
        const char* src = (const char*)W + (size_t)kg * 65536 + nb * 128;
        __builtin_amdgcn_global_load_lds((const unsigned*)(src + voff), (LAS unsigned*)(ring + (s % 3) * 1024), 16, 0, 0);
        ++s;
    }
    __device__ __forceinline__ void prime() { one(); one(); }
    __device__ __forceinline__ void issue() { if (s < 768) one(); else { const char* src = (const char*)wg; __builtin_amdgcn_global_load_lds((const unsigned*)(src + voff), (LAS unsigned*)(ring + (s % 3) * 1024), 16, 0, 0); ++s; } }
    __device__ __forceinline__ void reads() {} __device__ __forceinline__ void pack() {} template <int J> __device__ __forceinline__ void store() {} __device__ __forceinline__ void drain() {}
};

__device__ __forceinline__ void p1_meta(Frame& F) {
    const int fr = F.lane & 15, fq = F.lane >> 4;
    LAS f32x4* part = (LAS f32x4*)F.lds;
    for (int j = blockIdx.x; j < 192; j += F.G) {
        const int cb = j & 63, sp = j >> 6;
        const int c0 = 16 * cb;
        const bf16* hm = WSP(bf16, WS_HM) + (size_t)fr * D + 8 * fq + 256 * F.wave;
        const bf16* w0 = WSP(bf16, WS_WIN) + (size_t)((sp == 0 ? O_U : sp == 1 ? O_K : O_V) + c0 + fr) * D + 8 * fq + 256 * F.wave;
        const bf16* w1 = WSP(bf16, WS_WIN) + (size_t)(O_C + c0 + fr) * D + 8 * fq + 256 * F.wave;
        f32x4 a0 = {0.f, 0.f, 0.f, 0.f}, a1 = {0.f, 0.f, 0.f, 0.f};
        const bf16* w1p = sp == 0 ? w1 : w0;
        bf16x8 af[8], b0[8], b1[8];
#pragma unroll
        for (int s = 0; s < 8; ++s) { af[s] = *(const bf16x8*)(hm + 32 * s); b0[s] = *(const bf16x8*)(w0 + 32 * s); b1[s] = *(const bf16x8*)(w1p + 32 * s); }
#pragma unroll
        for (int s = 0; s < 8; ++s) { a0 = __builtin_amdgcn_mfma_f32_16x16x32_bf16(af[s], b0[s], a0, 0, 0, 0); a1 = __builtin_amdgcn_mfma_f32_16x16x32_bf16(af[s], b1[s], a1, 0, 0, 0); }
        part[(F.wave * 2 + 0) * 64 + F.lane] = a0; part[(F.wave * 2 + 1) * 64 + F.lane] = a1;
        __syncthreads();
        if (F.wave == 0) {
            a0 = part[F.lane]; a1 = part[64 + F.lane];
#pragma unroll
            for (int w = 1; w < 8; ++w) { a0 += part[(w * 2 + 0) * 64 + F.lane]; a1 += part[(w * 2 + 1) * 64 + F.lane]; }
            bf16* dst = WSP(bf16, sp == 0 ? WS_CU : sp == 1 ? WS_K : WS_V);
#pragma unroll
            for (int jj = 0; jj < 4; ++jj) { const int tok = 4 * fq + jj; const float v = sp == 0 ? a0[jj] * a1[jj] : a0[jj];
#pragma unroll
                for (int b = 0; b < BATCH; ++b) dst[(size_t)(b * LTOT + tok) * 1024 + c0 + fr] = (bf16)f2bf(v); }
        }
        __syncthreads();
    }
}
struct Sched1 {
    static constexpr bool AROW_LOADS = false;
    int G, c; unsigned char* ws; const LAS int* ut;
    __device__ __forceinline__ void coords(int i, int (&f)[8]) const { int pm = 0, pn = 0; f[0] = pg8::static_tile(i * G + c, MR / 256, 24, pm, pn) ? 1 : 0; f[1] = pm; f[2] = pn; f[3] = 0; f[4] = 0; f[5] = 0; f[6] = 256; }
    __device__ __forceinline__ bool next(int i, Unit& u) const {
        if (!read_unit(ut, i, u)) return false;
        const char* W = (const char*)(ws + WS_WIN);
        u.A = (const char*)(ws + WS_HN) + (size_t)u.pm * 256 * D * 2; u.e = 0; u.nrow = 256; u.aux = 0;
        if (u.pn < 8) { u.kind = 0; u.B0 = W + (size_t)(O_U + 128 * u.pn) * D * 2; u.B1 = W + (size_t)(O_C + 128 * u.pn) * D * 2; u.dst = (char*)(ws + WS_CU) + 256 * u.pn; u.ld = 1024; u.aux = 1; }
        else {
            const int col0 = u.pn < 12 ? O_B + (u.pn - 8) * 256 : O_Q + (u.pn - 12) * 256;
            u.B0 = W + (size_t)col0 * D * 2; u.B1 = u.B0 + (size_t)128 * D * 2; u.kind = 1;
            if (col0 < O_C) { u.dst = (char*)(ws + WS_BP) + (col0 - O_B) * 2; u.ld = 1024; }
            else if (col0 < O_K) { u.dst = (char*)(ws + WS_Q) + (col0 - O_Q) * 2; u.ld = 1024; u.kind = 2; }
            else if (col0 < O_V) { u.dst = (char*)(ws + WS_K) + (col0 - O_K) * 2; u.ld = 1024; u.aux = 1; }
            else if (col0 < O_GC) { u.dst = (char*)(ws + WS_V) + (col0 - O_V) * 2; u.ld = 1024; u.aux = 1; }
            else if (col0 < O_GA) { u.dst = (char*)(ws + WS_GC) + (col0 - O_GC) * 2; u.ld = 2048; }
            else { u.dst = (char*)(ws + WS_GA) + (col0 - O_GA) * 2; u.ld = 2048; }
        }
        return true;
    }
    __device__ __forceinline__ unsigned arow(const Unit&, int r) const { return (unsigned)r * (unsigned)(D * 2); }
    __device__ __forceinline__ unsigned hstepA() const { return 128u * D * 2u; }
};
struct Sched1g {
    static constexpr bool AROW_LOADS = false;
    int G, c; unsigned char* ws; const LAS int* ut;
    __device__ __forceinline__ void coords(int i, int (&f)[8]) const { int pm = 0, pn = 0; f[0] = pg8::static_tile(i * G + c, MR / 256, 16, pm, pn) ? 1 : 0; f[1] = pm; f[2] = pn; f[3] = 1; f[4] = 0; f[5] = 0; f[6] = 256; }
    __device__ __forceinline__ bool next(int i, Unit& u) const {
        if (!read_unit(ut, i, u)) return false;
        u.A = (const char*)(ws + WS_HN8) + (size_t)u.pm * 256 * D; u.e = 0; u.nrow = 256; u.aux = 0; u.kind = 1;
        u.B0 = (const char*)(ws + WS_WIN8) + (size_t)(128 * u.pn) * D; u.B1 = u.B0 + (size_t)2048 * D;
        u.dst = (char*)(ws + WS_GC) + (size_t)(128 * u.pn) * 2; u.ld = 2048;
        return true;
    }
    __device__ __forceinline__ unsigned arow(const Unit&, int r) const { return (unsigned)r * (unsigned)D; }
    __device__ __forceinline__ unsigned hstepA() const { return 128u * D; }
};
struct Epi1 {
    static constexpr bool PERM = true; static constexpr bool CHAIN = false;
    __device__ __forceinline__ void operator()(const f32x4 (&acc)[2][2][4][2], const Unit& u, int wr, int wc, int fr, int fq) const {
        const int m0 = u.pm * 256 + wr * 64 + fr; const int radd = u.aux ? NMETA * (m0 / SEQ + 1) : 0;
        const float sc = u.kind == 2 ? 0.08838834764831845f : 1.f;
#pragma unroll
        for (int ai = 0; ai < 2; ++ai)
#pragma unroll
            for (int m = 0; m < 4; ++m) {
                bf16* rowp = (bf16*)u.dst + (size_t)(m0 + radd + ai * 128 + m * 16) * u.ld + wc * 32 + 8 * fq;
                if (u.kind == 0) { const f32x4 v0 = acc[ai][0][m][0] * acc[ai][1][m][0], v1 = acc[ai][0][m][1] * acc[ai][1][m][1];
                    u32x4 w; w.x = cvt_pk_bf16(v0[0], v0[1]); w.y = cvt_pk_bf16(v0[2], v0[3]); w.z = cvt_pk_bf16(v1[0], v1[1]); w.w = cvt_pk_bf16(v1[2], v1[3]);
                    *(u32x4*)rowp = w; }
                else {
#pragma unroll
                    for (int bj = 0; bj < 2; ++bj) { const f32x4 v0 = acc[ai][bj][m][0] * sc, v1 = acc[ai][bj][m][1] * sc;
                        u32x4 w; w.x = cvt_pk_bf16(v0[0], v0[1]); w.y = cvt_pk_bf16(v0[2], v0[3]); w.z = cvt_pk_bf16(v1[0], v1[1]); w.w = cvt_pk_bf16(v1[2], v1[3]);
                        *(u32x4*)(rowp + bj * 128) = w; } }
            }
    }
};

struct Epi1g {
    static constexpr bool PERM = true; static constexpr bool CHAIN = false;
    __device__ __forceinline__ void operator()(const f32x4 (&acc)[2][2][4][2], const Unit& u, int wr, int wc, int fr, int fq) const {
        const int m0 = u.pm * 256 + wr * 64 + fr;
#pragma unroll
        for (int ai = 0; ai < 2; ++ai)
#pragma unroll
            for (int m = 0; m < 4; ++m) {
                bf16* rowp = (bf16*)u.dst + (size_t)(m0 + ai * 128 + m * 16) * 2048 + wc * 32 + 8 * fq;
                float r[8], sg[8];
#pragma unroll
                for (int n = 0; n < 2; ++n)
#pragma unroll
                    for (int j = 0; j < 4; ++j) { const float ea = __expf(-acc[ai][1][m][n][j]), ec = __expf(-acc[ai][0][m][n][j]);
                        sg[4 * n + j] = __builtin_amdgcn_rcpf(1.f + ea); r[4 * n + j] = (1.f + ea) * __builtin_amdgcn_rcpf(1.f + ec); }
                u32x4 w; w.x = cvt_pk_bf16(r[0], r[1]); w.y = cvt_pk_bf16(r[2], r[3]); w.z = cvt_pk_bf16(r[4], r[5]); w.w = cvt_pk_bf16(r[6], r[7]);
                *(u32x4*)rowp = w;
                w.x = cvt_pk_bf16(sg[0], sg[1]); w.y = cvt_pk_bf16(sg[2], sg[3]); w.z = cvt_pk_bf16(sg[4], sg[5]); w.w = cvt_pk_bf16(sg[6], sg[7]);
                *(u32x4*)(rowp + (WS_GA - WS_GC) / 2) = w;
            }
    }
};

typedef short v4i16_t __attribute__((ext_vector_type(4)));
__device__ __forceinline__ s16x4 vtr(const LAS unsigned char* p) { return __builtin_bit_cast(s16x4, __builtin_amdgcn_ds_read_tr16_b64_v4i16((LAS v4i16_t*)p)); }
__device__ __forceinline__ int voff_b(int row, int ch) { return 256 * row + 16 * (ch ^ (((row & 3) << 2) | ((row >> 2) & 3))); }
__device__ __forceinline__ void p2_attn(Frame& F) {
    const int gw = F.vcu * 8 + F.wave, NGW = F.G * 8, lane = F.lane, r = lane & 31, hf = lane >> 5;
    LAS unsigned char* vl = F.lds + F.wave * 8192;
    const int gl = lane & 15, tq = gl >> 2, tp = gl & 3, cg = (lane >> 4) & 1;
    for (int item = gw; item < BATCH * NH * (SEQ / 32); item += NGW) {
        const int qb = item & 127, h = (item >> 7) & 7, b = item >> 10;
        const int m0 = b * SEQ + 32 * qb, p0 = NMETA + 32 * qb;
        bf16x8 qf[8];
        { const bf16* qp = WSP(bf16, WS_Q) + (size_t)(m0 + r) * 1024 + h * HD + 8 * hf;
#pragma unroll
          for (int kk = 0; kk < 8; ++kk) qf[kk] = *(const bf16x8*)(qp + 16 * kk); }
        f32x16 O[4];
#pragma unroll
        for (int d = 0; d < 4; ++d)
#pragma unroll
            for (int i = 0; i < 16; ++i) O[d][i] = 0.f;
        float carry = 0.f;
        const bf16* kbase = WSP(bf16, WS_K) + (size_t)(b * LTOT) * 1024 + h * HD;
        const bf16* vbase = WSP(bf16, WS_V) + (size_t)(b * LTOT) * 1024 + h * HD;
        bf16x8 kf[8];
        { int ks = p0 + r; ks = ks > LTOT - 1 ? LTOT - 1 : ks; const bf16* kp = kbase + (size_t)ks * 1024 + 8 * hf;
#pragma unroll
          for (int kk = 0; kk < 8; ++kk) kf[kk] = *(const bf16x8*)(kp + 16 * kk); }
        for (int s0 = p0; s0 > -32; s0 -= 32) {
            f32x16 S;
#pragma unroll
            for (int i = 0; i < 16; ++i) S[i] = 0.f;
#pragma unroll
            for (int kk = 0; kk < 8; ++kk) S = __builtin_amdgcn_mfma_f32_32x32x16_bf16(kf[kk], qf[kk], S, 0, 0, 0);
            __builtin_amdgcn_sched_barrier(0);
            unsigned vadj = 0u; asm volatile("" : "+v"(vadj) : "v"(S[15]));
#pragma unroll
            for (int i = 0; i < 8; ++i) { const int p = i * 64 + lane, row = p >> 4, ch = (p & 15) ^ (((row & 3) << 2) | ((row >> 2) & 3)); int vs = s0 + row; vs = vs < 0 ? 0 : (vs > LTOT - 1 ? LTOT - 1 : vs);
                __builtin_amdgcn_global_load_lds((const unsigned*)(vbase + (size_t)vs * 1024 + ch * 8 + vadj), (LAS unsigned*)(vl + i * 1024), 16, 0, 0); }
            { int ks = s0 - 32 + r; ks = ks < 0 ? 0 : (ks > LTOT - 1 ? LTOT - 1 : ks); const bf16* kp = kbase + (size_t)ks * 1024 + 8 * hf;
#pragma unroll
              for (int kk = 0; kk < 8; ++kk) kf[kk] = *(const bf16x8*)(kp + 16 * kk); }
            __builtin_amdgcn_sched_barrier(0);
            float lr[16], lb[16];
#pragma unroll
            for (int i = 0; i < 16; ++i) { const int s = s0 + (i & 3) + 8 * (i >> 2) + 4 * hf; const bool valid = (s < p0 + r) && (s >= 0); const float z = S[i];
                const float l = fminf(z, 0.f) - __logf(1.f + __expf(-fabsf(z)));
                lb[i] = valid ? l : -1e30f; lr[i] = valid ? l - z : 0.f; }
            float own[4], oth[4], suf[4];
#pragma unroll
            for (int c = 0; c < 4; ++c) { own[c] = (lr[4 * c] + lr[4 * c + 1]) + (lr[4 * c + 2] + lr[4 * c + 3]); oth[c] = __shfl_xor(own[c], 32); }
            float tail = 0.f;
#pragma unroll
            for (int c = 3; c >= 0; --c) { suf[c] = tail + (hf == 0 ? oth[c] : 0.f); tail += own[c] + oth[c]; }
            float w[16];
#pragma unroll
            for (int c = 0; c < 4; ++c) { float in = carry + suf[c];
#pragma unroll
                for (int j = 3; j >= 0; --j) { w[4 * c + j] = __expf(lb[4 * c + j] + in); in += lr[4 * c + j]; } }
            carry += tail;
            bf16x8 pf[2];
#pragma unroll
            for (int s = 0; s < 2; ++s) { u32x4 t; t.x = cvt_pk_bf16(w[8 * s], w[8 * s + 1]); t.y = cvt_pk_bf16(w[8 * s + 2], w[8 * s + 3]); t.z = cvt_pk_bf16(w[8 * s + 4], w[8 * s + 5]); t.w = cvt_pk_bf16(w[8 * s + 6], w[8 * s + 7]);
                pf[s] = __builtin_bit_cast(bf16x8, t); }
            asm volatile("s_waitcnt vmcnt(8)" ::: "memory");
            __builtin_amdgcn_sched_barrier(0);
#pragma unroll
            for (int db = 0; db < 4; ++db)
#pragma unroll
                for (int s = 0; s < 2; ++s) {
                    const int r0 = 16 * s + 4 * hf, c0 = 4 * db + 2 * cg;
                    const s16x4 lo = vtr(vl + voff_b(r0 + tq, c0 + (tp >> 1)) + 8 * (tp & 1));
                    const s16x4 hi = vtr(vl + voff_b(r0 + 8 + tq, c0 + (tp >> 1)) + 8 * (tp & 1));
                    bf16x8 vf; vf[0] = lo[0]; vf[1] = lo[1]; vf[2] = lo[2]; vf[3] = lo[3]; vf[4] = hi[0]; vf[5] = hi[1]; vf[6] = hi[2]; vf[7] = hi[3];
                    O[db] = __builtin_amdgcn_mfma_f32_32x32x16_bf16(vf, pf[s], O[db], 0, 0, 0);
                }
            if (__all(carry < -104.f)) break;
        }
        bf16* op = WSP(bf16, WS_O) + (size_t)(m0 + r) * 1024 + h * HD + 4 * hf;
#pragma unroll
        for (int db = 0; db < 4; ++db)
#pragma unroll
            for (int i4 = 0; i4 < 4; ++i4) { u32x2 t; t.x = cvt_pk_bf16(O[db][4 * i4], O[db][4 * i4 + 1]); t.y = cvt_pk_bf16(O[db][4 * i4 + 2], O[db][4 * i4 + 3]);
                *(u32x2*)(op + 32 * db + 8 * i4) = t; }
    }
}
__device__ __forceinline__ void p2_conv(Frame& F) {
    const int nth = F.G * 512, total = MR * (CC / 8);
    int c = blockIdx.x * 512 + F.tid;
    if (c >= total) return;
    const int c8 = (c & 127) * 8;
    const f32x4 w0a = GLD(f32x4, F.conv_w + c8), w0b = GLD(f32x4, F.conv_w + c8 + 4), w1a = GLD(f32x4, F.conv_w + CC + c8), w1b = GLD(f32x4, F.conv_w + CC + c8 + 4),
                w2a = GLD(f32x4, F.conv_w + 2 * CC + c8), w2b = GLD(f32x4, F.conv_w + 2 * CC + c8 + 4);
    const float W0[8] = {w0a[0], w0a[1], w0a[2], w0a[3], w0b[0], w0b[1], w0b[2], w0b[3]}, W1[8] = {w1a[0], w1a[1], w1a[2], w1a[3], w1b[0], w1b[1], w1b[2], w1b[3]},
                W2[8] = {w2a[0], w2a[1], w2a[2], w2a[3], w2b[0], w2b[1], w2b[2], w2b[3]};
    u32x4 x0, x1, x2, bp;
#define P2C_LD(cc, A0, A1, A2, AB) do { const int m_ = (cc) >> 7, b_ = m_ / SEQ; const size_t row_ = (size_t)m_ + NMETA * (b_ + 1); const bf16* cu_ = WSP(bf16, WS_CU) + row_ * 1024 + c8; \
        A0 = *(const u32x4*)(cu_ - 2048); A1 = *(const u32x4*)(cu_ - 1024); A2 = *(const u32x4*)cu_; AB = *(const u32x4*)(WSP(bf16, WS_BP) + (size_t)m_ * 1024 + c8); } while (0)
    P2C_LD(c, x0, x1, x2, bp);
    for (; c < total; c += nth) {
        u32x4 n0 = x0, n1 = x1, n2 = x2, nb = bp;
        if (c + nth < total) P2C_LD(c + nth, n0, n1, n2, nb);
        const int m = c >> 7;
        const unsigned X0[4] = {x0.x, x0.y, x0.z, x0.w}, X1[4] = {x1.x, x1.y, x1.z, x1.w}, X2[4] = {x2.x, x2.y, x2.z, x2.w}, BP[4] = {bp.x, bp.y, bp.z, bp.w};
        unsigned ow[4];
#pragma unroll
        for (int q = 0; q < 4; ++q) {
            const float lo = bf_lo(BP[q]) * (W0[2 * q] * bf_lo(X0[q]) + W1[2 * q] * bf_lo(X1[q]) + W2[2 * q] * bf_lo(X2[q]));
            const float hi = bf_hi(BP[q]) * (W0[2 * q + 1] * bf_hi(X0[q]) + W1[2 * q + 1] * bf_hi(X1[q]) + W2[2 * q + 1] * bf_hi(X2[q]));
            ow[q] = cvt_pk_bf16(lo, hi); }
        u32x4 o; o.x = ow[0]; o.y = ow[1]; o.z = ow[2]; o.w = ow[3];
        *(u32x4*)(WSP(bf16, WS_YCIN) + (size_t)m * 1024 + c8) = o;
        x0 = n0; x1 = n1; x2 = n2; bp = nb;
    }
#undef P2C_LD
}

struct Sched3 {
    static constexpr bool AROW_LOADS = false;
    int G, c; unsigned char* ws; const LAS int* ut;
    __device__ __forceinline__ void coords(int i, int (&f)[8]) const { int pm = 0, pn = 0; f[0] = pg8::static_tile((i >> 1) * G + c, MR / 256, D / 256, pm, pn) ? 1 : 0; f[1] = pm; f[2] = pn; f[3] = i & 1; f[4] = 0; f[5] = 0; f[6] = 256; }
    __device__ __forceinline__ bool next(int i, Unit& u) const {
        if (!read_unit(ut, i, u)) return false;
        const int sub = u.kind; u.e = 0; u.nrow = 256; u.aux = 0;
        u.A = (const char*)(ws + (sub ? WS_O : WS_YCIN)) + (size_t)u.pm * 256 * 2048;
        u.B0 = (const char*)(ws + (sub ? WS_WATTN : WS_WCONV)) + (size_t)(256 * u.pn) * 1024 * 2; u.B1 = u.B0 + (size_t)128 * 1024 * 2;
        u.dst = (char*)(ws + (sub ? WS_GA : WS_GC)); u.ld = D;
        return true;
    }
    __device__ __forceinline__ unsigned arow(const Unit&, int r) const { return (unsigned)r * 2048u; }
    __device__ __forceinline__ unsigned hstepA() const { return 128u * 2048u; }
};
struct Epi3 {
    static constexpr bool PERM = true; static constexpr bool CHAIN = true;
    const bf16* gr; const bf16* gs; bf16* merged;
    __device__ __forceinline__ void mid(f32x4 (&acc)[2][2][4][2], const Unit& u, int wr, int wc, int fr, int fq) const {
        const int m0 = u.pm * 256 + wr * 64 + fr, col0 = u.pn * 256 + wc * 32 + 8 * fq;
#pragma unroll
        for (int ai = 0; ai < 2; ++ai)
#pragma unroll
            for (int m = 0; m < 4; ++m) { const size_t off = (size_t)(m0 + ai * 128 + m * 16) * D + col0;
#pragma unroll
                for (int bj = 0; bj < 2; ++bj) {
                    const u32x4 g = *(const u32x4*)(gr + off + bj * 128);
                    f32x4& v0 = acc[ai][bj][m][0]; f32x4& v1 = acc[ai][bj][m][1];
                    v0[0] *= bf_lo(g.x); v0[1] *= bf_hi(g.x); v0[2] *= bf_lo(g.y); v0[3] *= bf_hi(g.y);
                    v1[0] *= bf_lo(g.z); v1[1] *= bf_hi(g.z); v1[2] *= bf_lo(g.w); v1[3] *= bf_hi(g.w); } }
    }
    __device__ __forceinline__ void operator()(const f32x4 (&acc)[2][2][4][2], const Unit& u, int wr, int wc, int fr, int fq) const {
        const int m0 = u.pm * 256 + wr * 64 + fr, col0 = u.pn * 256 + wc * 32 + 8 * fq;
        u32x4 gv[8][2];
#define EPI3_LD(g) do { const size_t off_ = (size_t)(m0 + ((g) >> 2) * 128 + ((g) & 3) * 16) * D + col0; gv[g][0] = *(const u32x4*)(gs + off_); gv[g][1] = *(const u32x4*)(gs + off_ + 128); } while (0)
        EPI3_LD(0); EPI3_LD(1); EPI3_LD(2); EPI3_LD(3);
#pragma unroll
        for (int gi = 0; gi < 8; ++gi) { const int ai = gi >> 2, m = gi & 3; const size_t off = (size_t)(m0 + ai * 128 + m * 16) * D + col0;
#pragma unroll
                for (int bj = 0; bj < 2; ++bj) {
                    const u32x4 g = gv[gi][bj];
                    f32x4 v0 = acc[ai][bj][m][0], v1 = acc[ai][bj][m][1];
                    v0[0] *= bf_lo(g.x); v0[1] *= bf_hi(g.x); v0[2] *= bf_lo(g.y); v0[3] *= bf_hi(g.y);
                    v1[0] *= bf_lo(g.z); v1[1] *= bf_hi(g.z); v1[2] *= bf_lo(g.w); v1[3] *= bf_hi(g.w);
                    u32x4 w; w.x = cvt_pk_bf16(v0[0], v0[1]); w.y = cvt_pk_bf16(v0[2], v0[3]); w.z = cvt_pk_bf16(v1[0], v1[1]); w.w = cvt_pk_bf16(v1[2], v1[3]);
                    *(u32x4*)(merged + off + bj * 128) = w; }
            if (gi + 4 < 8) EPI3_LD(gi + 4); }
#undef EPI3_LD
    }
};

struct Sched4 {
    static constexpr bool AROW_LOADS = false;
    int G, c; unsigned char* ws; const LAS int* ut;
    __device__ __forceinline__ void coords(int i, int (&f)[8]) const { int pm = 0, pn = 0; f[0] = pg8::static_tile(i * G + c, MR / 256, D / 256, pm, pn) ? 1 : 0; f[1] = pm; f[2] = pn; f[3] = 0; f[4] = 0; f[5] = 0; f[6] = 256; }
    __device__ __forceinline__ bool next(int i, Unit& u) const {
        if (!read_unit(ut, i, u)) return false;
        u.kind = 0; u.e = 0; u.nrow = 256; u.aux = 0; u.A = (const char*)(ws + WS_MERGED) + (size_t)u.pm * 256 * D * 2;
        u.B0 = (const char*)(ws + WS_WO) + (size_t)(256 * u.pn) * D * 2; u.B1 = u.B0 + (size_t)128 * D * 2; u.dst = nullptr; u.ld = D;
        return true;
    }
    __device__ __forceinline__ unsigned arow(const Unit&, int r) const { return (unsigned)r * (unsigned)(D * 2); }
    __device__ __forceinline__ unsigned hstepA() const { return 128u * D * 2u; }
};
struct Epi4 {
    static constexpr bool PERM = true; static constexpr bool CHAIN = false;
    const bf16* xb; bf16* hres2;
    __device__ __forceinline__ void operator()(const f32x4 (&acc)[2][2][4][2], const Unit& u, int wr, int wc, int fr, int fq) const {
        const int row0 = u.pm * 256 + wr * 64 + fr, col0 = u.pn * 256 + wc * 32 + 8 * fq;
        u32x4 xv[8][2];
#define EPI4_LD(g) do { const size_t off_ = (size_t)(row0 + ((g) >> 2) * 128 + ((g) & 3) * 16) * D + col0; xv[g][0] = GLD(u32x4, xb + off_); xv[g][1] = GLD(u32x4, xb + off_ + 128); } while (0)
        EPI4_LD(0); EPI4_LD(1); EPI4_LD(2); EPI4_LD(3);
#pragma unroll
        for (int g = 0; g < 8; ++g) { const int ai = g >> 2, m = g & 3; const size_t off = (size_t)(row0 + ai * 128 + m * 16) * D + col0;
#pragma unroll
            for (int bj = 0; bj < 2; ++bj) { const u32x4 xw = xv[g][bj];
                const f32x4 v0 = (f32x4){bf_lo(xw.x), bf_hi(xw.x), bf_lo(xw.y), bf_hi(xw.y)} + acc[ai][bj][m][0], v1 = (f32x4){bf_lo(xw.z), bf_hi(xw.z), bf_lo(xw.w), bf_hi(xw.w)} + acc[ai][bj][m][1];
                u32x4 w; w.x = cvt_pk_bf16(v0[0], v0[1]); w.y = cvt_pk_bf16(v0[2], v0[3]); w.z = cvt_pk_bf16(v1[0], v1[1]); w.w = cvt_pk_bf16(v1[2], v1[3]);
                *(u32x4*)(hres2 + off + bj * 128) = w; }
            if (g + 4 < 8) EPI4_LD(g + 4); }
#undef EPI4_LD
    }
};

__device__ __forceinline__ void p5_route(Frame& F) {
    LAS float* part = (LAS float*)F.lds;
    LAS float* ssqp = part + 2 * 64 * 33;
    LAS int* lcnt = (LAS int*)(ssqp + 128);
    LAS int* gbase = lcnt + 32;
    const int lane = F.lane, fr = lane & 15, fq = lane >> 4, tg = F.wave & 3, kh = F.wave >> 2;
    const bf16* hres2 = WSP(bf16, WS_HRES2);
    for (int tb = blockIdx.x; tb < MR / 64; tb += F.G) {
        if (F.tid < 32) lcnt[F.tid] = 0;
        const int tok = tb * 64 + tg * 16 + fr;
        const bf16* xr = hres2 + (size_t)tok * D + kh * 1024 + 8 * fq;
        const float* gr = F.g_ffn + kh * 1024 + 8 * fq;
        unsigned char* hgw = WSP(unsigned char, WS_HG) + (size_t)tok * D + kh * 1024 + 8 * fq;
        const u32x4* wf = WSP(u32x4, WS_WRF) + (size_t)(kh * 32) * 128 + lane;
        f32x4 acc0 = {0.f, 0.f, 0.f, 0.f}, acc1 = {0.f, 0.f, 0.f, 0.f}; float ssq = 0.f;
#pragma unroll 4
        for (int s = 0; s < 32; ++s) {
            const u32x4 xw = *(const u32x4*)(xr + 32 * s);
            f32x4 x0 = {bf_lo(xw.x), bf_hi(xw.x), bf_lo(xw.y), bf_hi(xw.y)}, x1 = {bf_lo(xw.z), bf_hi(xw.z), bf_lo(xw.w), bf_hi(xw.w)};
            const f32x4 g0 = GLD(f32x4, gr + 32 * s), g1 = GLD(f32x4, gr + 32 * s + 4);
            ssq += (x0[0] * x0[0] + x0[1] * x0[1]) + (x0[2] * x0[2] + x0[3] * x0[3]) + (x1[0] * x1[0] + x1[1] * x1[1]) + (x1[2] * x1[2] + x1[3] * x1[3]);
            x0 *= g0; x1 *= g1;
            u32x4 t; t.x = cvt_pk_bf16(x0[0], x0[1]); t.y = cvt_pk_bf16(x0[2], x0[3]); t.z = cvt_pk_bf16(x1[0], x1[1]); t.w = cvt_pk_bf16(x1[2], x1[3]);
            { u32x2 h8; h8.x = cvt4_fp8(x0[0], x0[1], x0[2], x0[3]); h8.y = cvt4_fp8(x1[0], x1[1], x1[2], x1[3]); *(u32x2*)(hgw + 32 * s) = h8; }
            const bf16x8 bfr = __builtin_bit_cast(bf16x8, t);
            const bf16x8 a0 = __builtin_bit_cast(bf16x8, wf[(size_t)(2 * s) * 64]), a1 = __builtin_bit_cast(bf16x8, wf[(size_t)(2 * s + 1) * 64]);
            acc0 = __builtin_amdgcn_mfma_f32_16x16x32_bf16(a0, bfr, acc0, 0, 0, 0);
            acc1 = __builtin_amdgcn_mfma_f32_16x16x32_bf16(a1, bfr, acc1, 0, 0, 0);
        }
        ssq += __shfl_xor(ssq, 16); ssq += __shfl_xor(ssq, 32);
        { LAS float* pp = part + (kh * 64 + tg * 16 + fr) * 33 + 4 * fq;
#pragma unroll
          for (int j = 0; j < 4; ++j) { pp[j] = acc0[j]; pp[16 + j] = acc1[j]; }
          if (fq == 0) ssqp[kh * 64 + tg * 16 + fr] = ssq; }
        __syncthreads();
        if (F.wave == 0) {
            const int t = tb * 64 + lane;
            const float rstd = rsqrtf((ssqp[lane] + ssqp[64 + lane]) * (1.f / D) + EPS);
            float lg[NE];
#pragma unroll
            for (int e = 0; e < NE; ++e) lg[e] = rstd * (part[lane * 33 + e] + part[(64 + lane) * 33 + e]) + GLD(float, F.b_router + e);
            int ti[TOPK]; float tv[TOPK]; unsigned used = 0u;
#pragma unroll
            for (int k = 0; k < TOPK; ++k) { int bi = -1; float bv = 0.f;
#pragma unroll
                for (int e = 0; e < NE; ++e) { const bool take = !((used >> e) & 1u) && (bi < 0 || lg[e] > bv); bi = take ? e : bi; bv = take ? lg[e] : bv; }
                used |= 1u << bi; ti[k] = bi; tv[k] = bv; }
            float ex[TOPK], den = 0.f;
#pragma unroll
            for (int k = 0; k < TOPK; ++k) { ex[k] = __expf(tv[k] - tv[0]); den += ex[k]; }
            const float rden = 1.f / den;
            int lrk[TOPK];
#pragma unroll
            for (int k = 0; k < TOPK; ++k) lrk[k] = __hip_atomic_fetch_add(&lcnt[ti[k]], 1, __ATOMIC_RELAXED, __HIP_MEMORY_SCOPE_WORKGROUP);
            LDS_WAIT();
            if (lane < 32) { const int c = lcnt[lane]; int gb = 0; if (c) gb = (int)atomicAdd(F.ctl + CW_CNT + 64 * lane, (unsigned)c); gbase[lane] = gb; }
            LDS_WAIT();
#pragma unroll
            for (int k = 0; k < TOPK; ++k) { const int e = ti[k], sid = e * SLOT_CAP + gbase[e] + lrk[k];
                WSP(int, WS_TOKOF)[sid] = t; WSP(float, WS_RSTDOF)[sid] = rstd; WSP(float, WS_CWOF)[sid] = ex[k] * rden; WSP(int, WS_TOKSLOT)[t * TOPK + k] = sid; }
        }
        __syncthreads();
    }
}

__device__ __forceinline__ void moe_tables(Frame& F) {
    LAS int* tb = (LAS int*)(F.lds + LDS_TBL);
    if (F.wave == 0) {
        const int c = F.lane < NE ? (int)__hip_atomic_load(F.ctl + CW_CNT + 64 * (F.lane & 31), __ATOMIC_RELAXED, __HIP_MEMORY_SCOPE_AGENT) : 0;
        int t = (c + 255) >> 8, inc = t;
#pragma unroll
        for (int o = 1; o < 32; o <<= 1) { const int v = __shfl_up(inc, o); if ((F.lane & 31) >= o) inc += v; }
        if (F.lane < NE) { tb[F.lane] = c; tb[32 + F.lane + 1] = inc; }
        if (F.lane == 0) tb[32] = 0;
    }
    __syncthreads();
}
constexpr int ROT_UNITS = 24;
__device__ __forceinline__ void build_rowoffs(const LAS int* ut, LAS unsigned* rot, const unsigned char* ws, int wave) {
    int lt = (int)__builtin_amdgcn_mbcnt_hi(~0u, __builtin_amdgcn_mbcnt_lo(~0u, 0u)); asm volatile("" : "+v"(lt));
    const int tid = wave * 64 + lt;
    for (int idx = tid; idx < ROT_UNITS * 256; idx += 512) {
        const int i = idx >> 8, r = idx & 255; const LAS int* p = ut + 8 * i;
        unsigned off = 0u;
        if (p[0] != 0 && r < p[6]) off = (unsigned)((const GAS int*)(ws + WS_TOKOF))[p[4] * SLOT_CAP + p[5] * 256 + r] * (unsigned)D;
        rot[idx] = off;
    }
    __syncthreads();
}
template <bool SECOND> struct SchedMoe {
    static constexpr bool AROW_LOADS = !SECOND;
    static constexpr int second = SECOND ? 1 : 0;
    int G, c, nN; unsigned char* ws; const LAS int* tb; const LAS int* ut;
    __device__ __forceinline__ void coords(int i, int (&f)[8]) const {
        const int Mt = tb[32 + NE]; int gm = 0, pn = 0; f[0] = pg8::static_tile(i * G + c, Mt, nN, gm, pn, 8) ? 1 : 0;
        int e = 0;
        for (int j = 0; j < NE - 1; ++j) e += (tb[32 + j + 1] <= gm) ? 1 : 0;
        const int mt = gm - tb[32 + e], cnt = tb[e];
        f[1] = gm; f[2] = pn; f[3] = 0; f[4] = e; f[5] = mt; f[6] = (cnt - mt * 256) < 256 ? (cnt - mt * 256) : 256;
    }
    __device__ __forceinline__ bool next(int i, Unit& u) const {
        if (!read_unit(ut, i, u)) return false;
        const int gm = u.pm, pn = u.pn, e = u.e; u.ld = i; u.dst = nullptr;
        if (!second) { u.A = (const char*)(ws + WS_HG); u.B0 = (const char*)(ws + WS_WG) + ((size_t)e * DFF + 128 * pn) * D; u.B1 = (const char*)(ws + WS_WU) + ((size_t)e * DFF + 128 * pn) * D; }
        else { u.A = (const char*)(ws + WS_ACT) + (size_t)gm * 256 * DFF; u.B0 = (const char*)(ws + WS_WD) + ((size_t)e * D + 256 * pn) * DFF; u.B1 = u.B0 + (size_t)128 * DFF; }
        return true;
    }
    __device__ __forceinline__ unsigned arow(const Unit& u, int r) const {
        if (second) return (unsigned)r * (unsigned)DFF;
        const LAS unsigned* rot = (const LAS unsigned*)((const LAS unsigned char*)tb + (LDS_CVRING - LDS_TBL));
        return rot[u.ld * 256 + r];
    }
    __device__ __forceinline__ unsigned hstepA() const { return 128u * DFF; }
};
struct Epi6 {
    static constexpr bool PERM = true; static constexpr bool CHAIN = false; static constexpr bool WIDE = true; static constexpr bool RELAX = true;
    const float* b_gate; const float* b_up; const float* rstd_of; unsigned char* act;
    __device__ __forceinline__ void operator()(const f32x4 (&acc)[2][2][4][2], const Unit& u, int wr, int wc, int fr, int fq) const {
        const int colw = u.pn * 128 + wc * 32 + 16 * (fq & 1), col0 = colw + 8 * (fq >> 1), hi = fq >> 1;
        const f32x4 bg0 = GLD(f32x4, b_gate + u.e * DFF + col0), bg1 = GLD(f32x4, b_gate + u.e * DFF + col0 + 4), bu0 = GLD(f32x4, b_up + u.e * DFF + col0), bu1 = GLD(f32x4, b_up + u.e * DFF + col0 + 4);
        float rsv[8];
#pragma unroll
        for (int i = 0; i < 8; ++i) rsv[i] = rstd_of[u.e * SLOT_CAP + u.aux * 256 + (i >> 2) * 128 + wr * 64 + (i & 3) * 16 + fr];
        asm volatile("s_waitcnt vmcnt(0)" ::: "memory");
#pragma unroll
        for (int ai = 0; ai < 2; ++ai)
#pragma unroll
            for (int mp = 0; mp < 2; ++mp) { const int rl0 = ai * 128 + wr * 64 + mp * 32 + fr;
                u32x2 w[2];
#pragma unroll
                for (int q = 0; q < 2; ++q) { const int m = 2 * mp + q;
                    const float rs = rsv[ai * 4 + m];
                    f32x4 o[2];
#pragma unroll
                    for (int n = 0; n < 2; ++n) { const f32x4 g = acc[ai][0][m][n] * rs + (n ? bg1 : bg0), up = acc[ai][1][m][n] * rs + (n ? bu1 : bu0);
#pragma unroll
                        for (int j = 0; j < 4; ++j) { const float gt = fminf(g[j], 7.f), uu = fminf(fmaxf(up[j], -7.f), 7.f); o[n][j] = (uu + 1.f) * (gt * fast_sigmoid(1.702f * gt)); } }
                    w[q].x = cvt4_fp8(o[0][0], o[0][1], o[0][2], o[0][3]); w[q].y = cvt4_fp8(o[1][0], o[1][1], o[1][2], o[1][3]); }
                const auto rx = __builtin_amdgcn_permlane32_swap(w[0].x, w[1].x, false, false), ry = __builtin_amdgcn_permlane32_swap(w[0].y, w[1].y, false, false);
                const int rl = rl0 + 16 * hi;
                if (rl < u.nrow) { u32x4 v; v.x = rx[0]; v.y = ry[0]; v.z = rx[1]; v.w = ry[1];
                    *(u32x4*)(act + (size_t)(u.pm * 256 + rl) * DFF + colw) = v; } }
    }
};
struct Epi7 {
    static constexpr bool PERM = true; static constexpr bool CHAIN = false; static constexpr bool WIDE = true; static constexpr bool RELAX = true;
    const float* b_down; const float* cw_of; unsigned char* Y;
    __device__ __forceinline__ void operator()(const f32x4 (&acc)[2][2][4][2], const Unit& u, int wr, int wc, int fr, int fq) const {
        const int colw = u.pn * 256 + wc * 32 + 16 * (fq & 1), col0 = colw + 8 * (fq >> 1), hi = fq >> 1;
        f32x4 bv[2][2];
#pragma unroll
        for (int bj = 0; bj < 2; ++bj)
#pragma unroll
            for (int n = 0; n < 2; ++n) bv[bj][n] = GLD(f32x4, b_down + u.e * D + col0 + bj * 128 + 4 * n);
        float cwv[8];
#pragma unroll
        for (int i = 0; i < 8; ++i) cwv[i] = cw_of[u.e * SLOT_CAP + u.aux * 256 + (i >> 2) * 128 + wr * 64 + (i & 3) * 16 + fr];
        asm volatile("s_waitcnt vmcnt(0)" ::: "memory");
#pragma unroll
        for (int ai = 0; ai < 2; ++ai)
#pragma unroll
            for (int mp = 0; mp < 2; ++mp) { const int rl0 = ai * 128 + wr * 64 + mp * 32 + fr, rl = rl0 + 16 * hi;
                const float cw0 = cwv[ai * 4 + 2 * mp], cw1 = cwv[ai * 4 + 2 * mp + 1];
#pragma unroll
                for (int bj = 0; bj < 2; ++bj) { u32x2 w[2];
#pragma unroll
                    for (int q = 0; q < 2; ++q) { const float cw = q ? cw1 : cw0; const f32x4 v0 = (acc[ai][bj][2 * mp + q][0] + bv[bj][0]) * cw, v1 = (acc[ai][bj][2 * mp + q][1] + bv[bj][1]) * cw;
                        w[q].x = cvt4_fp8(v0[0], v0[1], v0[2], v0[3]); w[q].y = cvt4_fp8(v1[0], v1[1], v1[2], v1[3]); }
                    const auto rx = __builtin_amdgcn_permlane32_swap(w[0].x, w[1].x, false, false), ry = __builtin_amdgcn_permlane32_swap(w[0].y, w[1].y, false, false);
                    if (rl < u.nrow) { u32x4 v; v.x = rx[0]; v.y = ry[0]; v.z = rx[1]; v.w = ry[1];
                        *(u32x4*)(Y + (size_t)(u.pm * 256 + rl) * D + colw + bj * 128) = v; } } }
    }
};

struct EpiNull { static constexpr bool PERM = true; static constexpr bool CHAIN = false;
    __device__ __forceinline__ void operator()(const f32x4 (&acc)[2][2][4][2], const Unit& u, int, int, int, int) const {
        float s = 0.f;
#pragma unroll
        for (int a = 0; a < 2; ++a)
#pragma unroll
            for (int b = 0; b < 2; ++b)
#pragma unroll
                for (int m = 0; m < 4; ++m)
#pragma unroll
                    for (int n = 0; n < 2; ++n) s += acc[a][b][m][n][0] + acc[a][b][m][n][3];
        if (s == 1.2345e30f) ((float*)u.A)[0] = s; } };
__device__ __forceinline__ void p8_final(Frame& F) {
    const LAS int* tb = (const LAS int*)(F.lds + LDS_TBL);
    const int gw = F.vcu * 8 + F.wave, NGW = F.G * 8, lane = F.lane;
    const bf16* hres2 = WSP(bf16, WS_HRES2); const unsigned char* Y = WSP(unsigned char, WS_Y);
    for (int t = gw; t < MR; t += NGW) {
        const int* ts = WSP(int, WS_TOKSLOT) + t * TOPK;
        const unsigned char* yr[TOPK];
#pragma unroll
        for (int k = 0; k < TOPK; ++k) { const int sid = __builtin_amdgcn_readfirstlane(ts[k]); const int e = sid >> 14, r = sid & (SLOT_CAP - 1); yr[k] = Y + (size_t)(tb[32 + e] * 256 + r) * D + 16 * lane; }
        const bf16* xr = hres2 + (size_t)t * D + 16 * lane;
        float v[2][16]; float s = 0.f;
#pragma unroll
        for (int j = 0; j < 2; ++j) {
            const u32x4 xa = *(const u32x4*)(xr + 1024 * j), xb = *(const u32x4*)(xr + 1024 * j + 8);
            const unsigned xw[8] = {xa.x, xa.y, xa.z, xa.w, xb.x, xb.y, xb.z, xb.w};
#pragma unroll
            for (int q = 0; q < 8; ++q) { v[j][2 * q] = bf_lo(xw[q]); v[j][2 * q + 1] = bf_hi(xw[q]); }
#pragma unroll
            for (int k = 0; k < TOPK; ++k) { const u32x4 y = *(const u32x4*)(yr[k] + 1024 * j); const unsigned yw[4] = {y.x, y.y, y.z, y.w};
#pragma unroll
                for (int q = 0; q < 4; ++q) { const f32x2_t lo = __builtin_amdgcn_cvt_pk_f32_fp8((int)yw[q], false), hi = __builtin_amdgcn_cvt_pk_f32_fp8((int)yw[q], true);
                    v[j][4 * q] += lo[0]; v[j][4 * q + 1] += lo[1]; v[j][4 * q + 2] += hi[0]; v[j][4 * q + 3] += hi[1]; } }
#pragma unroll
            for (int q = 0; q < 16; ++q) s += v[j][q] * v[j][q];
        }
        const float rstd = rsqrtf(wave_sum(s) * (1.f / D) + EPS);
#pragma unroll
        for (int j = 0; j < 2; ++j) { f32x4* op = (f32x4*)(F.out + (size_t)t * D + 16 * lane + 1024 * j); const GAS f32x4* gp = (const GAS f32x4*)(F.g_final + 16 * lane + 1024 * j);
#pragma unroll
            for (int q = 0; q < 4; ++q) { const f32x4 g = gp[q]; f32x4 o; o[0] = v[j][4 * q] * rstd * g[0]; o[1] = v[j][4 * q + 1] * rstd * g[1]; o[2] = v[j][4 * q + 2] * rstd * g[2]; o[3] = v[j][4 * q + 3] * rstd * g[3]; op[q] = o; } }
    }
}

#ifndef DUP_PHASE
#define DUP_PHASE -1
#endif
#ifdef CV_DUMMY
constexpr size_t CV_DST = WS_Y;
#else
constexpr size_t CV_DST = WS_WG;
#endif
__global__ void __launch_bounds__(512, 2) mk_fwd(Args args) {
    extern __shared__ __attribute__((aligned(16))) unsigned char lds[];
    Frame F;
    F.lds = (LAS unsigned char*)lds;
    F.tid = threadIdx.x; F.lane = F.tid & 63; F.wave = __builtin_amdgcn_readfirstlane(F.tid >> 6);
    F.G = gridDim.x; { const int bx = blockIdx.x; F.vcu = (F.G % 8 == 0) ? (bx % 8) * (F.G / 8) + bx / 8 : bx; }
    F.x = args.in[0]; F.meta = args.in[1]; F.g_mix = args.in[2]; F.w_in = args.in[3]; F.conv_w = args.in[4]; F.w_conv_out = args.in[5]; F.w_attn_out = args.in[6]; F.w_o = args.in[7];
    F.g_ffn = args.in[8]; F.w_router = args.in[9]; F.b_router = args.in[10]; F.w_gate = args.in[11]; F.b_gate = args.in[12]; F.w_up = args.in[13]; F.b_up = args.in[14];
    F.w_down = args.in[15]; F.b_down = args.in[16]; F.g_final = args.in[17];
    F.out = args.out; F.ws = args.ws; F.ctl = (unsigned*)(args.ws + WS_CTL);
    for (int u = F.tid; u < (LDS_BYTES - RING_BYTES) / 4; u += 512) ((LAS unsigned*)(F.lds + RING_BYTES))[u] = 0u;
    __syncthreads();
    const int lo = args.ph_lo, hi = args.ph_hi;
    const bool multi = (hi - lo) > 1;
    XcdBarrier bar; bar.bar = F.ctl + CW_BAR; bar.x = 0; bar.st = nullptr;
    if (multi) bar = xcd_barrier_post(F.ctl + CW_BAR, (volatile LAS unsigned*)(F.lds + LDS_MISC));
#ifdef ONLY_PHASE
#define IN(k) ((k) == ONLY_PHASE)
#else
#define IN(k) (lo <= (k) && (k) < hi)
#endif
#define ARG(i) ([&]() { const float* p_ = args.in[i]; asm volatile("" : "+s"(p_)); return p_; }())
#define SEAM(k) do { if (IN(k) && IN((k) + 1)) xcd_barrier(bar); } while (0)
#ifdef CV_DUMMY
    const bool ride = false; const bool cvon = true;
#else
    const bool ride = (F.G == 256); const bool cvon = ride;
#endif
    if (IN(0)) { p0_prologue(F, ride); if (DUP_PHASE == 0) p0_prologue(F, ride); SEAM(0); }
    if (IN(1)) {
        F.w_gate = ARG(11); F.w_up = ARG(13); F.w_down = ARG(15);
        p1_meta(F);
        LAS int* ut = (LAS int*)(F.lds + LDS_UNITS);
        Sched1 S{F.G, (int)blockIdx.x, F.ws, ut}; Epi1 E; build_units(S, ut);
#define CVW(NB_, lo_, hi_) int cl_ = (int)__builtin_amdgcn_mbcnt_hi(~0u, __builtin_amdgcn_mbcnt_lo(~0u, 0u)); asm volatile("" : "+v"(cl_));     \
        ConvW<NB_> cvw{F.w_gate, F.w_up, F.w_down, F.ws + CV_DST, F.lds + LDS_CVRING + F.wave * 3072, F.vcu * 8 + F.wave, cvon ? (lo_) : 0, cvon ? (lo_) : 0, cvon ? (hi_) : 0, \
                    (unsigned)((cl_ >> 2) * 8192 + (cl_ & 3) * 16), (unsigned)((cl_ >> 4) * 256 + (cl_ & 15) * 4), (unsigned)((cl_ & 15) * 2048 + (cl_ >> 4) * 16), {0.f, 0.f, 0.f, 0.f}, {}}
        { CVW(8, 0, 384); pg8::gemm_phase<Epi1, Sched1, true, true, false, ConvW<8>>(F.lds, D, S, E, cvw); }
        { Sched1g Sg{F.G, (int)blockIdx.x, F.ws, ut}; build_units(Sg, ut);
          CVW(8, 384, 512); Epi1g Eg; pg8::gemm_phase<Epi1g, Sched1g, true, true, true, ConvW<8>>(F.lds, D, Sg, Eg, cvw); }
        SEAM(1);
    }
    if (IN(2)) { F.conv_w = ARG(4); p2_attn(F); p2_conv(F); if (DUP_PHASE == 2) { p2_attn(F); p2_conv(F); } SEAM(2); }
    if (IN(3)) {
        F.w_gate = ARG(11); F.w_up = ARG(13); F.w_down = ARG(15);
        LAS int* ut = (LAS int*)(F.lds + LDS_UNITS);
        Sched3 S{F.G, (int)blockIdx.x, F.ws, ut}; Epi3 E{WSP(bf16, WS_GC), WSP(bf16, WS_GA), WSP(bf16, WS_MERGED)}; build_units(S, ut);
        { CVW(8, 512, 640); pg8::gemm_phase<Epi3, Sched3, true, true, false, ConvW<8>>(F.lds, 1024, S, E, cvw); }
        SEAM(3);
    }
    if (IN(4)) {
        F.w_gate = ARG(11); F.w_up = ARG(13); F.w_down = ARG(15); F.x = ARG(0);
        LAS int* ut = (LAS int*)(F.lds + LDS_UNITS);
        Sched4 S{F.G, (int)blockIdx.x, F.ws, ut}; Epi4 E{WSP(bf16, WS_XB), WSP(bf16, WS_HRES2)}; build_units(S, ut);
        { CVW(8, 640, 768); pg8::gemm_phase<Epi4, Sched4, true, true, false, ConvW<8>>(F.lds, D, S, E, cvw); }
        if (DUP_PHASE == 4) pg8::gemm_phase<Epi4, Sched4, true, true>(F.lds, D, S, E);
        if (DUP_PHASE == 14) { EpiNull EN; pg8::gemm_phase<EpiNull, Sched4, true, true>(F.lds, D, S, EN); }
        SEAM(4);
    }
    if (IN(5)) { F.g_ffn = ARG(8); F.b_router = ARG(10); p5_route(F); SEAM(5); }
    if (IN(6)) {
        F.b_gate = ARG(12); F.b_up = ARG(14);
        moe_tables(F);
        LAS int* ut = (LAS int*)(F.lds + LDS_UNITS);
        SchedMoe<false> S{F.G, (int)blockIdx.x, DFF / 128, F.ws, (const LAS int*)(F.lds + LDS_TBL), ut}; build_units(S, ut);
        build_rowoffs(ut, (LAS unsigned*)(F.lds + LDS_CVRING), F.ws, F.wave);
        Epi6 E{F.b_gate, F.b_up, WSP(float, WS_RSTDOF), WSP(unsigned char, WS_ACT)};
        pg8::gemm_phase<Epi6, SchedMoe<false>, true, true, true>(F.lds, D, S, E);
        if (DUP_PHASE == 6) pg8::gemm_phase<Epi6, SchedMoe<false>, true, true, true>(F.lds, D, S, E);
        if (DUP_PHASE == 16) { EpiNull EN; pg8::gemm_phase<EpiNull, SchedMoe<false>, true, true, true>(F.lds, D, S, EN); }
                SEAM(6);
    }
    if (IN(7)) {
        F.b_down = ARG(16);
        moe_tables(F);
        LAS int* ut = (LAS int*)(F.lds + LDS_UNITS);
        SchedMoe<true> S{F.G, (int)blockIdx.x, D / 256, F.ws, (const LAS int*)(F.lds + LDS_TBL), ut}; build_units(S, ut);
        Epi7 E{F.b_down, WSP(float, WS_CWOF), WSP(unsigned char, WS_Y)};
        pg8::gemm_phase<Epi7, SchedMoe<true>, true, true, true>(F.lds, DFF, S, E);
        if (DUP_PHASE == 7) pg8::gemm_phase<Epi7, SchedMoe<true>, true, true, true>(F.lds, DFF, S, E);
        if (DUP_PHASE == 17) { EpiNull EN; pg8::gemm_phase<EpiNull, SchedMoe<true>, true, true, true>(F.lds, DFF, S, EN); }
        SEAM(7);
    }
    if (IN(8)) { F.g_final = ARG(17); moe_tables(F); p8_final(F); if (DUP_PHASE == 8) p8_final(F); }
#undef IN
#undef SEAM
}

#ifndef DEBUG_HYBRID
#ifndef MK_ONE_LAUNCH
#define MK_ONE_LAUNCH 1
#endif
extern "C" void kernel_launch(void* const* d_in, const int* in_sizes, int n_in, void* d_out, int out_size, void* d_ws, size_t ws_size, hipStream_t stream) {
    static int grid = 0;
    if (grid == 0) {
        if (n_in != 18 || out_size != MR * D || ws_size < WS_END) { fprintf(stderr, "kernel_launch: unexpected problem (n_in %d, out %d, ws %zu, need %zu)\n", n_in, out_size, ws_size, (size_t)WS_END); grid = -1; return; }
        int dev = 0, cus = 0, per_cu = 0;
        if (hipGetDevice(&dev) != hipSuccess || hipDeviceGetAttribute(&cus, hipDeviceAttributeMultiprocessorCount, dev) != hipSuccess) { grid = -1; return; }
        if (hipFuncSetAttribute((const void*)mk_fwd, hipFuncAttributeMaxDynamicSharedMemorySize, LDS_BYTES) != hipSuccess) { fprintf(stderr, "kernel_launch: hipFuncSetAttribute failed\n"); grid = -1; return; }
        if (hipOccupancyMaxActiveBlocksPerMultiprocessor(&per_cu, (const void*)mk_fwd, 512, LDS_BYTES) != hipSuccess || per_cu < 1) { fprintf(stderr, "kernel_launch: occupancy query says %d\n", per_cu); }
        (void)hipGetLastError();
        grid = cus;
    }
    if (grid < 0) return;
    if (hipMemsetAsync((char*)d_ws + WS_CTL, 0, CTL_ZERO_BYTES, stream) != hipSuccess) return;
    Args a{};
    for (int i = 0; i < 18; ++i) a.in[i] = (const float*)d_in[i];
    a.out = (float*)d_out; a.ws = (unsigned char*)d_ws;
#if MK_ONE_LAUNCH
    a.ph_lo = 0; a.ph_hi = NPH;
    hipLaunchKernelGGL(mk_fwd, dim3(grid), dim3(512), LDS_BYTES, stream, a);
#else
    for (int p = 0; p < NPH; ++p) { a.ph_lo = p; a.ph_hi = p + 1; hipLaunchKernelGGL(mk_fwd, dim3(grid), dim3(512), LDS_BYTES, stream, a); }
#endif
}
#endif
```

```cpp
#include <hip/hip_runtime.h>
#include <cstdio>
#include <cstdint>

#define GAS __attribute__((address_space(1)))
#define GLD(T, p) (*(const GAS T*)(p))
#define LAS __attribute__((address_space(3)))
typedef unsigned short bf16;
typedef short bf16x8 __attribute__((ext_vector_type(8)));
typedef short s16x4 __attribute__((ext_vector_type(4)));
typedef float f32x4 __attribute__((ext_vector_type(4)));
typedef float f32x16 __attribute__((ext_vector_type(16)));
typedef unsigned u32x4 __attribute__((ext_vector_type(4)));
typedef unsigned u32x2 __attribute__((ext_vector_type(2)));

constexpr int D = 2048, BATCH = 4, SEQ = 4096, NMETA = 16, LTOT = SEQ + NMETA;
constexpr int MR = BATCH * SEQ;
constexpr int ROWS = BATCH * LTOT;
constexpr int NH = 8, HD = 128, AW = 1024, CC = 1024, NE = 32, TOPK = 4, DFF = 2048, INW = 10240;
constexpr int O_U = 0, O_B = 1024, O_C = 2048, O_Q = 3072, O_K = 4096, O_V = 5120, O_GC = 6144, O_GA = 8192;
constexpr float EPS = 1e-5f;
constexpr int SLOT_CAP = 16384;
constexpr int MAXT = MR * TOPK / 256 + NE;
constexpr int NPH = 9;

constexpr size_t MiB = 1u << 20;
constexpr size_t WS_CTL = 0, CTL_ZERO_BYTES = 1 * MiB;
constexpr size_t WS_WIN = 1 * MiB;
constexpr size_t WS_WCONV = WS_WIN + 40 * MiB;
constexpr size_t WS_WATTN = WS_WCONV + 4 * MiB;
constexpr size_t WS_WO = WS_WATTN + 4 * MiB;
constexpr size_t WS_WRF = WS_WO + 8 * MiB;
constexpr size_t WS_HM = WS_WRF + 1 * MiB;
constexpr size_t WS_WG = WS_HM + 1 * MiB;
constexpr size_t WS_WU = WS_WG + 256 * MiB;
constexpr size_t WS_WD = WS_WU + 256 * MiB;
constexpr size_t WS_HRES2 = WS_WD + 256 * MiB;
constexpr size_t WS_XB = WS_HRES2 + 64 * MiB;
constexpr size_t WS_HG = WS_HRES2 + 128 * MiB;
constexpr size_t WS_TOKOF = WS_HG + 64 * MiB;
constexpr size_t WS_RSTDOF = WS_TOKOF + 2 * MiB;
constexpr size_t WS_CWOF = WS_RSTDOF + 2 * MiB;
constexpr size_t WS_TOKSLOT = WS_CWOF + 2 * MiB;
constexpr size_t WS_Y = WS_TOKSLOT + 1 * MiB;
constexpr size_t WS_X = WS_Y + 288 * MiB;
constexpr size_t WS_HN = WS_X;
constexpr size_t WS_YCIN = WS_X, WS_O = WS_X + 32 * MiB;
constexpr size_t WS_CU = WS_X + 64 * MiB;
constexpr size_t WS_BP = WS_CU + 33 * MiB;
constexpr size_t WS_Q = WS_BP + 32 * MiB;
constexpr size_t WS_K = WS_Q + 32 * MiB;
constexpr size_t WS_V = WS_K + 33 * MiB;
constexpr size_t WS_GC = WS_V + 33 * MiB;
constexpr size_t WS_GA = WS_GC + 64 * MiB;
constexpr size_t WS_MERGED = WS_GA + 64 * MiB;
constexpr size_t WS_HN8 = WS_MERGED + 64 * MiB;
constexpr size_t WS_WIN8 = WS_HN8 + 32 * MiB;
constexpr size_t WS_X_END1 = WS_WIN8 + 8 * MiB;
constexpr size_t WS_ACT = WS_X;
constexpr size_t WS_X_END2 = WS_ACT + 288 * MiB;
constexpr size_t WS_END = WS_X_END1 > WS_X_END2 ? WS_X_END1 : WS_X_END2;
static_assert((size_t)MAXT * 256 * D * 2 <= 288 * MiB, "act/Y size");
constexpr int CW_BAR = 1024;
constexpr int CW_CNT = 8192;

constexpr int RING_BYTES = 131072;
constexpr int LDS_TBL = RING_BYTES;
constexpr int LDS_MISC = RING_BYTES + 1024;
constexpr int LDS_UNITS = RING_BYTES + 2048;
constexpr int LDS_CVRING = RING_BYTES + 4096;
constexpr int LDS_BYTES = 159744;

#define LDS_WAIT() asm volatile("s_waitcnt lgkmcnt(0)" ::: "memory")
#define VM_WAIT() asm volatile("s_waitcnt vmcnt(0)" ::: "memory")
__device__ __forceinline__ unsigned f2bf(float f) { unsigned u = __builtin_bit_cast(unsigned, f); return (u + 0x7fffu + ((u >> 16) & 1u)) >> 16; }

typedef float f32x2_t __attribute__((ext_vector_type(2)));
typedef __bf16 bf16x2_t __attribute__((ext_vector_type(2)));
__device__ __forceinline__ unsigned cvt_pk_bf16(float lo, float hi) { const f32x2_t v = {lo, hi}; return __builtin_bit_cast(unsigned, __builtin_convertvector(v, bf16x2_t)); }
__device__ __forceinline__ unsigned pk2(float lo, float hi) { return cvt_pk_bf16(lo, hi); }
__device__ __forceinline__ unsigned cvt4_fp8(float a, float b, float c, float d) { int p = __builtin_amdgcn_cvt_pk_fp8_f32(a, b, 0, false); p = __builtin_amdgcn_cvt_pk_fp8_f32(c, d, p, true); return (unsigned)p; }
__device__ __forceinline__ float bf_lo(unsigned w) { return __builtin_bit_cast(float, w << 16); }
__device__ __forceinline__ float bf_hi(unsigned w) { return __builtin_bit_cast(float, w & 0xffff0000u); }
__device__ __forceinline__ float wave_sum(float v) {
#pragma unroll
    for (int o = 1; o < 64; o <<= 1) v += __shfl_xor(v, o);
    return v;
}
__device__ __forceinline__ float fast_sigmoid(float x) { return __builtin_amdgcn_rcpf(1.f + __expf(-x)); }

#define XB_TMO      128
#define XB_XCNT(j)  (256  + 64 * (j))
#define XB_XSUB(j)  (1280 + 64 * (j))
#define XB_XGEN(j)  (2304 + 64 * (j))
#define XB_TOP      3328
#define XB_TOPGEN   3392
#define XCD_BAR_WORDS 3456
#define XB_SPIN_CAP (1u << 18)
__device__ __forceinline__ unsigned xb_ld(unsigned* p)              { return __hip_atomic_load(p, __ATOMIC_RELAXED, __HIP_MEMORY_SCOPE_AGENT); }
__device__ __forceinline__ unsigned xb_add(unsigned* p, unsigned v) { return __hip_atomic_fetch_add(p, v, __ATOMIC_RELAXED, __HIP_MEMORY_SCOPE_AGENT); }
__device__ __forceinline__ unsigned xb_xcc_id() { return (unsigned)__builtin_amdgcn_s_getreg((3 << 11) | 20) & 0xFu; }
#define XB_SPIN(cond, bar) do { unsigned _sp = 0; while (cond) { __builtin_amdgcn_s_sleep(1); \
    if ((++_sp & 255u) == 0u) { if (xb_ld(&(bar)[XB_TMO])) break; if (_sp > XB_SPIN_CAP) { atomicAdd(&(bar)[XB_TMO], 1u); break; } } } } while (0)
struct XcdBarrier { unsigned* bar; unsigned x; volatile LAS unsigned* st; };
__device__ __forceinline__ XcdBarrier xcd_barrier_post(unsigned* bar, volatile LAS unsigned* st) {
    XcdBarrier b; b.bar = bar; b.x = xb_xcc_id(); b.st = st;
    if (threadIdx.x == 0) (void)xb_add(&bar[XB_XCNT(b.x)], 1u);
    return b;
}
__device__ __forceinline__ void xcd_barrier_complete(unsigned* bar, unsigned x, unsigned& nloc, unsigned& nx) {
    const unsigned G = gridDim.x * gridDim.y * gridDim.z;
    unsigned sum, cnt, mine, sp = 0u;
    for (;;) {
        sum = 0u; cnt = 0u; mine = 0u;
#pragma unroll
        for (unsigned j = 0; j < 16; ++j) { const unsigned c = xb_ld(&bar[XB_XCNT(j)]); sum += c; cnt += (c > 0u) ? 1u : 0u; mine = (j == x) ? c : mine; }
        if (sum == G) break;
        __builtin_amdgcn_s_sleep(1);
        if ((++sp & 255u) == 0u) { if (xb_ld(&bar[XB_TMO])) break; if (sp > XB_SPIN_CAP) { atomicAdd(&bar[XB_TMO], 1u); break; } }
    }
    nloc = mine > 0u ? mine : 1u; nx = cnt > 0u ? cnt : 1u;
}
__device__ __forceinline__ void xcd_barrier(const XcdBarrier& b) {
    asm volatile("s_waitcnt vmcnt(0)" ::: "memory");
    __syncthreads();
    if (threadIdx.x == 0) {
        unsigned* bar = b.bar;
        __builtin_amdgcn_s_waitcnt(0);
        unsigned nloc = b.st[0], nx = b.st[1];
        if (nloc == 0u) { xcd_barrier_complete(bar, b.x, nloc, nx); b.st[0] = nloc; b.st[1] = nx; }
        const unsigned old = xb_add(&bar[XB_XSUB(b.x)], 1u);
        const unsigned gen = old / nloc;
        if (old + 1u == (gen + 1u) * nloc) {
            __builtin_amdgcn_fence(__ATOMIC_RELEASE, "agent");
            asm volatile("s_waitcnt vmcnt(0)" ::: "memory");
            const unsigned og = xb_add(&bar[XB_TOP], 1u);
            const unsigned tg = og / nx;
            if (og + 1u == (tg + 1u) * nx) xb_add(&bar[XB_TOPGEN], 1u);
            else XB_SPIN(xb_ld(&bar[XB_TOPGEN]) == tg, bar);
            __builtin_amdgcn_fence(__ATOMIC_ACQUIRE, "agent");
            xb_add(&bar[XB_XGEN(b.x)], 1u);
            asm volatile("s_waitcnt vmcnt(0)" ::: "memory");
        } else {
            XB_SPIN(xb_ld(&bar[XB_XGEN(b.x)]) == gen, bar);
            __builtin_amdgcn_fence(__ATOMIC_ACQUIRE, "agent");
            asm volatile("s_waitcnt vmcnt(0)" ::: "memory");
        }
    }
    __syncthreads();
}

namespace pg8 {
constexpr int BM = 256, BK = 64, HALF = 128, HTB = HALF * BK * 2, STAGE_BYTES = 8 * HTB, NXCD = 8, WGM = 4;
__host__ __device__ __forceinline__ int lds_byte(int r, int c) { const int st = (r >> 4) * 2 + (c >> 5), rr = r & 15, cc = c & 31, ob = rr * 64 + cc * 2; return st * 1024 + (ob ^ (((ob >> 9) & 1) << 5)); }
__host__ __device__ __forceinline__ void stage_rc(int b, int& R, int& C) { const int st = b / 1024, sb = b % 1024, swz = sb ^ (((sb >> 9) & 1) << 5); R = (st >> 1) * 16 + swz / 64; C = (st & 1) * 32 + (swz % 64) / 2; }
__host__ __device__ __forceinline__ int perm32(int rho) { const int n = rho >> 4, i = rho & 15; return 8 * (i >> 2) + 4 * n + (i & 3); }
__host__ __device__ __forceinline__ int perm32w(int rho) { const int n = rho >> 4, i = rho & 15; return 16 * ((i >> 2) & 1) + 8 * (i >> 3) + 4 * n + (i & 3); }
template <class E, class = void> struct epi_wide { static constexpr bool value = false; };
template <class E> struct epi_wide<E, decltype((void)E::WIDE)> { static constexpr bool value = E::WIDE; };
template <class E, class = void> struct epi_relax { static constexpr bool value = false; };
template <class E> struct epi_relax<E, decltype((void)E::RELAX)> { static constexpr bool value = E::RELAX; };

struct Unit {
    int pm, pn;
    int kind, e, nrow, aux;
    const char* A;
    const char* B0;
    const char* B1;
    char* dst; int ld;
};
__device__ __forceinline__ bool static_tile(int L, int nM, int nN, int& pm, int& pn, const int WGM = pg8::WGM) {
    const int nwg = nM * nN; if (L >= nwg) return false;
    int wgid = L; { const int q = nwg / NXCD, r = nwg % NXCD, xcd = wgid % NXCD, off = wgid / NXCD; wgid = (xcd < r ? xcd * (q + 1) : r * (q + 1) + (xcd - r) * q) + off; }
    const int nig = WGM * nN, gid = wgid / nig, fm = gid * WGM, gsz = (nM - fm) < WGM ? (nM - fm) : WGM;
    pm = fm + ((wgid % nig) % gsz); pn = (wgid % nig) / gsz; return true;
}

typedef int v8i32 __attribute__((ext_vector_type(8)));
typedef int v4i32 __attribute__((ext_vector_type(4)));
template <bool FP8> struct Frag;
template <> struct Frag<false> { bf16x8 k[2]; };
template <> struct Frag<true> { v8i32 v; };
__device__ __forceinline__ void load_frag(Frag<false>& f, const LAS unsigned char* p) { f.k[0] = *(const LAS bf16x8*)p; f.k[1] = *(const LAS bf16x8*)(p + 1024); }
__device__ __forceinline__ void load_frag(Frag<true>& f, const LAS unsigned char* p) { const v4i32 lo = *(const LAS v4i32*)p, hi = *(const LAS v4i32*)(p + 1024); f.v = __builtin_shufflevector(lo, hi, 0, 1, 2, 3, 4, 5, 6, 7); }
__device__ __forceinline__ void mma_frag(f32x4& c, const Frag<false>& b, const Frag<false>& a) {
    c = __builtin_amdgcn_mfma_f32_16x16x32_bf16(b.k[0], a.k[0], c, 0, 0, 0); c = __builtin_amdgcn_mfma_f32_16x16x32_bf16(b.k[1], a.k[1], c, 0, 0, 0); }
__device__ __forceinline__ void mma_block(f32x4 (&c)[4][2], const Frag<false> (&a)[4], const Frag<false> (&b)[2]) {
#pragma unroll
    for (int m = 0; m < 4; ++m)
#pragma unroll
        for (int n = 0; n < 2; ++n) { c[m][n] = __builtin_amdgcn_mfma_f32_16x16x32_bf16(b[n].k[0], a[m].k[0], c[m][n], 0, 0, 0); c[m][n] = __builtin_amdgcn_mfma_f32_16x16x32_bf16(b[n].k[1], a[m].k[1], c[m][n], 0, 0, 0); }
}
__device__ __forceinline__ void mma_block(f32x4 (&c)[4][2], const Frag<true> (&a)[4], const Frag<true> (&b)[2]) {
#if defined(__HIP_DEVICE_COMPILE__)
    const int sc = 0x7c7c7c7c;
    asm volatile("s_nop 1\n\t"
                 "v_mfma_scale_f32_16x16x128_f8f6f4 %0, %12, %8, %0, %14, %14 op_sel_hi:[0,0,0]\n\t"
                 "v_mfma_scale_f32_16x16x128_f8f6f4 %1, %13, %8, %1, %14, %14 op_sel_hi:[0,0,0]\n\t"
                 "v_mfma_scale_f32_16x16x128_f8f6f4 %2, %12, %9, %2, %14, %14 op_sel_hi:[0,0,0]\n\t"
                 "v_mfma_scale_f32_16x16x128_f8f6f4 %3, %13, %9, %3, %14, %14 op_sel_hi:[0,0,0]\n\t"
                 "v_mfma_scale_f32_16x16x128_f8f6f4 %4, %12, %10, %4, %14, %14 op_sel_hi:[0,0,0]\n\t"
                 "v_mfma_scale_f32_16x16x128_f8f6f4 %5, %13, %10, %5, %14, %14 op_sel_hi:[0,0,0]\n\t"
                 "v_mfma_scale_f32_16x16x128_f8f6f4 %6, %12, %11, %6, %14, %14 op_sel_hi:[0,0,0]\n\t"
                 "v_mfma_scale_f32_16x16x128_f8f6f4 %7, %13, %11, %7, %14, %14 op_sel_hi:[0,0,0]"
                 : "+v"(c[0][0]), "+v"(c[0][1]), "+v"(c[1][0]), "+v"(c[1][1]), "+v"(c[2][0]), "+v"(c[2][1]), "+v"(c[3][0]), "+v"(c[3][1])
                 : "v"(a[0].v), "v"(a[1].v), "v"(a[2].v), "v"(a[3].v), "v"(b[0].v), "v"(b[1].v), "v"(sc));
#endif
}
__device__ __forceinline__ void mma_frag(f32x4& c, const Frag<true>& b, const Frag<true>& a) {
    c = __builtin_amdgcn_mfma_scale_f32_16x16x128_f8f6f4(b.v, a.v, c, 0, 0, 0, 0x79797979, 0, 0x7f7f7f7f); }
struct NoConv { static constexpr int MODE = 0; __device__ __forceinline__ void prime() {} __device__ __forceinline__ void issue() {} __device__ __forceinline__ void reads() {} __device__ __forceinline__ void pack() {} template <int J> __device__ __forceinline__ void store() {} __device__ __forceinline__ void drain() {} };
template <class Epi, class Sched, bool ALIGN_EPI, bool SP2, bool FP8 = false, class Conv = NoConv>
__device__ __forceinline__ void gemm_phase(LAS unsigned char* lds, const int K, const Sched& S, const Epi& E, Conv cv = Conv()) {
    const int tid = threadIdx.x, wid = __builtin_amdgcn_readfirstlane(tid >> 6), lane = tid & 63, wr = wid >> 2, wc = wid & 3, fr = lane & 15, fq = lane >> 4;
    const int nt = FP8 ? K / 128 : K / BK;
    int Rr[2], Cc[2]; unsigned voffB[2];
#pragma unroll
    for (int i = 0; i < 2; ++i) { stage_rc(tid * 16 + i * 8192, Rr[i], Cc[i]); const int Rb = Epi::PERM ? ((Rr[i] & ~31) + (epi_wide<Epi>::value ? perm32w(Rr[i] & 31) : perm32(Rr[i] & 31))) : Rr[i]; voffB[i] = FP8 ? (unsigned)(Rb * K) + (unsigned)Cc[i] * 2u : (unsigned)(Rb * K + Cc[i]) * 2u; }
    const size_t kstep = (size_t)(BK * 2);
    const unsigned ldsw = (unsigned)wid * 1024u;
    const int aoff = lds_byte(wr * 64 + fr, fq * 8), boff = lds_byte(wc * 32 + fr, fq * 8);
#define PG8_SA(b, h) (((b) * 2 + (h)) * HTB)
#define PG8_SB(b, h) ((4 + (b) * 2 + (h)) * HTB)
#define PG8_STAGE(bufoff, gbase, voff) do { _Pragma("unroll") for (int _i = 0; _i < 2; ++_i) \
        __builtin_amdgcn_global_load_lds((const unsigned*)((const char*)(gbase) + (voff)[_i]), (LAS unsigned*)(lds + (bufoff) + ldsw + _i * 8192), 16, 0, 0); } while (0)
#define PG8_LDA(dst, b, h) do { _Pragma("unroll") for (int m = 0; m < 4; ++m) load_frag(dst[m], lds + PG8_SA(b, h) + aoff + m * 2048); } while (0)
#define PG8_LDB(dst, b, h) do { _Pragma("unroll") for (int n = 0; n < 2; ++n) load_frag(dst[n], lds + PG8_SB(b, h) + boff + n * 2048); } while (0)
#define PG8_MMA(ai, bj, At, Bt) do { __builtin_amdgcn_s_setprio(1); mma_block(acc[ai][bj], At, Bt); __builtin_amdgcn_s_setprio(0); } while (0)
#define PG8_WAIT_V(n) asm volatile("s_waitcnt vmcnt(" #n ")" ::: "memory")
#define PG8_WAIT_L(n) asm volatile("s_waitcnt lgkmcnt(" #n ")" ::: "memory")
#define PG8_WAIT_K() do { if constexpr (Conv::MODE == 0) PG8_WAIT_V(8); else if constexpr (Conv::MODE == 1) PG8_WAIT_V(9); else PG8_WAIT_V(10); } while (0)
#define PG8_BAR __builtin_amdgcn_s_barrier()
#define PG8_SCHED __builtin_amdgcn_sched_barrier(0)
    constexpr bool GATHER = Sched::AROW_LOADS;
    constexpr bool RELAX = SP2 && Conv::MODE == 0 && epi_relax<Epi>::value;
#define PG8_AOFFS(dst, u) do { if constexpr (GATHER) { _Pragma("unroll") for (int _h = 0; _h < 2; ++_h) _Pragma("unroll") for (int _i = 0; _i < 2; ++_i) dst[_h][_i] = S.arow(u, _h * HALF + Rr[_i]) + (unsigned)Cc[_i] * 2u; \
        asm volatile("" : "+v"(dst[0][0]), "+v"(dst[0][1]), "+v"(dst[1][0]), "+v"(dst[1][1])); } } while (0)
#define PG8_STAGE_A(bufoff, gbase, h, offs) do { if constexpr (GATHER) { PG8_STAGE(bufoff, gbase, (offs)[h]); } else { PG8_STAGE(bufoff, (gbase) + (h) * hstepA, voffA); } } while (0)
    int ui = 0;
    Unit cur;
    if (!S.next(0, cur)) return;
    f32x4 acc[2][2][4][2];
#pragma unroll
    for (int a = 0; a < 2; ++a)
#pragma unroll
        for (int b = 0; b < 2; ++b)
#pragma unroll
            for (int m = 0; m < 4; ++m)
#pragma unroll
                for (int n = 0; n < 2; ++n) acc[a][b][m][n] = (f32x4){0.f, 0.f, 0.f, 0.f};
    Frag<FP8> At[4], B0[2], B1[2];
    unsigned oA[2][2], oAn[2][2], voffA[2];
    const size_t hstepA = GATHER ? 0 : (size_t)S.hstepA();
#pragma unroll
    for (int i = 0; i < 2; ++i) { voffA[i] = GATHER ? 0u : S.arow(cur, Rr[i]) + (unsigned)Cc[i] * 2u; oA[0][i] = oA[1][i] = oAn[0][i] = oAn[1][i] = 0u; }
    PG8_AOFFS(oA, cur);
    const char* cA = cur.A; const char* cB0 = cur.B0; const char* cB1 = cur.B1;
    cv.prime();
    if constexpr (SP2) {
        PG8_STAGE(PG8_SB(0, 0), cB0, voffB); PG8_STAGE(PG8_SB(0, 1), cB1, voffB); PG8_STAGE_A(PG8_SA(0, 0), cA, 0, oA); PG8_STAGE_A(PG8_SA(0, 1), cA, 1, oA);
        if (wr == 1) PG8_BAR;
        PG8_WAIT_V(2); PG8_BAR;
        PG8_STAGE(PG8_SB(1, 0), cB0 + kstep, voffB); PG8_STAGE_A(PG8_SA(1, 0), cA + kstep, 0, oA); PG8_STAGE(PG8_SB(1, 1), cB1 + kstep, voffB);
        PG8_WAIT_V(6); PG8_BAR;
    } else {
        PG8_STAGE(PG8_SB(0, 0), cB0, voffB); PG8_STAGE_A(PG8_SA(0, 0), cA, 0, oA); PG8_STAGE(PG8_SB(0, 1), cB1, voffB); PG8_STAGE_A(PG8_SA(0, 1), cA, 1, oA);
        if (wr == 1) PG8_BAR;
        PG8_WAIT_V(4); PG8_BAR;
        PG8_STAGE(PG8_SB(1, 0), cB0 + kstep, voffB); PG8_STAGE_A(PG8_SA(1, 0), cA + kstep, 0, oA); PG8_STAGE(PG8_SB(1, 1), cB1 + kstep, voffB);
        PG8_WAIT_V(6); PG8_BAR;
    }
    for (;;) {
        bool has_next = false; const char* nA = cA; const char* nB0 = cB0; const char* nB1 = cB1;
#define PG8_NEXT_UNIT() do { if (t == 0) { Unit nxt; has_next = S.next(ui + 1, nxt); if (has_next) { nA = nxt.A; nB0 = nxt.B0; nB1 = nxt.B1; PG8_AOFFS(oAn, nxt); } else { \
            _Pragma("unroll") for (int _h = 0; _h < 2; ++_h) _Pragma("unroll") for (int _i = 0; _i < 2; ++_i) oAn[_h][_i] = oA[_h][_i]; } } } while (0)
        { const int t = 0; PG8_NEXT_UNIT(); }
        for (int t = 0; t < nt; t += 2) {
            const bool last = (t == nt - 2);
            const char* a1 = cA + (size_t)(t + 1) * kstep;
            const char* a2 = last ? nA : cA + (size_t)(t + 2) * kstep;
            const char* b20 = last ? nB0 : cB0 + (size_t)(t + 2) * kstep; const char* b21 = last ? nB1 : cB1 + (size_t)(t + 2) * kstep;
            const char* a3 = a2 + kstep; const char* b30 = b20 + kstep; const char* b31 = b21 + kstep;
            unsigned s2[2][2];
#pragma unroll
            for (int h = 0; h < 2; ++h)
#pragma unroll
                for (int i = 0; i < 2; ++i) s2[h][i] = last ? oAn[h][i] : oA[h][i];
            if constexpr (SP2) {
            const bool relaxed = RELAX && ui > 0 && t == 0;
            cv.issue(); PG8_LDB(B0, 0, 0); PG8_LDB(B1, 0, 1); PG8_SCHED; PG8_LDA(At, 0, 0); if (!relaxed) PG8_STAGE_A(PG8_SA(1, 1), a1, 1, oA); cv.reads();
            if (!relaxed) PG8_WAIT_K(); PG8_WAIT_L(0); PG8_BAR; PG8_MMA(0, 0, At, B0); PG8_MMA(0, 1, At, B1); cv.template store<0>(); PG8_BAR; PG8_SCHED;
            cv.issue(); PG8_LDA(At, 0, 1); PG8_STAGE(PG8_SB(0, 0), b20, voffB); PG8_STAGE(PG8_SB(0, 1), b21, voffB); PG8_STAGE_A(PG8_SA(0, 0), a2, 0, s2); cv.reads();
            if (!relaxed) PG8_WAIT_K(); PG8_WAIT_L(0); PG8_BAR; PG8_MMA(1, 0, At, B0); PG8_MMA(1, 1, At, B1); cv.template store<1>(); PG8_BAR; PG8_SCHED;
            cv.issue(); PG8_LDB(B0, 1, 0); PG8_LDB(B1, 1, 1); PG8_SCHED; PG8_LDA(At, 1, 0); PG8_STAGE_A(PG8_SA(0, 1), a2, 1, s2); cv.reads();
            if (!relaxed) PG8_WAIT_K(); PG8_WAIT_L(0); PG8_BAR; PG8_MMA(0, 0, At, B0); PG8_MMA(0, 1, At, B1); cv.template store<2>(); PG8_BAR; PG8_SCHED;
            cv.issue(); PG8_LDA(At, 1, 1); PG8_STAGE(PG8_SB(1, 0), b30, voffB); PG8_STAGE(PG8_SB(1, 1), b31, voffB); PG8_STAGE_A(PG8_SA(1, 0), a3, 0, s2); cv.reads();
            PG8_WAIT_K(); PG8_WAIT_L(0); PG8_BAR; PG8_MMA(1, 0, At, B0); PG8_MMA(1, 1, At, B1); cv.template store<3>(); PG8_BAR; PG8_SCHED;
            } else {
            PG8_LDB(B0, 0, 0); PG8_SCHED; PG8_LDA(At, 0, 0); PG8_STAGE_A(PG8_SA(1, 1), a1, 1, oA);
            PG8_WAIT_L(8); PG8_BAR; PG8_WAIT_L(0); PG8_MMA(0, 0, At, B0); PG8_BAR; PG8_SCHED;
            PG8_LDB(B1, 0, 1); PG8_STAGE(PG8_SB(0, 0), b20, voffB);
            PG8_BAR; PG8_WAIT_L(0); PG8_MMA(0, 1, At, B1); PG8_BAR;
            PG8_LDA(At, 0, 1); PG8_STAGE_A(PG8_SA(0, 0), a2, 0, s2);
            PG8_BAR; PG8_WAIT_L(0); PG8_MMA(1, 0, At, B0); PG8_BAR; PG8_SCHED;
            PG8_STAGE(PG8_SB(0, 1), b21, voffB);
            PG8_WAIT_V(6); PG8_BAR; PG8_MMA(1, 1, At, B1); PG8_BAR;
            PG8_LDB(B0, 1, 0); PG8_SCHED; PG8_LDA(At, 1, 0); PG8_STAGE_A(PG8_SA(0, 1), a2, 1, s2);
            PG8_WAIT_L(8); PG8_BAR; PG8_WAIT_L(0); PG8_MMA(0, 0, At, B0); PG8_BAR; PG8_SCHED;
            PG8_LDB(B1, 1, 1); PG8_STAGE(PG8_SB(1, 0), b30, voffB);
            PG8_BAR; PG8_WAIT_L(0); PG8_MMA(0, 1, At, B1); PG8_BAR;
            PG8_LDA(At, 1, 1); PG8_STAGE_A(PG8_SA(1, 0), a3, 0, s2);
            PG8_BAR; PG8_WAIT_L(0); PG8_MMA(1, 0, At, B0); PG8_BAR; PG8_SCHED;
            PG8_STAGE(PG8_SB(1, 1), b31, voffB);
            PG8_WAIT_V(6); PG8_BAR; PG8_MMA(1, 1, At, B1); PG8_BAR;
            }
        }
        if constexpr (RELAX) { if (has_next) PG8_STAGE_A(PG8_SA(1, 1), nA + kstep, 1, oAn); }
        if constexpr (ALIGN_EPI) { if (wr == 0) PG8_BAR; }
        if constexpr (FP8) asm volatile("s_nop 15\n\ts_nop 7" ::: "memory");
        bool chained = false;
        { Unit eu; (void)S.next(ui, eu);
          if constexpr (Epi::CHAIN) { if (eu.kind == 0) { E.mid(acc, eu, wr, wc, fr, fq); chained = true; } else E(acc, eu, wr, wc, fr, fq); }
          else E(acc, eu, wr, wc, fr, fq); }
        if (!has_next) break;
        if (!chained) {
#pragma unroll
        for (int a = 0; a < 2; ++a)
#pragma unroll
            for (int b = 0; b < 2; ++b)
#pragma unroll
                for (int m = 0; m < 4; ++m)
#pragma unroll
                    for (int n = 0; n < 2; ++n) acc[a][b][m][n] = (f32x4){0.f, 0.f, 0.f, 0.f};
        }
        cA = nA; cB0 = nB0; cB1 = nB1; ++ui;
#pragma unroll
        for (int h = 0; h < 2; ++h)
#pragma unroll
            for (int i = 0; i < 2; ++i) oA[h][i] = oAn[h][i];
        if constexpr (ALIGN_EPI) { if (wr == 1) PG8_BAR; }
    }
    PG8_WAIT_V(0);
    if constexpr (!ALIGN_EPI) { if (wr == 0) PG8_BAR; }
    PG8_BAR;
    cv.drain();
#undef PG8_SA
#undef PG8_SB
#undef PG8_STAGE
#undef PG8_LDA
#undef PG8_LDB
#undef PG8_MMA
#undef PG8_WAIT_V
#undef PG8_WAIT_L
#undef PG8_WAIT_K
#undef PG8_BAR
#undef PG8_SCHED
#undef PG8_AOFFS
#undef PG8_NEXT_UNIT
#undef PG8_STAGE_A
}
}
using pg8::Unit;

struct Args { const float* in[18]; float* out; unsigned char* ws; int ph_lo, ph_hi; };
struct Frame {
    LAS unsigned char* lds;
    int tid, lane, wave, vcu, G;
    const float *x, *meta, *g_mix, *w_in, *conv_w, *w_conv_out, *w_attn_out, *w_o, *g_ffn, *w_router, *b_router, *w_gate, *b_gate, *w_up, *b_up, *w_down, *b_down, *g_final;
    float* out; unsigned char* ws; unsigned* ctl;
};
#define WSP(T, off) ((T*)(F.ws + (off)))

__device__ __forceinline__ void p0_item_load(const float* W, int N, int item, int lane, f32x4 (&v)[8], int ldn = 0) {
    const int nblk = N / 32, kb = item / nblk, nb = item % nblk, k0 = 64 * kb, n0 = 32 * nb; const int ld = ldn ? ldn : N;
#pragma unroll
    for (int i = 0; i < 8; ++i) { const int p = 64 * i + lane; v[i] = *(const GAS f32x4*)(W + (size_t)(k0 + (p >> 3)) * ld + n0 + 4 * (p & 7)); }
}
__device__ __forceinline__ void p0_item_finish(const f32x4 (&v)[8], int K, int N, bf16* WT, LAS float* scr, int item, int lane) {
    const int nblk = N / 32, kb = item / nblk, nb = item % nblk, k0 = 64 * kb, n0 = 32 * nb;
#pragma unroll
    for (int i = 0; i < 8; ++i) { const int p = 64 * i + lane; LAS float* d = scr + (p >> 3) * 33 + 4 * (p & 7); d[0] = v[i][0]; d[1] = v[i][1]; d[2] = v[i][2]; d[3] = v[i][3]; }
    LDS_WAIT(); asm volatile("" ::: "memory");
    const int c = lane & 7;
#pragma unroll
    for (int j = 0; j < 4; ++j) { const int n = (lane >> 3) + 8 * j; const LAS float* s = scr + (8 * c) * 33 + n;
        u32x4 o; o.x = pk2(s[0 * 33], s[1 * 33]); o.y = pk2(s[2 * 33], s[3 * 33]); o.z = pk2(s[4 * 33], s[5 * 33]); o.w = pk2(s[6 * 33], s[7 * 33]);
        *(GAS u32x4*)(WT + (size_t)(n0 + n) * K + k0 + 8 * c) = o; }
    LDS_WAIT(); asm volatile("" ::: "memory");
}
__device__ __forceinline__ void p0_item_finish_fp8(const f32x4 (&v)[8], int K, int N, unsigned char* WT8, LAS float* scr, int item, int lane) {
    const int nblk = N / 32, kb = item / nblk, nb = item % nblk, k0 = 64 * kb, n0 = 32 * nb;
#pragma unroll
    for (int i = 0; i < 8; ++i) { const int p = 64 * i + lane; LAS float* d = scr + (p >> 3) * 33 + 4 * (p & 7); d[0] = v[i][0]; d[1] = v[i][1]; d[2] = v[i][2]; d[3] = v[i][3]; }
    LDS_WAIT(); asm volatile("" ::: "memory");
    const int c = lane & 3;
#pragma unroll
    for (int j = 0; j < 2; ++j) { const int n = (lane >> 2) + 16 * j; const LAS float* s = scr + (16 * c) * 33 + n;
        u32x4 o;
        o.x = cvt4_fp8(64.f * s[0 * 33], 64.f * s[1 * 33], 64.f * s[2 * 33], 64.f * s[3 * 33]);   o.y = cvt4_fp8(64.f * s[4 * 33], 64.f * s[5 * 33], 64.f * s[6 * 33], 64.f * s[7 * 33]);
        o.z = cvt4_fp8(64.f * s[8 * 33], 64.f * s[9 * 33], 64.f * s[10 * 33], 64.f * s[11 * 33]); o.w = cvt4_fp8(64.f * s[12 * 33], 64.f * s[13 * 33], 64.f * s[14 * 33], 64.f * s[15 * 33]);
        *(GAS u32x4*)(WT8 + (size_t)(n0 + n) * K + k0 + 16 * c) = o; }
    LDS_WAIT(); asm volatile("" ::: "memory");
}
__device__ __forceinline__ void p0_transpose_item(const float* W, int K, int N, bf16* WT, int row_off, LAS float* scr, int item, int lane) {
    f32x4 v[8]; p0_item_load(W, N, item, lane, v); p0_item_finish(v, K, N, WT + (size_t)row_off * K, scr, item, lane);
}
template <bool FP8>
__device__ __forceinline__ void p0_transpose_stream(const float* W, bf16* WT, int K, int N, int nmat, int gw, int NGW, LAS float* scr, int lane, int ldn = 0) {
    const int ipm = (K / 64) * (N / 32), total = nmat * ipm; const size_t msz = (size_t)K * N;
    for (int it = gw; it < total; it += 3 * NGW) {
        const int i1 = it + NGW, i2 = it + 2 * NGW;
        f32x4 va[8], vb[8], vc[8];
        p0_item_load(W + (size_t)(it / ipm) * msz, N, it % ipm, lane, va, ldn);
        if (i1 < total) p0_item_load(W + (size_t)(i1 / ipm) * msz, N, i1 % ipm, lane, vb, ldn);
        if (i2 < total) p0_item_load(W + (size_t)(i2 / ipm) * msz, N, i2 % ipm, lane, vc, ldn);
        if constexpr (FP8) p0_item_finish_fp8(va, K, N, (unsigned char*)WT + (size_t)(it / ipm) * msz, scr, it % ipm, lane); else p0_item_finish(va, K, N, WT + (size_t)(it / ipm) * msz, scr, it % ipm, lane);
        if (i1 < total) { if constexpr (FP8) p0_item_finish_fp8(vb, K, N, (unsigned char*)WT + (size_t)(i1 / ipm) * msz, scr, i1 % ipm, lane); else p0_item_finish(vb, K, N, WT + (size_t)(i1 / ipm) * msz, scr, i1 % ipm, lane); }
        if (i2 < total) { if constexpr (FP8) p0_item_finish_fp8(vc, K, N, (unsigned char*)WT + (size_t)(i2 / ipm) * msz, scr, i2 % ipm, lane); else p0_item_finish(vc, K, N, WT + (size_t)(i2 / ipm) * msz, scr, i2 % ipm, lane); }
    }
}
__device__ __forceinline__ void rms_row_to_bf16(const float* xrow, const float* g, bf16* orow, int lane, unsigned char* orow8 = nullptr, bf16* xbrow = nullptr) {
    const GAS f32x4* xr = (const GAS f32x4*)xrow + lane; const GAS f32x4* gr = (const GAS f32x4*)g + lane;
    f32x4 v[8]; float s = 0.f;
#pragma unroll
    for (int j = 0; j < 8; ++j) { v[j] = xr[64 * j]; s += (v[j].x * v[j].x + v[j].y * v[j].y) + (v[j].z * v[j].z + v[j].w * v[j].w); }
    if (xbrow) { GAS u32x2* xb8 = (GAS u32x2*)xbrow + lane;
#pragma unroll
        for (int j = 0; j < 8; ++j) { u32x2 w; w.x = pk2(v[j].x, v[j].y); w.y = pk2(v[j].z, v[j].w); xb8[64 * j] = w; } }
    const float rstd = rsqrtf(wave_sum(s) * (1.f / D) + EPS);
    GAS u32x2* o8 = (GAS u32x2*)orow + lane;
#pragma unroll
    for (int j = 0; j < 8; ++j) { const f32x4 gg = gr[64 * j]; const f32x4 y = {v[j].x * rstd * gg.x, v[j].y * rstd * gg.y, v[j].z * rstd * gg.z, v[j].w * rstd * gg.w};
        u32x2 w; w.x = pk2(y.x, y.y); w.y = pk2(y.z, y.w); o8[64 * j] = w;
        if (orow8) ((GAS unsigned*)orow8)[lane + 64 * j] = cvt4_fp8(y.x, y.y, y.z, y.w); }
}
__device__ __forceinline__ void p0_prologue(Frame& F, bool ride) {
    LAS float* scr = (LAS float*)(F.lds + F.wave * 16384);
    const int gw = F.vcu * 8 + F.wave, NGW = F.G * 8;
    if (!ride) {
    p0_transpose_stream<true>(F.w_gate, WSP(bf16, WS_WG), D, DFF, NE, gw, NGW, scr, F.lane);
    p0_transpose_stream<true>(F.w_up, WSP(bf16, WS_WU), D, DFF, NE, gw, NGW, scr, F.lane);
    p0_transpose_stream<true>(F.w_down, WSP(bf16, WS_WD), DFF, D, NE, gw, NGW, scr, F.lane);
    }
    p0_transpose_stream<false>(F.w_in, WSP(bf16, WS_WIN), D, O_GC, 1, gw, NGW, scr, F.lane, INW);
    p0_transpose_stream<true>(F.w_in + O_GC, WSP(bf16, WS_WIN8), D, INW - O_GC, 1, gw, NGW, scr, F.lane, INW);
    p0_transpose_stream<false>(F.w_conv_out, WSP(bf16, WS_WCONV), CC, D, 1, gw, NGW, scr, F.lane);
    p0_transpose_stream<false>(F.w_attn_out, WSP(bf16, WS_WATTN), AW, D, 1, gw, NGW, scr, F.lane);
    p0_transpose_stream<false>(F.w_o, WSP(bf16, WS_WO), D, D, 1, gw, NGW, scr, F.lane);
#ifdef PROBE_STREAM
    {
        f32x4 acc4 = {0.f, 0.f, 0.f, 0.f};
        const size_t n4 = (size_t)NE * D * DFF / 4;
        for (int w3 = 0; w3 < 3; ++w3) { const GAS f32x4* p = (const GAS f32x4*)(w3 == 0 ? F.w_gate : w3 == 1 ? F.w_up : F.w_down);
            for (size_t i = (size_t)gw * 64 + F.lane; i < n4; i += (size_t)NGW * 64 * 32) {
#pragma unroll
                for (int u = 0; u < 32; ++u) { const size_t j = i + (size_t)u * NGW * 64; if (j < n4) acc4 += p[j]; } } }
        if (acc4[0] + acc4[1] + acc4[2] + acc4[3] == 123456.789f) WSP(float, WS_HM)[1024 * 1024 / 4 - 1] = 1.f;
    }
#endif
    for (int m = gw; m < MR; m += NGW) rms_row_to_bf16(F.x + (size_t)m * D, F.g_mix, WSP(bf16, WS_HN) + (size_t)m * D, F.lane, WSP(unsigned char, WS_HN8) + (size_t)m * D, WSP(bf16, WS_XB) + (size_t)m * D);
    if (gw < NMETA) rms_row_to_bf16(F.meta + (size_t)gw * D, F.g_mix, WSP(bf16, WS_HM) + (size_t)gw * D, F.lane);
    for (int c = blockIdx.x * 512 + F.tid; c < 64 * 2 * 64; c += F.G * 512) {
        const int ln = c & 63, eb = (c >> 6) & 1, ks = c >> 7; const float* w = F.w_router + (size_t)(32 * ks + 8 * (ln >> 4)) * NE + 16 * eb + (ln & 15);
        u32x4 o; o.x = pk2(w[0], w[NE]); o.y = pk2(w[2 * NE], w[3 * NE]); o.z = pk2(w[4 * NE], w[5 * NE]); o.w = pk2(w[6 * NE], w[7 * NE]);
        *(WSP(u32x4, WS_WRF) + c) = o;
    }
}

template <class S> __device__ __forceinline__ void build_units(const S& sch, LAS int* ut) {
    const int lt = (int)__builtin_amdgcn_mbcnt_hi(~0u, __builtin_amdgcn_mbcnt_lo(~0u, 0u));
    if (__builtin_amdgcn_readfirstlane((int)threadIdx.x) < 64) { int f[8]; f[7] = 0; sch.coords(lt, f);
#pragma unroll
        for (int k = 0; k < 8; ++k) ut[8 * lt + k] = f[k]; }
    __syncthreads();
}
__device__ __forceinline__ bool read_unit(const LAS int* ut, int i, Unit& u) {
    if (i >= 64) return false;
    const LAS int* p = ut + 8 * i;
    if (__builtin_amdgcn_readfirstlane(p[0]) == 0) return false;
    u.pm = __builtin_amdgcn_readfirstlane(p[1]); u.pn = __builtin_amdgcn_readfirstlane(p[2]); u.kind = __builtin_amdgcn_readfirstlane(p[3]);
    u.e = __builtin_amdgcn_readfirstlane(p[4]); u.aux = __builtin_amdgcn_readfirstlane(p[5]); u.nrow = __builtin_amdgcn_readfirstlane(p[6]);
    return true;
}

template <int NB>
struct ConvW {
    static_assert(NB == 8, "one batch size");
    static constexpr int MODE = 1;
    const float* wg; const float* wu; const float* wd; unsigned char* w8; LAS unsigned char* ring; int gw, s_iss, s_con, s_end; unsigned voff, rdoff, dstoff; float x[4]; unsigned d[NB];
    __device__ __forceinline__ void one() {
        const int strip = (s_iss >> 7) * 2048 + gw, kg = s_iss & 127, mat = strip >> 7, nb = strip & 127;
        const float* W = (mat < 32 ? wg : mat < 64 ? wu : wd) + (size_t)(mat & 31) * D * DFF;
        const char* src = (const char*)W + (size_t)kg * (16 * 8192) + nb * 64;
        __builtin_amdgcn_global_load_lds((const unsigned*)(src + voff), (LAS unsigned*)(ring + (s_iss % 3) * 1024), 16, 0, 0);
        ++s_iss;
    }
    __device__ __forceinline__ void prime() { if (s_iss < s_end) one(); if (s_iss < s_end) one(); }
    __device__ __forceinline__ void issue() { if (s_iss < s_end) one(); }
    __device__ __forceinline__ void reads() { if (s_con < s_end) { const LAS float* p = (const LAS float*)(ring + (s_con % 3) * 1024 + rdoff); x[0] = p[0]; x[1] = p[16]; x[2] = p[32]; x[3] = p[48]; } }
    template <int J> __device__ __forceinline__ void store() { if (s_con < s_end) {
        const unsigned v = cvt4_fp8(64.f * x[0], 64.f * x[1], 64.f * x[2], 64.f * x[3]);
        const bool par = (s_con >> 2) & 1;
        if (par) d[4 + J] = v; else d[J] = v;
        if (J == 3 && par) {
            const int s0 = s_con - 7, strip = (s0 >> 7) * 2048 + gw, kg = s0 & 127, mat = strip >> 7, nb = strip & 127;
            unsigned char* dst = w8 + (size_t)(mat >> 5) * (256 * MiB) + (size_t)(mat & 31) * D * DFF + (size_t)nb * 16 * 2048 + kg * 16;
            const auto a0 = __builtin_amdgcn_permlane32_swap(d[0], d[2], false, false), a1 = __builtin_amdgcn_permlane32_swap(d[1], d[3], false, false);
            const auto a2 = __builtin_amdgcn_permlane32_swap(d[4], d[6], false, false), a3 = __builtin_amdgcn_permlane32_swap(d[5], d[7], false, false);
            const auto va0 = __builtin_amdgcn_permlane16_swap(a0[0], a1[0], false, false), vb0 = __builtin_amdgcn_permlane16_swap(a0[1], a1[1], false, false);
            const auto va1 = __builtin_amdgcn_permlane16_swap(a2[0], a3[0], false, false), vb1 = __builtin_amdgcn_permlane16_swap(a2[1], a3[1], false, false);
            u32x4 o0, o1; o0.x = va0[0]; o0.y = va0[1]; o0.z = vb0[0]; o0.w = vb0[1]; o1.x = va1[0]; o1.y = va1[1]; o1.z = vb1[0]; o1.w = vb1[1];
            *(GAS u32x4*)(dst + dstoff) = o0; *(GAS u32x4*)(dst + dstoff + 64) = o1; }
        ++s_con; } }
    __device__ __forceinline__ void drain() {}
};

struct ConvProbe {
    static constexpr int MODE = 1;
    const float* wg; const float* wu; const float* wd; LAS unsigned char* ring; int gw; unsigned voff; int s;
    __device__ __forceinline__ void one() {
        const int strip = gw * 3 + (s >> 8), kg = s & 255, mat = strip >> 6, nb = strip & 63;
        const float* W = (mat < 32 ? wg : mat < 64 ? wu : wd) + (size_t)(mat & 31) * D * DFF;
        const char* src = (const char*)W + (size_t)kg * 65536 + nb * 128;
        __builtin_amdgcn_global_load_lds((const unsigned*)(src + voff), (LAS unsigned*)(ring + (s % 3) * 1024), 16, 0, 0);
        ++s;
    }
    __device__ __forceinline__ void prime() { one(); one(); }
    __device__ __forceinline__ void issue() { if (s < 768) one(); else { const char* src = (const char*)wg; __builtin_amdgcn_global_load_lds((const unsigned*)(src + voff), (LAS unsigned*)(ring + (s % 3) * 1024), 16, 0, 0); ++s; } }
    __device__ __forceinline__ void reads() {} __device__ __forceinline__ void pack() {} template <int J> __device__ __forceinline__ void store() {} __device__ __forceinline__ void drain() {}
};

__device__ __forceinline__ void p1_meta(Frame& F) {
    const int fr = F.lane & 15, fq = F.lane >> 4;
    LAS f32x4* part = (LAS f32x4*)F.lds;
    for (int j = blockIdx.x; j < 192; j += F.G) {
        const int cb = j & 63, sp = j >> 6;
        const int c0 = 16 * cb;
        const bf16* hm = WSP(bf16, WS_HM) + (size_t)fr * D + 8 * fq + 256 * F.wave;
        const bf16* w0 = WSP(bf16, WS_WIN) + (size_t)((sp == 0 ? O_U : sp == 1 ? O_K : O_V) + c0 + fr) * D + 8 * fq + 256 * F.wave;
        const bf16* w1 = WSP(bf16, WS_WIN) + (size_t)(O_C + c0 + fr) * D + 8 * fq + 256 * F.wave;
        f32x4 a0 = {0.f, 0.f, 0.f, 0.f}, a1 = {0.f, 0.f, 0.f, 0.f};
        const bf16* w1p = sp == 0 ? w1 : w0;
        bf16x8 af[8], b0[8], b1[8];
#pragma unroll
        for (int s = 0; s < 8; ++s) { af[s] = *(const bf16x8*)(hm + 32 * s); b0[s] = *(const bf16x8*)(w0 + 32 * s); b1[s] = *(const bf16x8*)(w1p + 32 * s); }
#pragma unroll
        for (int s = 0; s < 8; ++s) { a0 = __builtin_amdgcn_mfma_f32_16x16x32_bf16(af[s], b0[s], a0, 0, 0, 0); a1 = __builtin_amdgcn_mfma_f32_16x16x32_bf16(af[s], b1[s], a1, 0, 0, 0); }
        part[(F.wave * 2 + 0) * 64 + F.lane] = a0; part[(F.wave * 2 + 1) * 64 + F.lane] = a1;
        __syncthreads();
        if (F.wave == 0) {
            a0 = part[F.lane]; a1 = part[64 + F.lane];
#pragma unroll
            for (int w = 1; w < 8; ++w) { a0 += part[(w * 2 + 0) * 64 + F.lane]; a1 += part[(w * 2 + 1) * 64 + F.lane]; }
            bf16* dst = WSP(bf16, sp == 0 ? WS_CU : sp == 1 ? WS_K : WS_V);
#pragma unroll
            for (int jj = 0; jj < 4; ++jj) { const int tok = 4 * fq + jj; const float v = sp == 0 ? a0[jj] * a1[jj] : a0[jj];
#pragma unroll
                for (int b = 0; b < BATCH; ++b) dst[(size_t)(b * LTOT + tok) * 1024 + c0 + fr] = (bf16)f2bf(v); }
        }
        __syncthreads();
    }
}
struct Sched1 {
    static constexpr bool AROW_LOADS = false;
    int G, c; unsigned char* ws; const LAS int* ut;
    __device__ __forceinline__ void coords(int i, int (&f)[8]) const { int pm = 0, pn = 0; f[0] = pg8::static_tile(i * G + c, MR / 256, 24, pm, pn) ? 1 : 0; f[1] = pm; f[2] = pn; f[3] = 0; f[4] = 0; f[5] = 0; f[6] = 256; }
    __device__ __forceinline__ bool next(int i, Unit& u) const {
        if (!read_unit(ut, i, u)) return false;
        const char* W = (const char*)(ws + WS_WIN);
        u.A = (const char*)(ws + WS_HN) + (size_t)u.pm * 256 * D * 2; u.e = 0; u.nrow = 256; u.aux = 0;
        if (u.pn < 8) { u.kind = 0; u.B0 = W + (size_t)(O_U + 128 * u.pn) * D * 2; u.B1 = W + (size_t)(O_C + 128 * u.pn) * D * 2; u.dst = (char*)(ws + WS_CU) + 256 * u.pn; u.ld = 1024; u.aux = 1; }
        else {
            const int col0 = u.pn < 12 ? O_B + (u.pn - 8) * 256 : O_Q + (u.pn - 12) * 256;
            u.B0 = W + (size_t)col0 * D * 2; u.B1 = u.B0 + (size_t)128 * D * 2; u.kind = 1;
            if (col0 < O_C) { u.dst = (char*)(ws + WS_BP) + (col0 - O_B) * 2; u.ld = 1024; }
            else if (col0 < O_K) { u.dst = (char*)(ws + WS_Q) + (col0 - O_Q) * 2; u.ld = 1024; u.kind = 2; }
            else if (col0 < O_V) { u.dst = (char*)(ws + WS_K) + (col0 - O_K) * 2; u.ld = 1024; u.aux = 1; }
            else if (col0 < O_GC) { u.dst = (char*)(ws + WS_V) + (col0 - O_V) * 2; u.ld = 1024; u.aux = 1; }
            else if (col0 < O_GA) { u.dst = (char*)(ws + WS_GC) + (col0 - O_GC) * 2; u.ld = 2048; }
            else { u.dst = (char*)(ws + WS_GA) + (col0 - O_GA) * 2; u.ld = 2048; }
        }
        return true;
    }
    __device__ __forceinline__ unsigned arow(const Unit&, int r) const { return (unsigned)r * (unsigned)(D * 2); }
    __device__ __forceinline__ unsigned hstepA() const { return 128u * D * 2u; }
};
struct Sched1g {
    static constexpr bool AROW_LOADS = false;
    int G, c; unsigned char* ws; const LAS int* ut;
    __device__ __forceinline__ void coords(int i, int (&f)[8]) const { int pm = 0, pn = 0; f[0] = pg8::static_tile(i * G + c, MR / 256, 16, pm, pn) ? 1 : 0; f[1] = pm; f[2] = pn; f[3] = 1; f[4] = 0; f[5] = 0; f[6] = 256; }
    __device__ __forceinline__ bool next(int i, Unit& u) const {
        if (!read_unit(ut, i, u)) return false;
        u.A = (const char*)(ws + WS_HN8) + (size_t)u.pm * 256 * D; u.e = 0; u.nrow = 256; u.aux = 0; u.kind = 1;
        u.B0 = (const char*)(ws + WS_WIN8) + (size_t)(128 * u.pn) * D; u.B1 = u.B0 + (size_t)2048 * D;
        u.dst = (char*)(ws + WS_GC) + (size_t)(128 * u.pn) * 2; u.ld = 2048;
        return true;
    }
    __device__ __forceinline__ unsigned arow(const Unit&, int r) const { return (unsigned)r * (unsigned)D; }
    __device__ __forceinline__ unsigned hstepA() const { return 128u * D; }
};
struct Epi1 {
    static constexpr bool PERM = true; static constexpr bool CHAIN = false;
    __device__ __forceinline__ void operator()(const f32x4 (&acc)[2][2][4][2], const Unit& u, int wr, int wc, int fr, int fq) const {
        const int m0 = u.pm * 256 + wr * 64 + fr; const int radd = u.aux ? NMETA * (m0 / SEQ + 1) : 0;
        const float sc = u.kind == 2 ? 0.08838834764831845f : 1.f;
#pragma unroll
        for (int ai = 0; ai < 2; ++ai)
#pragma unroll
            for (int m = 0; m < 4; ++m) {
                bf16* rowp = (bf16*)u.dst + (size_t)(m0 + radd + ai * 128 + m * 16) * u.ld + wc * 32 + 8 * fq;
                if (u.kind == 0) { const f32x4 v0 = acc[ai][0][m][0] * acc[ai][1][m][0], v1 = acc[ai][0][m][1] * acc[ai][1][m][1];
                    u32x4 w; w.x = cvt_pk_bf16(v0[0], v0[1]); w.y = cvt_pk_bf16(v0[2], v0[3]); w.z = cvt_pk_bf16(v1[0], v1[1]); w.w = cvt_pk_bf16(v1[2], v1[3]);
                    *(u32x4*)rowp = w; }
                else {
#pragma unroll
                    for (int bj = 0; bj < 2; ++bj) { const f32x4 v0 = acc[ai][bj][m][0] * sc, v1 = acc[ai][bj][m][1] * sc;
                        u32x4 w; w.x = cvt_pk_bf16(v0[0], v0[1]); w.y = cvt_pk_bf16(v0[2], v0[3]); w.z = cvt_pk_bf16(v1[0], v1[1]); w.w = cvt_pk_bf16(v1[2], v1[3]);
                        *(u32x4*)(rowp + bj * 128) = w; } }
            }
    }
};

struct Epi1g {
    static constexpr bool PERM = true; static constexpr bool CHAIN = false;
    __device__ __forceinline__ void operator()(const f32x4 (&acc)[2][2][4][2], const Unit& u, int wr, int wc, int fr, int fq) const {
        const int m0 = u.pm * 256 + wr * 64 + fr;
#pragma unroll
        for (int ai = 0; ai < 2; ++ai)
#pragma unroll
            for (int m = 0; m < 4; ++m) {
                bf16* rowp = (bf16*)u.dst + (size_t)(m0 + ai * 128 + m * 16) * 2048 + wc * 32 + 8 * fq;
                float r[8], sg[8];
#pragma unroll
                for (int n = 0; n < 2; ++n)
#pragma unroll
                    for (int j = 0; j < 4; ++j) { const float ea = __expf(-acc[ai][1][m][n][j]), ec = __expf(-acc[ai][0][m][n][j]);
                        sg[4 * n + j] = __builtin_amdgcn_rcpf(1.f + ea); r[4 * n + j] = (1.f + ea) * __builtin_amdgcn_rcpf(1.f + ec); }
                u32x4 w; w.x = cvt_pk_bf16(r[0], r[1]); w.y = cvt_pk_bf16(r[2], r[3]); w.z = cvt_pk_bf16(r[4], r[5]); w.w = cvt_pk_bf16(r[6], r[7]);
                *(u32x4*)rowp = w;
                w.x = cvt_pk_bf16(sg[0], sg[1]); w.y = cvt_pk_bf16(sg[2], sg[3]); w.z = cvt_pk_bf16(sg[4], sg[5]); w.w = cvt_pk_bf16(sg[6], sg[7]);
                *(u32x4*)(rowp + (WS_GA - WS_GC) / 2) = w;
            }
    }
};

typedef short v4i16_t __attribute__((ext_vector_type(4)));
__device__ __forceinline__ s16x4 vtr(const LAS unsigned char* p) { return __builtin_bit_cast(s16x4, __builtin_amdgcn_ds_read_tr16_b64_v4i16((LAS v4i16_t*)p)); }
__device__ __forceinline__ int voff_b(int row, int ch) { return 256 * row + 16 * (ch ^ (((row & 3) << 2) | ((row >> 2) & 3))); }
__device__ __forceinline__ void p2_attn(Frame& F) {
    const int gw = F.vcu * 8 + F.wave, NGW = F.G * 8, lane = F.lane, r = lane & 31, hf = lane >> 5;
    LAS unsigned char* vl = F.lds + F.wave * 8192;
    const int gl = lane & 15, tq = gl >> 2, tp = gl & 3, cg = (lane >> 4) & 1;
    for (int item = gw; item < BATCH * NH * (SEQ / 32); item += NGW) {
        const int qb = item & 127, h = (item >> 7) & 7, b = item >> 10;
        const int m0 = b * SEQ + 32 * qb, p0 = NMETA + 32 * qb;
        bf16x8 qf[8];
        { const bf16* qp = WSP(bf16, WS_Q) + (size_t)(m0 + r) * 1024 + h * HD + 8 * hf;
#pragma unroll
          for (int kk = 0; kk < 8; ++kk) qf[kk] = *(const bf16x8*)(qp + 16 * kk); }
        f32x16 O[4];
#pragma unroll
        for (int d = 0; d < 4; ++d)
#pragma unroll
            for (int i = 0; i < 16; ++i) O[d][i] = 0.f;
        float carry = 0.f;
        const bf16* kbase = WSP(bf16, WS_K) + (size_t)(b * LTOT) * 1024 + h * HD;
        const bf16* vbase = WSP(bf16, WS_V) + (size_t)(b * LTOT) * 1024 + h * HD;
        bf16x8 kf[8];
        { int ks = p0 + r; ks = ks > LTOT - 1 ? LTOT - 1 : ks; const bf16* kp = kbase + (size_t)ks * 1024 + 8 * hf;
#pragma unroll
          for (int kk = 0; kk < 8; ++kk) kf[kk] = *(const bf16x8*)(kp + 16 * kk); }
        for (int s0 = p0; s0 > -32; s0 -= 32) {
            f32x16 S;
#pragma unroll
            for (int i = 0; i < 16; ++i) S[i] = 0.f;
#pragma unroll
            for (int kk = 0; kk < 8; ++kk) S = __builtin_amdgcn_mfma_f32_32x32x16_bf16(kf[kk], qf[kk], S, 0, 0, 0);
            __builtin_amdgcn_sched_barrier(0);
            unsigned vadj = 0u; asm volatile("" : "+v"(vadj) : "v"(S[15]));
#pragma unroll
            for (int i = 0; i < 8; ++i) { const int p = i * 64 + lane, row = p >> 4, ch = (p & 15) ^ (((row & 3) << 2) | ((row >> 2) & 3)); int vs = s0 + row; vs = vs < 0 ? 0 : (vs > LTOT - 1 ? LTOT - 1 : vs);
                __builtin_amdgcn_global_load_lds((const unsigned*)(vbase + (size_t)vs * 1024 + ch * 8 + vadj), (LAS unsigned*)(vl + i * 1024), 16, 0, 0); }
            { int ks = s0 - 32 + r; ks = ks < 0 ? 0 : (ks > LTOT - 1 ? LTOT - 1 : ks); const bf16* kp = kbase + (size_t)ks * 1024 + 8 * hf;
#pragma unroll
              for (int kk = 0; kk < 8; ++kk) kf[kk] = *(const bf16x8*)(kp + 16 * kk); }
            __builtin_amdgcn_sched_barrier(0);
            float lr[16], lb[16];
#pragma unroll
            for (int i = 0; i < 16; ++i) { const int s = s0 + (i & 3) + 8 * (i >> 2) + 4 * hf; const bool valid = (s < p0 + r) && (s >= 0); const float z = S[i];
                const float l = fminf(z, 0.f) - __logf(1.f + __expf(-fabsf(z)));
                lb[i] = valid ? l : -1e30f; lr[i] = valid ? l - z : 0.f; }
            float own[4], oth[4], suf[4];
#pragma unroll
            for (int c = 0; c < 4; ++c) { own[c] = (lr[4 * c] + lr[4 * c + 1]) + (lr[4 * c + 2] + lr[4 * c + 3]); oth[c] = __shfl_xor(own[c], 32); }
            float tail = 0.f;
#pragma unroll
            for (int c = 3; c >= 0; --c) { suf[c] = tail + (hf == 0 ? oth[c] : 0.f); tail += own[c] + oth[c]; }
            float w[16];
#pragma unroll
            for (int c = 0; c < 4; ++c) { float in = carry + suf[c];
#pragma unroll
                for (int j = 3; j >= 0; --j) { w[4 * c + j] = __expf(lb[4 * c + j] + in); in += lr[4 * c + j]; } }
            carry += tail;
            bf16x8 pf[2];
#pragma unroll
            for (int s = 0; s < 2; ++s) { u32x4 t; t.x = cvt_pk_bf16(w[8 * s], w[8 * s + 1]); t.y = cvt_pk_bf16(w[8 * s + 2], w[8 * s + 3]); t.z = cvt_pk_bf16(w[8 * s + 4], w[8 * s + 5]); t.w = cvt_pk_bf16(w[8 * s + 6], w[8 * s + 7]);
                pf[s] = __builtin_bit_cast(bf16x8, t); }
            asm volatile("s_waitcnt vmcnt(8)" ::: "memory");
            __builtin_amdgcn_sched_barrier(0);
#pragma unroll
            for (int db = 0; db < 4; ++db)
#pragma unroll
                for (int s = 0; s < 2; ++s) {
                    const int r0 = 16 * s + 4 * hf, c0 = 4 * db + 2 * cg;
                    const s16x4 lo = vtr(vl + voff_b(r0 + tq, c0 + (tp >> 1)) + 8 * (tp & 1));
                    const s16x4 hi = vtr(vl + voff_b(r0 + 8 + tq, c0 + (tp >> 1)) + 8 * (tp & 1));
                    bf16x8 vf; vf[0] = lo[0]; vf[1] = lo[1]; vf[2] = lo[2]; vf[3] = lo[3]; vf[4] = hi[0]; vf[5] = hi[1]; vf[6] = hi[2]; vf[7] = hi[3];
                    O[db] = __builtin_amdgcn_mfma_f32_32x32x16_bf16(vf, pf[s], O[db], 0, 0, 0);
                }
            if (__all(carry < -104.f)) break;
        }
        bf16* op = WSP(bf16, WS_O) + (size_t)(m0 + r) * 1024 + h * HD + 4 * hf;
#pragma unroll
        for (int db = 0; db < 4; ++db)
#pragma unroll
            for (int i4 = 0; i4 < 4; ++i4) { u32x2 t; t.x = cvt_pk_bf16(O[db][4 * i4], O[db][4 * i4 + 1]); t.y = cvt_pk_bf16(O[db][4 * i4 + 2], O[db][4 * i4 + 3]);
                *(u32x2*)(op + 32 * db + 8 * i4) = t; }
    }
}
__device__ __forceinline__ void p2_conv(Frame& F) {
    const int nth = F.G * 512, total = MR * (CC / 8);
    int c = blockIdx.x * 512 + F.tid;
    if (c >= total) return;
    const int c8 = (c & 127) * 8;
    const f32x4 w0a = GLD(f32x4, F.conv_w + c8), w0b = GLD(f32x4, F.conv_w + c8 + 4), w1a = GLD(f32x4, F.conv_w + CC + c8), w1b = GLD(f32x4, F.conv_w + CC + c8 + 4),
                w2a = GLD(f32x4, F.conv_w + 2 * CC + c8), w2b = GLD(f32x4, F.conv_w + 2 * CC + c8 + 4);
    const float W0[8] = {w0a[0], w0a[1], w0a[2], w0a[3], w0b[0], w0b[1], w0b[2], w0b[3]}, W1[8] = {w1a[0], w1a[1], w1a[2], w1a[3], w1b[0], w1b[1], w1b[2], w1b[3]},
                W2[8] = {w2a[0], w2a[1], w2a[2], w2a[3], w2b[0], w2b[1], w2b[2], w2b[3]};
    u32x4 x0, x1, x2, bp;
#define P2C_LD(cc, A0, A1, A2, AB) do { const int m_ = (cc) >> 7, b_ = m_ / SEQ; const size_t row_ = (size_t)m_ + NMETA * (b_ + 1); const bf16* cu_ = WSP(bf16, WS_CU) + row_ * 1024 + c8; \
        A0 = *(const u32x4*)(cu_ - 2048); A1 = *(const u32x4*)(cu_ - 1024); A2 = *(const u32x4*)cu_; AB = *(const u32x4*)(WSP(bf16, WS_BP) + (size_t)m_ * 1024 + c8); } while (0)
    P2C_LD(c, x0, x1, x2, bp);
    for (; c < total; c += nth) {
        u32x4 n0 = x0, n1 = x1, n2 = x2, nb = bp;
        if (c + nth < total) P2C_LD(c + nth, n0, n1, n2, nb);
        const int m = c >> 7;
        const unsigned X0[4] = {x0.x, x0.y, x0.z, x0.w}, X1[4] = {x1.x, x1.y, x1.z, x1.w}, X2[4] = {x2.x, x2.y, x2.z, x2.w}, BP[4] = {bp.x, bp.y, bp.z, bp.w};
        unsigned ow[4];
#pragma unroll
        for (int q = 0; q < 4; ++q) {
            const float lo = bf_lo(BP[q]) * (W0[2 * q] * bf_lo(X0[q]) + W1[2 * q] * bf_lo(X1[q]) + W2[2 * q] * bf_lo(X2[q]));
            const float hi = bf_hi(BP[q]) * (W0[2 * q + 1] * bf_hi(X0[q]) + W1[2 * q + 1] * bf_hi(X1[q]) + W2[2 * q + 1] * bf_hi(X2[q]));
            ow[q] = cvt_pk_bf16(lo, hi); }
        u32x4 o; o.x = ow[0]; o.y = ow[1]; o.z = ow[2]; o.w = ow[3];
        *(u32x4*)(WSP(bf16, WS_YCIN) + (size_t)m * 1024 + c8) = o;
        x0 = n0; x1 = n1; x2 = n2; bp = nb;
    }
#undef P2C_LD
}

struct Sched3 {
    static constexpr bool AROW_LOADS = false;
    int G, c; unsigned char* ws; const LAS int* ut;
    __device__ __forceinline__ void coords(int i, int (&f)[8]) const { int pm = 0, pn = 0; f[0] = pg8::static_tile((i >> 1) * G + c, MR / 256, D / 256, pm, pn) ? 1 : 0; f[1] = pm; f[2] = pn; f[3] = i & 1; f[4] = 0; f[5] = 0; f[6] = 256; }
    __device__ __forceinline__ bool next(int i, Unit& u) const {
        if (!read_unit(ut, i, u)) return false;
        const int sub = u.kind; u.e = 0; u.nrow = 256; u.aux = 0;
        u.A = (const char*)(ws + (sub ? WS_O : WS_YCIN)) + (size_t)u.pm * 256 * 2048;
        u.B0 = (const char*)(ws + (sub ? WS_WATTN : WS_WCONV)) + (size_t)(256 * u.pn) * 1024 * 2; u.B1 = u.B0 + (size_t)128 * 1024 * 2;
        u.dst = (char*)(ws + (sub ? WS_GA : WS_GC)); u.ld = D;
        return true;
    }
    __device__ __forceinline__ unsigned arow(const Unit&, int r) const { return (unsigned)r * 2048u; }
    __device__ __forceinline__ unsigned hstepA() const { return 128u * 2048u; }
};
struct Epi3 {
    static constexpr bool PERM = true; static constexpr bool CHAIN = true;
    const bf16* gr; const bf16* gs; bf16* merged;
    __device__ __forceinline__ void mid(f32x4 (&acc)[2][2][4][2], const Unit& u, int wr, int wc, int fr, int fq) const {
        const int m0 = u.pm * 256 + wr * 64 + fr, col0 = u.pn * 256 + wc * 32 + 8 * fq;
#pragma unroll
        for (int ai = 0; ai < 2; ++ai)
#pragma unroll
            for (int m = 0; m < 4; ++m) { const size_t off = (size_t)(m0 + ai * 128 + m * 16) * D + col0;
#pragma unroll
                for (int bj = 0; bj < 2; ++bj) {
                    const u32x4 g = *(const u32x4*)(gr + off + bj * 128);
                    f32x4& v0 = acc[ai][bj][m][0]; f32x4& v1 = acc[ai][bj][m][1];
                    v0[0] *= bf_lo(g.x); v0[1] *= bf_hi(g.x); v0[2] *= bf_lo(g.y); v0[3] *= bf_hi(g.y);
                    v1[0] *= bf_lo(g.z); v1[1] *= bf_hi(g.z); v1[2] *= bf_lo(g.w); v1[3] *= bf_hi(g.w); } }
    }
    __device__ __forceinline__ void operator()(const f32x4 (&acc)[2][2][4][2], const Unit& u, int wr, int wc, int fr, int fq) const {
        const int m0 = u.pm * 256 + wr * 64 + fr, col0 = u.pn * 256 + wc * 32 + 8 * fq;
        u32x4 gv[8][2];
#define EPI3_LD(g) do { const size_t off_ = (size_t)(m0 + ((g) >> 2) * 128 + ((g) & 3) * 16) * D + col0; gv[g][0] = *(const u32x4*)(gs + off_); gv[g][1] = *(const u32x4*)(gs + off_ + 128); } while (0)
        EPI3_LD(0); EPI3_LD(1); EPI3_LD(2); EPI3_LD(3);
#pragma unroll
        for (int gi = 0; gi < 8; ++gi) { const int ai = gi >> 2, m = gi & 3; const size_t off = (size_t)(m0 + ai * 128 + m * 16) * D + col0;
#pragma unroll
                for (int bj = 0; bj < 2; ++bj) {
                    const u32x4 g = gv[gi][bj];
                    f32x4 v0 = acc[ai][bj][m][0], v1 = acc[ai][bj][m][1];
                    v0[0] *= bf_lo(g.x); v0[1] *= bf_hi(g.x); v0[2] *= bf_lo(g.y); v0[3] *= bf_hi(g.y);
                    v1[0] *= bf_lo(g.z); v1[1] *= bf_hi(g.z); v1[2] *= bf_lo(g.w); v1[3] *= bf_hi(g.w);
                    u32x4 w; w.x = cvt_pk_bf16(v0[0], v0[1]); w.y = cvt_pk_bf16(v0[2], v0[3]); w.z = cvt_pk_bf16(v1[0], v1[1]); w.w = cvt_pk_bf16(v1[2], v1[3]);
                    *(u32x4*)(merged + off + bj * 128) = w; }
            if (gi + 4 < 8) EPI3_LD(gi + 4); }
#undef EPI3_LD
    }
};

struct Sched4 {
    static constexpr bool AROW_LOADS = false;
    int G, c; unsigned char* ws; const LAS int* ut;
    __device__ __forceinline__ void coords(int i, int (&f)[8]) const { int pm = 0, pn = 0; f[0] = pg8::static_tile(i * G + c, MR / 256, D / 256, pm, pn) ? 1 : 0; f[1] = pm; f[2] = pn; f[3] = 0; f[4] = 0; f[5] = 0; f[6] = 256; }
    __device__ __forceinline__ bool next(int i, Unit& u) const {
        if (!read_unit(ut, i, u)) return false;
        u.kind = 0; u.e = 0; u.nrow = 256; u.aux = 0; u.A = (const char*)(ws + WS_MERGED) + (size_t)u.pm * 256 * D * 2;
        u.B0 = (const char*)(ws + WS_WO) + (size_t)(256 * u.pn) * D * 2; u.B1 = u.B0 + (size_t)128 * D * 2; u.dst = nullptr; u.ld = D;
        return true;
    }
    __device__ __forceinline__ unsigned arow(const Unit&, int r) const { return (unsigned)r * (unsigned)(D * 2); }
    __device__ __forceinline__ unsigned hstepA() const { return 128u * D * 2u; }
};
struct Epi4 {
    static constexpr bool PERM = true; static constexpr bool CHAIN = false;
    const bf16* xb; bf16* hres2;
    __device__ __forceinline__ void operator()(const f32x4 (&acc)[2][2][4][2], const Unit& u, int wr, int wc, int fr, int fq) const {
        const int row0 = u.pm * 256 + wr * 64 + fr, col0 = u.pn * 256 + wc * 32 + 8 * fq;
        u32x4 xv[8][2];
#define EPI4_LD(g) do { const size_t off_ = (size_t)(row0 + ((g) >> 2) * 128 + ((g) & 3) * 16) * D + col0; xv[g][0] = GLD(u32x4, xb + off_); xv[g][1] = GLD(u32x4, xb + off_ + 128); } while (0)
        EPI4_LD(0); EPI4_LD(1); EPI4_LD(2); EPI4_LD(3);
#pragma unroll
        for (int g = 0; g < 8; ++g) { const int ai = g >> 2, m = g & 3; const size_t off = (size_t)(row0 + ai * 128 + m * 16) * D + col0;
#pragma unroll
            for (int bj = 0; bj < 2; ++bj) { const u32x4 xw = xv[g][bj];
                const f32x4 v0 = (f32x4){bf_lo(xw.x), bf_hi(xw.x), bf_lo(xw.y), bf_hi(xw.y)} + acc[ai][bj][m][0], v1 = (f32x4){bf_lo(xw.z), bf_hi(xw.z), bf_lo(xw.w), bf_hi(xw.w)} + acc[ai][bj][m][1];
                u32x4 w; w.x = cvt_pk_bf16(v0[0], v0[1]); w.y = cvt_pk_bf16(v0[2], v0[3]); w.z = cvt_pk_bf16(v1[0], v1[1]); w.w = cvt_pk_bf16(v1[2], v1[3]);
                *(u32x4*)(hres2 + off + bj * 128) = w; }
            if (g + 4 < 8) EPI4_LD(g + 4); }
#undef EPI4_LD
    }
};

__device__ __forceinline__ void p5_route(Frame& F) {
    LAS float* part = (LAS float*)F.lds;
    LAS float* ssqp = part + 2 * 64 * 33;
    LAS int* lcnt = (LAS int*)(ssqp + 128);
    LAS int* gbase = lcnt + 32;
    const int lane = F.lane, fr = lane & 15, fq = lane >> 4, tg = F.wave & 3, kh = F.wave >> 2;
    const bf16* hres2 = WSP(bf16, WS_HRES2);
    for (int tb = blockIdx.x; tb < MR / 64; tb += F.G) {
        if (F.tid < 32) lcnt[F.tid] = 0;
        const int tok = tb * 64 + tg * 16 + fr;
        const bf16* xr = hres2 + (size_t)tok * D + kh * 1024 + 8 * fq;
        const float* gr = F.g_ffn + kh * 1024 + 8 * fq;
        unsigned char* hgw = WSP(unsigned char, WS_HG) + (size_t)tok * D + kh * 1024 + 8 * fq;
        const u32x4* wf = WSP(u32x4, WS_WRF) + (size_t)(kh * 32) * 128 + lane;
        f32x4 acc0 = {0.f, 0.f, 0.f, 0.f}, acc1 = {0.f, 0.f, 0.f, 0.f}; float ssq = 0.f;
#pragma unroll 4
        for (int s = 0; s < 32; ++s) {
            const u32x4 xw = *(const u32x4*)(xr + 32 * s);
            f32x4 x0 = {bf_lo(xw.x), bf_hi(xw.x), bf_lo(xw.y), bf_hi(xw.y)}, x1 = {bf_lo(xw.z), bf_hi(xw.z), bf_lo(xw.w), bf_hi(xw.w)};
            const f32x4 g0 = GLD(f32x4, gr + 32 * s), g1 = GLD(f32x4, gr + 32 * s + 4);
            ssq += (x0[0] * x0[0] + x0[1] * x0[1]) + (x0[2] * x0[2] + x0[3] * x0[3]) + (x1[0] * x1[0] + x1[1] * x1[1]) + (x1[2] * x1[2] + x1[3] * x1[3]);
            x0 *= g0; x1 *= g1;
            u32x4 t; t.x = cvt_pk_bf16(x0[0], x0[1]); t.y = cvt_pk_bf16(x0[2], x0[3]); t.z = cvt_pk_bf16(x1[0], x1[1]); t.w = cvt_pk_bf16(x1[2], x1[3]);
            { u32x2 h8; h8.x = cvt4_fp8(x0[0], x0[1], x0[2], x0[3]); h8.y = cvt4_fp8(x1[0], x1[1], x1[2], x1[3]); *(u32x2*)(hgw + 32 * s) = h8; }
            const bf16x8 bfr = __builtin_bit_cast(bf16x8, t);
            const bf16x8 a0 = __builtin_bit_cast(bf16x8, wf[(size_t)(2 * s) * 64]), a1 = __builtin_bit_cast(bf16x8, wf[(size_t)(2 * s + 1) * 64]);
            acc0 = __builtin_amdgcn_mfma_f32_16x16x32_bf16(a0, bfr, acc0, 0, 0, 0);
            acc1 = __builtin_amdgcn_mfma_f32_16x16x32_bf16(a1, bfr, acc1, 0, 0, 0);
        }
        ssq += __shfl_xor(ssq, 16); ssq += __shfl_xor(ssq, 32);
        { LAS float* pp = part + (kh * 64 + tg * 16 + fr) * 33 + 4 * fq;
#pragma unroll
          for (int j = 0; j < 4; ++j) { pp[j] = acc0[j]; pp[16 + j] = acc1[j]; }
          if (fq == 0) ssqp[kh * 64 + tg * 16 + fr] = ssq; }
        __syncthreads();
        if (F.wave == 0) {
            const int t = tb * 64 + lane;
            const float rstd = rsqrtf((ssqp[lane] + ssqp[64 + lane]) * (1.f / D) + EPS);
            float lg[NE];
#pragma unroll
            for (int e = 0; e < NE; ++e) lg[e] = rstd * (part[lane * 33 + e] + part[(64 + lane) * 33 + e]) + GLD(float, F.b_router + e);
            int ti[TOPK]; float tv[TOPK]; unsigned used = 0u;
#pragma unroll
            for (int k = 0; k < TOPK; ++k) { int bi = -1; float bv = 0.f;
#pragma unroll
                for (int e = 0; e < NE; ++e) { const bool take = !((used >> e) & 1u) && (bi < 0 || lg[e] > bv); bi = take ? e : bi; bv = take ? lg[e] : bv; }
                used |= 1u << bi; ti[k] = bi; tv[k] = bv; }
            float ex[TOPK], den = 0.f;
#pragma unroll
            for (int k = 0; k < TOPK; ++k) { ex[k] = __expf(tv[k] - tv[0]); den += ex[k]; }
            const float rden = 1.f / den;
            int lrk[TOPK];
#pragma unroll
            for (int k = 0; k < TOPK; ++k) lrk[k] = __hip_atomic_fetch_add(&lcnt[ti[k]], 1, __ATOMIC_RELAXED, __HIP_MEMORY_SCOPE_WORKGROUP);
            LDS_WAIT();
            if (lane < 32) { const int c = lcnt[lane]; int gb = 0; if (c) gb = (int)atomicAdd(F.ctl + CW_CNT + 64 * lane, (unsigned)c); gbase[lane] = gb; }
            LDS_WAIT();
#pragma unroll
            for (int k = 0; k < TOPK; ++k) { const int e = ti[k], sid = e * SLOT_CAP + gbase[e] + lrk[k];
                WSP(int, WS_TOKOF)[sid] = t; WSP(float, WS_RSTDOF)[sid] = rstd; WSP(float, WS_CWOF)[sid] = ex[k] * rden; WSP(int, WS_TOKSLOT)[t * TOPK + k] = sid; }
        }
        __syncthreads();
    }
}

__device__ __forceinline__ void moe_tables(Frame& F) {
    LAS int* tb = (LAS int*)(F.lds + LDS_TBL);
    if (F.wave == 0) {
        const int c = F.lane < NE ? (int)__hip_atomic_load(F.ctl + CW_CNT + 64 * (F.lane & 31), __ATOMIC_RELAXED, __HIP_MEMORY_SCOPE_AGENT) : 0;
        int t = (c + 255) >> 8, inc = t;
#pragma unroll
        for (int o = 1; o < 32; o <<= 1) { const int v = __shfl_up(inc, o); if ((F.lane & 31) >= o) inc += v; }
        if (F.lane < NE) { tb[F.lane] = c; tb[32 + F.lane + 1] = inc; }
        if (F.lane == 0) tb[32] = 0;
    }
    __syncthreads();
}
constexpr int ROT_UNITS = 24;
__device__ __forceinline__ void build_rowoffs(const LAS int* ut, LAS unsigned* rot, const unsigned char* ws, int wave) {
    int lt = (int)__builtin_amdgcn_mbcnt_hi(~0u, __builtin_amdgcn_mbcnt_lo(~0u, 0u)); asm volatile("" : "+v"(lt));
    const int tid = wave * 64 + lt;
    for (int idx = tid; idx < ROT_UNITS * 256; idx += 512) {
        const int i = idx >> 8, r = idx & 255; const LAS int* p = ut + 8 * i;
        unsigned off = 0u;
        if (p[0] != 0 && r < p[6]) off = (unsigned)((const GAS int*)(ws + WS_TOKOF))[p[4] * SLOT_CAP + p[5] * 256 + r] * (unsigned)D;
        rot[idx] = off;
    }
    __syncthreads();
}
template <bool SECOND> struct SchedMoe {
    static constexpr bool AROW_LOADS = !SECOND;
    static constexpr int second = SECOND ? 1 : 0;
    int G, c, nN; unsigned char* ws; const LAS int* tb; const LAS int* ut;
    __device__ __forceinline__ void coords(int i, int (&f)[8]) const {
        const int Mt = tb[32 + NE]; int gm = 0, pn = 0; f[0] = pg8::static_tile(i * G + c, Mt, nN, gm, pn, 8) ? 1 : 0;
        int e = 0;
        for (int j = 0; j < NE - 1; ++j) e += (tb[32 + j + 1] <= gm) ? 1 : 0;
        const int mt = gm - tb[32 + e], cnt = tb[e];
        f[1] = gm; f[2] = pn; f[3] = 0; f[4] = e; f[5] = mt; f[6] = (cnt - mt * 256) < 256 ? (cnt - mt * 256) : 256;
    }
    __device__ __forceinline__ bool next(int i, Unit& u) const {
        if (!read_unit(ut, i, u)) return false;
        const int gm = u.pm, pn = u.pn, e = u.e; u.ld = i; u.dst = nullptr;
        if (!second) { u.A = (const char*)(ws + WS_HG); u.B0 = (const char*)(ws + WS_WG) + ((size_t)e * DFF + 128 * pn) * D; u.B1 = (const char*)(ws + WS_WU) + ((size_t)e * DFF + 128 * pn) * D; }
        else { u.A = (const char*)(ws + WS_ACT) + (size_t)gm * 256 * DFF; u.B0 = (const char*)(ws + WS_WD) + ((size_t)e * D + 256 * pn) * DFF; u.B1 = u.B0 + (size_t)128 * DFF; }
        return true;
    }
    __device__ __forceinline__ unsigned arow(const Unit& u, int r) const {
        if (second) return (unsigned)r * (unsigned)DFF;
        const LAS unsigned* rot = (const LAS unsigned*)((const LAS unsigned char*)tb + (LDS_CVRING - LDS_TBL));
        return rot[u.ld * 256 + r];
    }
    __device__ __forceinline__ unsigned hstepA() const { return 128u * DFF; }
};
struct Epi6 {
    static constexpr bool PERM = true; static constexpr bool CHAIN = false; static constexpr bool WIDE = true; static constexpr bool RELAX = true;
    const float* b_gate; const float* b_up; const float* rstd_of; unsigned char* act;
    __device__ __forceinline__ void operator()(const f32x4 (&acc)[2][2][4][2], const Unit& u, int wr, int wc, int fr, int fq) const {
        const int colw = u.pn * 128 + wc * 32 + 16 * (fq & 1), col0 = colw + 8 * (fq >> 1), hi = fq >> 1;
        const f32x4 bg0 = GLD(f32x4, b_gate + u.e * DFF + col0), bg1 = GLD(f32x4, b_gate + u.e * DFF + col0 + 4), bu0 = GLD(f32x4, b_up + u.e * DFF + col0), bu1 = GLD(f32x4, b_up + u.e * DFF + col0 + 4);
        float rsv[8];
#pragma unroll
        for (int i = 0; i < 8; ++i) rsv[i] = rstd_of[u.e * SLOT_CAP + u.aux * 256 + (i >> 2) * 128 + wr * 64 + (i & 3) * 16 + fr];
        asm volatile("s_waitcnt vmcnt(0)" ::: "memory");
#pragma unroll
        for (int ai = 0; ai < 2; ++ai)
#pragma unroll
            for (int mp = 0; mp < 2; ++mp) { const int rl0 = ai * 128 + wr * 64 + mp * 32 + fr;
                u32x2 w[2];
#pragma unroll
                for (int q = 0; q < 2; ++q) { const int m = 2 * mp + q;
                    const float rs = rsv[ai * 4 + m];
                    f32x4 o[2];
#pragma unroll
                    for (int n = 0; n < 2; ++n) {
                        const f32x4 ag = acc[ai][0][m][n], au = acc[ai][1][m][n], bg = n ? bg1 : bg0, bu = n ? bu1 : bu0;
#pragma unroll
                        for (int jp = 0; jp < 2; ++jp) {
                            const f32x2_t rs2 = {rs, rs};
                            f32x2_t g = __builtin_elementwise_fma((f32x2_t){ag[2 * jp], ag[2 * jp + 1]}, rs2, (f32x2_t){bg[2 * jp], bg[2 * jp + 1]});
                            f32x2_t up = __builtin_elementwise_fma((f32x2_t){au[2 * jp], au[2 * jp + 1]}, rs2, (f32x2_t){bu[2 * jp], bu[2 * jp + 1]});
                            const f32x2_t gt = {fminf(g[0], 7.f), fminf(g[1], 7.f)}, uu = {__builtin_amdgcn_fmed3f(up[0], -7.f, 7.f), __builtin_amdgcn_fmed3f(up[1], -7.f, 7.f)};
                            const f32x2_t t = gt * (f32x2_t){-2.455466959592976f, -2.455466959592976f};
                            const f32x2_t den = (f32x2_t){__builtin_amdgcn_exp2f(t[0]), __builtin_amdgcn_exp2f(t[1])} + (f32x2_t){1.f, 1.f};
                            const f32x2_t num = __builtin_elementwise_fma(uu, gt, gt);
                            const f32x2_t r = num * (f32x2_t){__builtin_amdgcn_rcpf(den[0]), __builtin_amdgcn_rcpf(den[1])};
                            o[n][2 * jp] = r[0]; o[n][2 * jp + 1] = r[1]; } }
                    w[q].x = cvt4_fp8(o[0][0], o[0][1], o[0][2], o[0][3]); w[q].y = cvt4_fp8(o[1][0], o[1][1], o[1][2], o[1][3]); }
                const auto rx = __builtin_amdgcn_permlane32_swap(w[0].x, w[1].x, false, false), ry = __builtin_amdgcn_permlane32_swap(w[0].y, w[1].y, false, false);
                const int rl = rl0 + 16 * hi;
                if (rl < u.nrow) { u32x4 v; v.x = rx[0]; v.y = ry[0]; v.z = rx[1]; v.w = ry[1];
                    *(u32x4*)(act + (size_t)(u.pm * 256 + rl) * DFF + colw) = v; } }
    }
};
struct Epi7 {
    static constexpr bool PERM = true; static constexpr bool CHAIN = false; static constexpr bool WIDE = true; static constexpr bool RELAX = true;
    const float* b_down; const float* cw_of; unsigned char* Y;
    __device__ __forceinline__ void operator()(const f32x4 (&acc)[2][2][4][2], const Unit& u, int wr, int wc, int fr, int fq) const {
        const int colw = u.pn * 256 + wc * 32 + 16 * (fq & 1), col0 = colw + 8 * (fq >> 1), hi = fq >> 1;
        f32x4 bv[2][2];
#pragma unroll
        for (int bj = 0; bj < 2; ++bj)
#pragma unroll
            for (int n = 0; n < 2; ++n) bv[bj][n] = GLD(f32x4, b_down + u.e * D + col0 + bj * 128 + 4 * n);
        float cwv[8];
#pragma unroll
        for (int i = 0; i < 8; ++i) cwv[i] = cw_of[u.e * SLOT_CAP + u.aux * 256 + (i >> 2) * 128 + wr * 64 + (i & 3) * 16 + fr];
        asm volatile("s_waitcnt vmcnt(0)" ::: "memory");
#pragma unroll
        for (int ai = 0; ai < 2; ++ai)
#pragma unroll
            for (int mp = 0; mp < 2; ++mp) { const int rl0 = ai * 128 + wr * 64 + mp * 32 + fr, rl = rl0 + 16 * hi;
                const float cw0 = cwv[ai * 4 + 2 * mp], cw1 = cwv[ai * 4 + 2 * mp + 1];
#pragma unroll
                for (int bj = 0; bj < 2; ++bj) { u32x2 w[2];
#pragma unroll
                    for (int q = 0; q < 2; ++q) { const float cw = q ? cw1 : cw0; const f32x4 v0 = (acc[ai][bj][2 * mp + q][0] + bv[bj][0]) * cw, v1 = (acc[ai][bj][2 * mp + q][1] + bv[bj][1]) * cw;
                        w[q].x = cvt4_fp8(v0[0], v0[1], v0[2], v0[3]); w[q].y = cvt4_fp8(v1[0], v1[1], v1[2], v1[3]); }
                    const auto rx = __builtin_amdgcn_permlane32_swap(w[0].x, w[1].x, false, false), ry = __builtin_amdgcn_permlane32_swap(w[0].y, w[1].y, false, false);
                    if (rl < u.nrow) { u32x4 v; v.x = rx[0]; v.y = ry[0]; v.z = rx[1]; v.w = ry[1];
                        *(u32x4*)(Y + (size_t)(u.pm * 256 + rl) * D + colw + bj * 128) = v; } } }
    }
};

struct EpiNull { static constexpr bool PERM = true; static constexpr bool CHAIN = false;
    __device__ __forceinline__ void operator()(const f32x4 (&acc)[2][2][4][2], const Unit& u, int, int, int, int) const {
        float s = 0.f;
#pragma unroll
        for (int a = 0; a < 2; ++a)
#pragma unroll
            for (int b = 0; b < 2; ++b)
#pragma unroll
                for (int m = 0; m < 4; ++m)
#pragma unroll
                    for (int n = 0; n < 2; ++n) s += acc[a][b][m][n][0] + acc[a][b][m][n][3];
        if (s == 1.2345e30f) ((float*)u.A)[0] = s; } };
__device__ __forceinline__ void p8_final(Frame& F) {
    const LAS int* tb = (const LAS int*)(F.lds + LDS_TBL);
    const int gw = F.vcu * 8 + F.wave, NGW = F.G * 8, lane = F.lane;
    const bf16* hres2 = WSP(bf16, WS_HRES2); const unsigned char* Y = WSP(unsigned char, WS_Y);
    for (int t = gw; t < MR; t += NGW) {
        const int* ts = WSP(int, WS_TOKSLOT) + t * TOPK;
        const unsigned char* yr[TOPK];
#pragma unroll
        for (int k = 0; k < TOPK; ++k) { const int sid = __builtin_amdgcn_readfirstlane(ts[k]); const int e = sid >> 14, r = sid & (SLOT_CAP - 1); yr[k] = Y + (size_t)(tb[32 + e] * 256 + r) * D + 16 * lane; }
        const bf16* xr = hres2 + (size_t)t * D + 16 * lane;
        float v[2][16]; float s = 0.f;
#pragma unroll
        for (int j = 0; j < 2; ++j) {
            const u32x4 xa = *(const u32x4*)(xr + 1024 * j), xb = *(const u32x4*)(xr + 1024 * j + 8);
            const unsigned xw[8] = {xa.x, xa.y, xa.z, xa.w, xb.x, xb.y, xb.z, xb.w};
#pragma unroll
            for (int q = 0; q < 8; ++q) { v[j][2 * q] = bf_lo(xw[q]); v[j][2 * q + 1] = bf_hi(xw[q]); }
#pragma unroll
            for (int k = 0; k < TOPK; ++k) { const u32x4 y = *(const u32x4*)(yr[k] + 1024 * j); const unsigned yw[4] = {y.x, y.y, y.z, y.w};
#pragma unroll
                for (int q = 0; q < 4; ++q) { const f32x2_t lo = __builtin_amdgcn_cvt_pk_f32_fp8((int)yw[q], false), hi = __builtin_amdgcn_cvt_pk_f32_fp8((int)yw[q], true);
                    v[j][4 * q] += lo[0]; v[j][4 * q + 1] += lo[1]; v[j][4 * q + 2] += hi[0]; v[j][4 * q + 3] += hi[1]; } }
#pragma unroll
            for (int q = 0; q < 16; ++q) s += v[j][q] * v[j][q];
        }
        const float rstd = rsqrtf(wave_sum(s) * (1.f / D) + EPS);
#pragma unroll
        for (int j = 0; j < 2; ++j) { f32x4* op = (f32x4*)(F.out + (size_t)t * D + 16 * lane + 1024 * j); const GAS f32x4* gp = (const GAS f32x4*)(F.g_final + 16 * lane + 1024 * j);
#pragma unroll
            for (int q = 0; q < 4; ++q) { const f32x4 g = gp[q]; f32x4 o; o[0] = v[j][4 * q] * rstd * g[0]; o[1] = v[j][4 * q + 1] * rstd * g[1]; o[2] = v[j][4 * q + 2] * rstd * g[2]; o[3] = v[j][4 * q + 3] * rstd * g[3]; op[q] = o; } }
    }
}

#ifndef DUP_PHASE
#define DUP_PHASE -1
#endif
#ifdef CV_DUMMY
constexpr size_t CV_DST = WS_Y;
#else
constexpr size_t CV_DST = WS_WG;
#endif
__global__ void __launch_bounds__(512, 2) mk_fwd(Args args) {
    extern __shared__ __attribute__((aligned(16))) unsigned char lds[];
    Frame F;
    F.lds = (LAS unsigned char*)lds;
    F.tid = threadIdx.x; F.lane = F.tid & 63; F.wave = __builtin_amdgcn_readfirstlane(F.tid >> 6);
    F.G = gridDim.x; { const int bx = blockIdx.x; F.vcu = (F.G % 8 == 0) ? (bx % 8) * (F.G / 8) + bx / 8 : bx; }
    F.x = args.in[0]; F.meta = args.in[1]; F.g_mix = args.in[2]; F.w_in = args.in[3]; F.conv_w = args.in[4]; F.w_conv_out = args.in[5]; F.w_attn_out = args.in[6]; F.w_o = args.in[7];
    F.g_ffn = args.in[8]; F.w_router = args.in[9]; F.b_router = args.in[10]; F.w_gate = args.in[11]; F.b_gate = args.in[12]; F.w_up = args.in[13]; F.b_up = args.in[14];
    F.w_down = args.in[15]; F.b_down = args.in[16]; F.g_final = args.in[17];
    F.out = args.out; F.ws = args.ws; F.ctl = (unsigned*)(args.ws + WS_CTL);
    for (int u = F.tid; u < (LDS_BYTES - RING_BYTES) / 4; u += 512) ((LAS unsigned*)(F.lds + RING_BYTES))[u] = 0u;
    __syncthreads();
    const int lo = args.ph_lo, hi = args.ph_hi;
    const bool multi = (hi - lo) > 1;
    XcdBarrier bar; bar.bar = F.ctl + CW_BAR; bar.x = 0; bar.st = nullptr;
    if (multi) bar = xcd_barrier_post(F.ctl + CW_BAR, (volatile LAS unsigned*)(F.lds + LDS_MISC));
#ifdef ONLY_PHASE
#define IN(k) ((k) == ONLY_PHASE)
#else
#define IN(k) (lo <= (k) && (k) < hi)
#endif
#define ARG(i) ([&]() { const float* p_ = args.in[i]; asm volatile("" : "+s"(p_)); return p_; }())
#define SEAM(k) do { if (IN(k) && IN((k) + 1)) xcd_barrier(bar); } while (0)
#ifdef CV_DUMMY
    const bool ride = false; const bool cvon = true;
#else
    const bool ride = (F.G == 256); const bool cvon = ride;
#endif
    if (IN(0)) { p0_prologue(F, ride); if (DUP_PHASE == 0) p0_prologue(F, ride); SEAM(0); }
    if (IN(1)) {
        F.w_gate = ARG(11); F.w_up = ARG(13); F.w_down = ARG(15);
        p1_meta(F);
        LAS int* ut = (LAS int*)(F.lds + LDS_UNITS);
        Sched1 S{F.G, (int)blockIdx.x, F.ws, ut}; Epi1 E; build_units(S, ut);
#define CVW(NB_, lo_, hi_) int cl_ = (int)__builtin_amdgcn_mbcnt_hi(~0u, __builtin_amdgcn_mbcnt_lo(~0u, 0u)); asm volatile("" : "+v"(cl_));     \
        ConvW<NB_> cvw{F.w_gate, F.w_up, F.w_down, F.ws + CV_DST, F.lds + LDS_CVRING + F.wave * 3072, F.vcu * 8 + F.wave, cvon ? (lo_) : 0, cvon ? (lo_) : 0, cvon ? (hi_) : 0, \
                    (unsigned)((cl_ >> 2) * 8192 + (cl_ & 3) * 16), (unsigned)((cl_ >> 4) * 256 + (cl_ & 15) * 4), (unsigned)((cl_ & 15) * 2048 + (cl_ >> 4) * 16), {0.f, 0.f, 0.f, 0.f}, {}}
        { CVW(8, 0, 384); pg8::gemm_phase<Epi1, Sched1, true, true, false, ConvW<8>>(F.lds, D, S, E, cvw); }
        { Sched1g Sg{F.G, (int)blockIdx.x, F.ws, ut}; build_units(Sg, ut);
          CVW(8, 384, 512); Epi1g Eg; pg8::gemm_phase<Epi1g, Sched1g, true, true, true, ConvW<8>>(F.lds, D, Sg, Eg, cvw); }
        SEAM(1);
    }
    if (IN(2)) { F.conv_w = ARG(4); p2_attn(F); p2_conv(F); if (DUP_PHASE == 2) { p2_attn(F); p2_conv(F); } SEAM(2); }
    if (IN(3)) {
        F.w_gate = ARG(11); F.w_up = ARG(13); F.w_down = ARG(15);
        LAS int* ut = (LAS int*)(F.lds + LDS_UNITS);
        Sched3 S{F.G, (int)blockIdx.x, F.ws, ut}; Epi3 E{WSP(bf16, WS_GC), WSP(bf16, WS_GA), WSP(bf16, WS_MERGED)}; build_units(S, ut);
        { CVW(8, 512, 640); pg8::gemm_phase<Epi3, Sched3, true, true, false, ConvW<8>>(F.lds, 1024, S, E, cvw); }
        SEAM(3);
    }
    if (IN(4)) {
        F.w_gate = ARG(11); F.w_up = ARG(13); F.w_down = ARG(15); F.x = ARG(0);
        LAS int* ut = (LAS int*)(F.lds + LDS_UNITS);
        Sched4 S{F.G, (int)blockIdx.x, F.ws, ut}; Epi4 E{WSP(bf16, WS_XB), WSP(bf16, WS_HRES2)}; build_units(S, ut);
        { CVW(8, 640, 768); pg8::gemm_phase<Epi4, Sched4, true, true, false, ConvW<8>>(F.lds, D, S, E, cvw); }
        if (DUP_PHASE == 4) pg8::gemm_phase<Epi4, Sched4, true, true>(F.lds, D, S, E);
        if (DUP_PHASE == 14) { EpiNull EN; pg8::gemm_phase<EpiNull, Sched4, true, true>(F.lds, D, S, EN); }
        SEAM(4);
    }
    if (IN(5)) { F.g_ffn = ARG(8); F.b_router = ARG(10); p5_route(F); SEAM(5); }
    if (IN(6)) {
        F.b_gate = ARG(12); F.b_up = ARG(14);
        moe_tables(F);
        LAS int* ut = (LAS int*)(F.lds + LDS_UNITS);
        SchedMoe<false> S{F.G, (int)blockIdx.x, DFF / 128, F.ws, (const LAS int*)(F.lds + LDS_TBL), ut}; build_units(S, ut);
        build_rowoffs(ut, (LAS unsigned*)(F.lds + LDS_CVRING), F.ws, F.wave);
        Epi6 E{F.b_gate, F.b_up, WSP(float, WS_RSTDOF), WSP(unsigned char, WS_ACT)};
        pg8::gemm_phase<Epi6, SchedMoe<false>, true, true, true>(F.lds, D, S, E);
        if (DUP_PHASE == 6) pg8::gemm_phase<Epi6, SchedMoe<false>, true, true, true>(F.lds, D, S, E);
        if (DUP_PHASE == 16) { EpiNull EN; pg8::gemm_phase<EpiNull, SchedMoe<false>, true, true, true>(F.lds, D, S, EN); }
                SEAM(6);
    }
    if (IN(7)) {
        F.b_down = ARG(16);
        moe_tables(F);
        LAS int* ut = (LAS int*)(F.lds + LDS_UNITS);
        SchedMoe<true> S{F.G, (int)blockIdx.x, D / 256, F.ws, (const LAS int*)(F.lds + LDS_TBL), ut}; build_units(S, ut);
        Epi7 E{F.b_down, WSP(float, WS_CWOF), WSP(unsigned char, WS_Y)};
        pg8::gemm_phase<Epi7, SchedMoe<true>, true, true, true>(F.lds, DFF, S, E);
        if (DUP_PHASE == 7) pg8::gemm_phase<Epi7, SchedMoe<true>, true, true, true>(F.lds, DFF, S, E);
        if (DUP_PHASE == 17) { EpiNull EN; pg8::gemm_phase<EpiNull, SchedMoe<true>, true, true, true>(F.lds, DFF, S, EN); }
        SEAM(7);
    }
    if (IN(8)) { F.g_final = ARG(17); moe_tables(F); p8_final(F); if (DUP_PHASE == 8) p8_final(F); }
#undef IN
#undef SEAM
}

#ifndef DEBUG_HYBRID
#ifndef MK_ONE_LAUNCH
#define MK_ONE_LAUNCH 1
#endif
extern "C" void kernel_launch(void* const* d_in, const int* in_sizes, int n_in, void* d_out, int out_size, void* d_ws, size_t ws_size, hipStream_t stream) {
    static int grid = 0;
    if (grid == 0) {
        if (n_in != 18 || out_size != MR * D || ws_size < WS_END) { fprintf(stderr, "kernel_launch: unexpected problem (n_in %d, out %d, ws %zu, need %zu)\n", n_in, out_size, ws_size, (size_t)WS_END); grid = -1; return; }
        int dev = 0, cus = 0, per_cu = 0;
        if (hipGetDevice(&dev) != hipSuccess || hipDeviceGetAttribute(&cus, hipDeviceAttributeMultiprocessorCount, dev) != hipSuccess) { grid = -1; return; }
        if (hipFuncSetAttribute((const void*)mk_fwd, hipFuncAttributeMaxDynamicSharedMemorySize, LDS_BYTES) != hipSuccess) { fprintf(stderr, "kernel_launch: hipFuncSetAttribute failed\n"); grid = -1; return; }
        if (hipOccupancyMaxActiveBlocksPerMultiprocessor(&per_cu, (const void*)mk_fwd, 512, LDS_BYTES) != hipSuccess || per_cu < 1) { fprintf(stderr, "kernel_launch: occupancy query says %d\n", per_cu); }
        (void)hipGetLastError();
        grid = cus;
    }
    if (grid < 0) return;
    if (hipMemsetAsync((char*)d_ws + WS_CTL, 0, CTL_ZERO_BYTES, stream) != hipSuccess) return;
    Args a{};
    for (int i = 0; i < 18; ++i) a.in[i] = (const float*)d_in[i];
    a.out = (float*)d_out; a.ws = (unsigned char*)d_ws;
#if MK_ONE_LAUNCH
    a.ph_lo = 0; a.ph_hi = NPH;
    hipLaunchKernelGGL(mk_fwd, dim3(grid), dim3(512), LDS_BYTES, stream, a);
#else
    for (int p = 0; p < NPH; ++p) { a.ph_lo = p; a.ph_hi = p + 1; hipLaunchKernelGGL(mk_fwd, dim3(grid), dim3(512), LDS_BYTES, stream, a); }
#endif
}
#endif
```

```cpp
#include <hip/hip_runtime.h>
#include <cstdio>
#include <cstdint>

#define GAS __attribute__((address_space(1)))
#define GLD(T, p) (*(const GAS T*)(p))
#define LAS __attribute__((address_space(3)))
typedef unsigned short bf16;
typedef short bf16x8 __attribute__((ext_vector_type(8)));
typedef short s16x4 __attribute__((ext_vector_type(4)));
typedef float f32x4 __attribute__((ext_vector_type(4)));
typedef float f32x16 __attribute__((ext_vector_type(16)));
typedef unsigned u32x4 __attribute__((ext_vector_type(4)));
typedef unsigned u32x2 __attribute__((ext_vector_type(2)));

constexpr int D = 2048, BATCH = 4, SEQ = 4096, NMETA = 16, LTOT = SEQ + NMETA;
constexpr int MR = BATCH * SEQ;
constexpr int ROWS = BATCH * LTOT;
constexpr int NH = 8, HD = 128, AW = 1024, CC = 1024, NE = 32, TOPK = 4, DFF = 2048, INW = 10240;
constexpr int O_U = 0, O_B = 1024, O_C = 2048, O_Q = 3072, O_K = 4096, O_V = 5120, O_GC = 6144, O_GA = 8192;
constexpr float EPS = 1e-5f;
constexpr int SLOT_CAP = 16384;
constexpr int MAXT = MR * TOPK / 256 + NE;
constexpr int NPH = 9;

constexpr size_t MiB = 1u << 20;
constexpr size_t WS_CTL = 0, CTL_ZERO_BYTES = 1 * MiB;
constexpr size_t WS_WIN = 1 * MiB;
constexpr size_t WS_WCONV = WS_WIN + 40 * MiB;
constexpr size_t WS_WATTN = WS_WCONV + 4 * MiB;
constexpr size_t WS_WO = WS_WATTN + 4 * MiB;
constexpr size_t WS_WRF = WS_WO + 8 * MiB;
constexpr size_t WS_HM = WS_WRF + 1 * MiB;
constexpr size_t WS_WG = WS_HM + 1 * MiB;
constexpr size_t WS_WU = WS_WG + 256 * MiB;
constexpr size_t WS_WD = WS_WU + 256 * MiB;
constexpr size_t WS_HRES2 = WS_WD + 256 * MiB;
constexpr size_t WS_XB = WS_HRES2 + 64 * MiB;
constexpr size_t WS_HG = WS_HRES2 + 128 * MiB;
constexpr size_t WS_TOKOF = WS_HG + 64 * MiB;
constexpr size_t WS_RSTDOF = WS_TOKOF + 2 * MiB;
constexpr size_t WS_CWOF = WS_RSTDOF + 2 * MiB;
constexpr size_t WS_TOKSLOT = WS_CWOF + 2 * MiB;
constexpr size_t WS_Y = WS_TOKSLOT + 1 * MiB;
constexpr size_t WS_X = WS_Y + 288 * MiB;
constexpr size_t WS_HN = WS_X;
constexpr size_t WS_YCIN = WS_X, WS_O = WS_X + 32 * MiB;
constexpr size_t WS_CU = WS_X + 64 * MiB;
constexpr size_t WS_BP = WS_CU + 33 * MiB;
constexpr size_t WS_Q = WS_BP + 32 * MiB;
constexpr size_t WS_K = WS_Q + 32 * MiB;
constexpr size_t WS_V = WS_K + 33 * MiB;
constexpr size_t WS_GC = WS_V + 33 * MiB;
constexpr size_t WS_GA = WS_GC + 64 * MiB;
constexpr size_t WS_MERGED = WS_GA + 64 * MiB;
constexpr size_t WS_HN8 = WS_MERGED + 64 * MiB;
constexpr size_t WS_WIN8 = WS_HN8 + 32 * MiB;
constexpr size_t WS_X_END1 = WS_WIN8 + 8 * MiB;
constexpr size_t WS_ACT = WS_X;
constexpr size_t WS_X_END2 = WS_ACT + 288 * MiB;
constexpr size_t WS_END = WS_X_END1 > WS_X_END2 ? WS_X_END1 : WS_X_END2;
static_assert((size_t)MAXT * 256 * D * 2 <= 288 * MiB, "act/Y size");
constexpr int CW_BAR = 1024;
constexpr int CW_CNT = 8192;

constexpr int RING_BYTES = 131072;
constexpr int LDS_TBL = RING_BYTES;
constexpr int LDS_MISC = RING_BYTES + 1024;
constexpr int LDS_UNITS = RING_BYTES + 2048;
constexpr int LDS_CVRING = RING_BYTES + 4096;
constexpr int LDS_BYTES = 159744;

#define LDS_WAIT() asm volatile("s_waitcnt lgkmcnt(0)" ::: "memory")
#define VM_WAIT() asm volatile("s_waitcnt vmcnt(0)" ::: "memory")
__device__ __forceinline__ unsigned f2bf(float f) { unsigned u = __builtin_bit_cast(unsigned, f); return (u + 0x7fffu + ((u >> 16) & 1u)) >> 16; }

typedef float f32x2_t __attribute__((ext_vector_type(2)));
typedef __bf16 bf16x2_t __attribute__((ext_vector_type(2)));
__device__ __forceinline__ unsigned cvt_pk_bf16(float lo, float hi) { const f32x2_t v = {lo, hi}; return __builtin_bit_cast(unsigned, __builtin_convertvector(v, bf16x2_t)); }
__device__ __forceinline__ unsigned pk2(float lo, float hi) { return cvt_pk_bf16(lo, hi); }
__device__ __forceinline__ unsigned cvt4_fp8(float a, float b, float c, float d) { int p = __builtin_amdgcn_cvt_pk_fp8_f32(a, b, 0, false); p = __builtin_amdgcn_cvt_pk_fp8_f32(c, d, p, true); return (unsigned)p; }
__device__ __forceinline__ float bf_lo(unsigned w) { return __builtin_bit_cast(float, w << 16); }
__device__ __forceinline__ float bf_hi(unsigned w) { return __builtin_bit_cast(float, w & 0xffff0000u); }
__device__ __forceinline__ float wave_sum(float v) {
#pragma unroll
    for (int o = 1; o < 64; o <<= 1) v += __shfl_xor(v, o);
    return v;
}
__device__ __forceinline__ float fast_sigmoid(float x) { return __builtin_amdgcn_rcpf(1.f + __expf(-x)); }

#define XB_TMO      128
#define XB_XCNT(j)  (256  + 64 * (j))
#define XB_XSUB(j)  (1280 + 64 * (j))
#define XB_XGEN(j)  (2304 + 64 * (j))
#define XB_TOP      3328
#define XB_TOPGEN   3392
#define XCD_BAR_WORDS 3456
#define XB_SPIN_CAP (1u << 18)
__device__ __forceinline__ unsigned xb_ld(unsigned* p)              { return __hip_atomic_load(p, __ATOMIC_RELAXED, __HIP_MEMORY_SCOPE_AGENT); }
__device__ __forceinline__ unsigned xb_add(unsigned* p, unsigned v) { return __hip_atomic_fetch_add(p, v, __ATOMIC_RELAXED, __HIP_MEMORY_SCOPE_AGENT); }
__device__ __forceinline__ unsigned xb_xcc_id() { return (unsigned)__builtin_amdgcn_s_getreg((3 << 11) | 20) & 0xFu; }
#define XB_SPIN(cond, bar) do { unsigned _sp = 0; while (cond) { __builtin_amdgcn_s_sleep(1); \
    if ((++_sp & 255u) == 0u) { if (xb_ld(&(bar)[XB_TMO])) break; if (_sp > XB_SPIN_CAP) { atomicAdd(&(bar)[XB_TMO], 1u); break; } } } } while (0)
struct XcdBarrier { unsigned* bar; unsigned x; volatile LAS unsigned* st; };
__device__ __forceinline__ XcdBarrier xcd_barrier_post(unsigned* bar, volatile LAS unsigned* st) {
    XcdBarrier b; b.bar = bar; b.x = xb_xcc_id(); b.st = st;
    if (threadIdx.x == 0) (void)xb_add(&bar[XB_XCNT(b.x)], 1u);
    return b;
}
__device__ __forceinline__ void xcd_barrier_complete(unsigned* bar, unsigned x, unsigned& nloc, unsigned& nx) {
    const unsigned G = gridDim.x * gridDim.y * gridDim.z;
    unsigned sum, cnt, mine, sp = 0u;
    for (;;) {
        sum = 0u; cnt = 0u; mine = 0u;
#pragma unroll
        for (unsigned j = 0; j < 16; ++j) { const unsigned c = xb_ld(&bar[XB_XCNT(j)]); sum += c; cnt += (c > 0u) ? 1u : 0u; mine = (j == x) ? c : mine; }
        if (sum == G) break;
        __builtin_amdgcn_s_sleep(1);
        if ((++sp & 255u) == 0u) { if (xb_ld(&bar[XB_TMO])) break; if (sp > XB_SPIN_CAP) { atomicAdd(&bar[XB_TMO], 1u); break; } }
    }
    nloc = mine > 0u ? mine : 1u; nx = cnt > 0u ? cnt : 1u;
}
__device__ __forceinline__ void xcd_barrier(const XcdBarrier& b) {
    asm volatile("s_waitcnt vmcnt(0)" ::: "memory");
    __syncthreads();
    if (threadIdx.x == 0) {
        unsigned* bar = b.bar;
        __builtin_amdgcn_s_waitcnt(0);
        unsigned nloc = b.st[0], nx = b.st[1];
        if (nloc == 0u) { xcd_barrier_complete(bar, b.x, nloc, nx); b.st[0] = nloc; b.st[1] = nx; }
        const unsigned old = xb_add(&bar[XB_XSUB(b.x)], 1u);
        const unsigned gen = old / nloc;
        if (old + 1u == (gen + 1u) * nloc) {
            __builtin_amdgcn_fence(__ATOMIC_RELEASE, "agent");
            asm volatile("s_waitcnt vmcnt(0)" ::: "memory");
            const unsigned og = xb_add(&bar[XB_TOP], 1u);
            const unsigned tg = og / nx;
            if (og + 1u == (tg + 1u) * nx) xb_add(&bar[XB_TOPGEN], 1u);
            else XB_SPIN(xb_ld(&bar[XB_TOPGEN]) == tg, bar);
            __builtin_amdgcn_fence(__ATOMIC_ACQUIRE, "agent");
            xb_add(&bar[XB_XGEN(b.x)], 1u);
            asm volatile("s_waitcnt vmcnt(0)" ::: "memory");
        } else {
            XB_SPIN(xb_ld(&bar[XB_XGEN(b.x)]) == gen, bar);
            __builtin_amdgcn_fence(__ATOMIC_ACQUIRE, "agent");
            asm volatile("s_waitcnt vmcnt(0)" ::: "memory");
        }
    }
    __syncthreads();
}

namespace pg8 {
constexpr int BM = 256, BK = 64, HALF = 128, HTB = HALF * BK * 2, STAGE_BYTES = 8 * HTB, NXCD = 8, WGM = 4;
__host__ __device__ __forceinline__ int lds_byte(int r, int c) { const int st = (r >> 4) * 2 + (c >> 5), rr = r & 15, cc = c & 31, ob = rr * 64 + cc * 2; return st * 1024 + (ob ^ (((ob >> 9) & 1) << 5)); }
__host__ __device__ __forceinline__ void stage_rc(int b, int& R, int& C) { const int st = b / 1024, sb = b % 1024, swz = sb ^ (((sb >> 9) & 1) << 5); R = (st >> 1) * 16 + swz / 64; C = (st & 1) * 32 + (swz % 64) / 2; }
__host__ __device__ __forceinline__ int perm32(int rho) { const int n = rho >> 4, i = rho & 15; return 8 * (i >> 2) + 4 * n + (i & 3); }
__host__ __device__ __forceinline__ int perm32w(int rho) { const int n = rho >> 4, i = rho & 15; return 16 * ((i >> 2) & 1) + 8 * (i >> 3) + 4 * n + (i & 3); }
template <class E, class = void> struct epi_wide { static constexpr bool value = false; };
template <class E> struct epi_wide<E, decltype((void)E::WIDE)> { static constexpr bool value = E::WIDE; };
template <class E, class = void> struct epi_relax { static constexpr bool value = false; };
template <class E> struct epi_relax<E, decltype((void)E::RELAX)> { static constexpr bool value = E::RELAX; };

struct Unit {
    int pm, pn;
    int kind, e, nrow, aux;
    const char* A;
    const char* B0;
    const char* B1;
    char* dst; int ld;
};
__device__ __forceinline__ bool static_tile(int L, int nM, int nN, int& pm, int& pn, const int WGM = pg8::WGM) {
    const int nwg = nM * nN; if (L >= nwg) return false;
    int wgid = L; { const int q = nwg / NXCD, r = nwg % NXCD, xcd = wgid % NXCD, off = wgid / NXCD; wgid = (xcd < r ? xcd * (q + 1) : r * (q + 1) + (xcd - r) * q) + off; }
    const int nig = WGM * nN, gid = wgid / nig, fm = gid * WGM, gsz = (nM - fm) < WGM ? (nM - fm) : WGM;
    pm = fm + ((wgid % nig) % gsz); pn = (wgid % nig) / gsz; return true;
}

typedef int v8i32 __attribute__((ext_vector_type(8)));
typedef int v4i32 __attribute__((ext_vector_type(4)));
template <bool FP8> struct Frag;
template <> struct Frag<false> { bf16x8 k[2]; };
template <> struct Frag<true> { v8i32 v; };
__device__ __forceinline__ void load_frag(Frag<false>& f, const LAS unsigned char* p) { f.k[0] = *(const LAS bf16x8*)p; f.k[1] = *(const LAS bf16x8*)(p + 1024); }
__device__ __forceinline__ void load_frag(Frag<true>& f, const LAS unsigned char* p) { const v4i32 lo = *(const LAS v4i32*)p, hi = *(const LAS v4i32*)(p + 1024); f.v = __builtin_shufflevector(lo, hi, 0, 1, 2, 3, 4, 5, 6, 7); }
__device__ __forceinline__ void mma_frag(f32x4& c, const Frag<false>& b, const Frag<false>& a) {
    c = __builtin_amdgcn_mfma_f32_16x16x32_bf16(b.k[0], a.k[0], c, 0, 0, 0); c = __builtin_amdgcn_mfma_f32_16x16x32_bf16(b.k[1], a.k[1], c, 0, 0, 0); }
__device__ __forceinline__ void mma_block(f32x4 (&c)[4][2], const Frag<false> (&a)[4], const Frag<false> (&b)[2]) {
#pragma unroll
    for (int m = 0; m < 4; ++m)
#pragma unroll
        for (int n = 0; n < 2; ++n) { c[m][n] = __builtin_amdgcn_mfma_f32_16x16x32_bf16(b[n].k[0], a[m].k[0], c[m][n], 0, 0, 0); c[m][n] = __builtin_amdgcn_mfma_f32_16x16x32_bf16(b[n].k[1], a[m].k[1], c[m][n], 0, 0, 0); }
}
__device__ __forceinline__ void mma_block(f32x4 (&c)[4][2], const Frag<true> (&a)[4], const Frag<true> (&b)[2]) {
#if defined(__HIP_DEVICE_COMPILE__)
    const int sc = 0x7c7c7c7c;
    asm volatile("s_nop 1\n\t"
                 "v_mfma_scale_f32_16x16x128_f8f6f4 %0, %12, %8, %0, %14, %14 op_sel_hi:[0,0,0]\n\t"
                 "v_mfma_scale_f32_16x16x128_f8f6f4 %1, %13, %8, %1, %14, %14 op_sel_hi:[0,0,0]\n\t"
                 "v_mfma_scale_f32_16x16x128_f8f6f4 %2, %12, %9, %2, %14, %14 op_sel_hi:[0,0,0]\n\t"
                 "v_mfma_scale_f32_16x16x128_f8f6f4 %3, %13, %9, %3, %14, %14 op_sel_hi:[0,0,0]\n\t"
                 "v_mfma_scale_f32_16x16x128_f8f6f4 %4, %12, %10, %4, %14, %14 op_sel_hi:[0,0,0]\n\t"
                 "v_mfma_scale_f32_16x16x128_f8f6f4 %5, %13, %10, %5, %14, %14 op_sel_hi:[0,0,0]\n\t"
                 "v_mfma_scale_f32_16x16x128_f8f6f4 %6, %12, %11, %6, %14, %14 op_sel_hi:[0,0,0]\n\t"
                 "v_mfma_scale_f32_16x16x128_f8f6f4 %7, %13, %11, %7, %14, %14 op_sel_hi:[0,0,0]"
                 : "+v"(c[0][0]), "+v"(c[0][1]), "+v"(c[1][0]), "+v"(c[1][1]), "+v"(c[2][0]), "+v"(c[2][1]), "+v"(c[3][0]), "+v"(c[3][1])
                 : "v"(a[0].v), "v"(a[1].v), "v"(a[2].v), "v"(a[3].v), "v"(b[0].v), "v"(b[1].v), "v"(sc));
#endif
}
__device__ __forceinline__ void mma_frag(f32x4& c, const Frag<true>& b, const Frag<true>& a) {
    c = __builtin_amdgcn_mfma_scale_f32_16x16x128_f8f6f4(b.v, a.v, c, 0, 0, 0, 0x79797979, 0, 0x7f7f7f7f); }
struct NoConv { static constexpr int MODE = 0; __device__ __forceinline__ void prime() {} __device__ __forceinline__ void issue() {} __device__ __forceinline__ void reads() {} __device__ __forceinline__ void pack() {} template <int J> __device__ __forceinline__ void store() {} __device__ __forceinline__ void drain() {} };
template <class Epi, class Sched, bool ALIGN_EPI, bool SP2, bool FP8 = false, class Conv = NoConv>
__device__ __forceinline__ void gemm_phase(LAS unsigned char* lds, const int K, const Sched& S, const Epi& E, Conv cv = Conv()) {
    const int tid = threadIdx.x, wid = __builtin_amdgcn_readfirstlane(tid >> 6), lane = tid & 63, wr = wid >> 2, wc = wid & 3, fr = lane & 15, fq = lane >> 4;
    const int nt = FP8 ? K / 128 : K / BK;
    int Rr[2], Cc[2]; unsigned voffB[2];
#pragma unroll
    for (int i = 0; i < 2; ++i) { stage_rc(tid * 16 + i * 8192, Rr[i], Cc[i]); const int Rb = Epi::PERM ? ((Rr[i] & ~31) + (epi_wide<Epi>::value ? perm32w(Rr[i] & 31) : perm32(Rr[i] & 31))) : Rr[i]; voffB[i] = FP8 ? (unsigned)(Rb * K) + (unsigned)Cc[i] * 2u : (unsigned)(Rb * K + Cc[i]) * 2u; }
    const size_t kstep = (size_t)(BK * 2);
    const unsigned ldsw = (unsigned)wid * 1024u;
    const int aoff = lds_byte(wr * 64 + fr, fq * 8), boff = lds_byte(wc * 32 + fr, fq * 8);
#define PG8_SA(b, h) (((b) * 2 + (h)) * HTB)
#define PG8_SB(b, h) ((4 + (b) * 2 + (h)) * HTB)
#define PG8_STAGE(bufoff, gbase, voff) do { _Pragma("unroll") for (int _i = 0; _i < 2; ++_i) \
        __builtin_amdgcn_global_load_lds((const unsigned*)((const char*)(gbase) + (voff)[_i]), (LAS unsigned*)(lds + (bufoff) + ldsw + _i * 8192), 16, 0, 0); } while (0)
#define PG8_LDA(dst, b, h) do { _Pragma("unroll") for (int m = 0; m < 4; ++m) load_frag(dst[m], lds + PG8_SA(b, h) + aoff + m * 2048); } while (0)
#define PG8_LDB(dst, b, h) do { _Pragma("unroll") for (int n = 0; n < 2; ++n) load_frag(dst[n], lds + PG8_SB(b, h) + boff + n * 2048); } while (0)
#define PG8_MMA(ai, bj, At, Bt) do { __builtin_amdgcn_s_setprio(1); mma_block(acc[ai][bj], At, Bt); __builtin_amdgcn_s_setprio(0); } while (0)
#define PG8_WAIT_V(n) asm volatile("s_waitcnt vmcnt(" #n ")" ::: "memory")
#define PG8_WAIT_L(n) asm volatile("s_waitcnt lgkmcnt(" #n ")" ::: "memory")
#define PG8_WAIT_K() do { if constexpr (Conv::MODE == 0) PG8_WAIT_V(8); else if constexpr (Conv::MODE == 1) PG8_WAIT_V(9); else PG8_WAIT_V(10); } while (0)
#define PG8_BAR __builtin_amdgcn_s_barrier()
#define PG8_SCHED __builtin_amdgcn_sched_barrier(0)
    constexpr bool GATHER = Sched::AROW_LOADS;
    constexpr bool RELAX = SP2 && Conv::MODE == 0 && epi_relax<Epi>::value;
#define PG8_AOFFS(dst, u) do { if constexpr (GATHER) { _Pragma("unroll") for (int _h = 0; _h < 2; ++_h) _Pragma("unroll") for (int _i = 0; _i < 2; ++_i) dst[_h][_i] = S.arow(u, _h * HALF + Rr[_i]) + (unsigned)Cc[_i] * 2u; \
        asm volatile("" : "+v"(dst[0][0]), "+v"(dst[0][1]), "+v"(dst[1][0]), "+v"(dst[1][1])); } } while (0)
#define PG8_STAGE_A(bufoff, gbase, h, offs) do { if constexpr (GATHER) { PG8_STAGE(bufoff, gbase, (offs)[h]); } else { PG8_STAGE(bufoff, (gbase) + (h) * hstepA, voffA); } } while (0)
    int ui = 0;
    Unit cur;
    if (!S.next(0, cur)) return;
    f32x4 acc[2][2][4][2];
#pragma unroll
    for (int a = 0; a < 2; ++a)
#pragma unroll
        for (int b = 0; b < 2; ++b)
#pragma unroll
            for (int m = 0; m < 4; ++m)
#pragma unroll
                for (int n = 0; n < 2; ++n) acc[a][b][m][n] = (f32x4){0.f, 0.f, 0.f, 0.f};
    Frag<FP8> At[4], B0[2], B1[2];
    unsigned oA[2][2], oAn[2][2], voffA[2];
    const size_t hstepA = GATHER ? 0 : (size_t)S.hstepA();
#pragma unroll
    for (int i = 0; i < 2; ++i) { voffA[i] = GATHER ? 0u : S.arow(cur, Rr[i]) + (unsigned)Cc[i] * 2u; oA[0][i] = oA[1][i] = oAn[0][i] = oAn[1][i] = 0u; }
    PG8_AOFFS(oA, cur);
    const char* cA = cur.A; const char* cB0 = cur.B0; const char* cB1 = cur.B1;
    cv.prime();
    if constexpr (SP2) {
        PG8_STAGE(PG8_SB(0, 0), cB0, voffB); PG8_STAGE(PG8_SB(0, 1), cB1, voffB); PG8_STAGE_A(PG8_SA(0, 0), cA, 0, oA); PG8_STAGE_A(PG8_SA(0, 1), cA, 1, oA);
        if (wr == 1) PG8_BAR;
        PG8_WAIT_V(2); PG8_BAR;
        PG8_STAGE(PG8_SB(1, 0), cB0 + kstep, voffB); PG8_STAGE_A(PG8_SA(1, 0), cA + kstep, 0, oA); PG8_STAGE(PG8_SB(1, 1), cB1 + kstep, voffB);
        PG8_WAIT_V(6); PG8_BAR;
    } else {
        PG8_STAGE(PG8_SB(0, 0), cB0, voffB); PG8_STAGE_A(PG8_SA(0, 0), cA, 0, oA); PG8_STAGE(PG8_SB(0, 1), cB1, voffB); PG8_STAGE_A(PG8_SA(0, 1), cA, 1, oA);
        if (wr == 1) PG8_BAR;
        PG8_WAIT_V(4); PG8_BAR;
        PG8_STAGE(PG8_SB(1, 0), cB0 + kstep, voffB); PG8_STAGE_A(PG8_SA(1, 0), cA + kstep, 0, oA); PG8_STAGE(PG8_SB(1, 1), cB1 + kstep, voffB);
        PG8_WAIT_V(6); PG8_BAR;
    }
    for (;;) {
        bool has_next = false; const char* nA = cA; const char* nB0 = cB0; const char* nB1 = cB1;
#define PG8_NEXT_UNIT() do { if (t == 0) { Unit nxt; has_next = S.next(ui + 1, nxt); if (has_next) { nA = nxt.A; nB0 = nxt.B0; nB1 = nxt.B1; PG8_AOFFS(oAn, nxt); } else { \
            _Pragma("unroll") for (int _h = 0; _h < 2; ++_h) _Pragma("unroll") for (int _i = 0; _i < 2; ++_i) oAn[_h][_i] = oA[_h][_i]; } } } while (0)
        { const int t = 0; PG8_NEXT_UNIT(); }
        for (int t = 0; t < nt; t += 2) {
            const bool last = (t == nt - 2);
            const char* a1 = cA + (size_t)(t + 1) * kstep;
            const char* a2 = last ? nA : cA + (size_t)(t + 2) * kstep;
            const char* b20 = last ? nB0 : cB0 + (size_t)(t + 2) * kstep; const char* b21 = last ? nB1 : cB1 + (size_t)(t + 2) * kstep;
            const char* a3 = a2 + kstep; const char* b30 = b20 + kstep; const char* b31 = b21 + kstep;
            unsigned s2[2][2];
#pragma unroll
            for (int h = 0; h < 2; ++h)
#pragma unroll
                for (int i = 0; i < 2; ++i) s2[h][i] = last ? oAn[h][i] : oA[h][i];
            if constexpr (SP2) {
            const bool relaxed = RELAX && ui > 0 && t == 0;
            cv.issue(); PG8_LDB(B0, 0, 0); PG8_LDB(B1, 0, 1); PG8_SCHED; PG8_LDA(At, 0, 0); if (!relaxed) PG8_STAGE_A(PG8_SA(1, 1), a1, 1, oA); cv.reads();
            if (!relaxed) PG8_WAIT_K(); PG8_WAIT_L(0); PG8_BAR; PG8_MMA(0, 0, At, B0); PG8_MMA(0, 1, At, B1); cv.template store<0>(); PG8_BAR; PG8_SCHED;
            cv.issue(); PG8_LDA(At, 0, 1); PG8_STAGE(PG8_SB(0, 0), b20, voffB); PG8_STAGE(PG8_SB(0, 1), b21, voffB); PG8_STAGE_A(PG8_SA(0, 0), a2, 0, s2); cv.reads();
            if (!relaxed) PG8_WAIT_K(); PG8_WAIT_L(0); PG8_BAR; PG8_MMA(1, 0, At, B0); PG8_MMA(1, 1, At, B1); cv.template store<1>(); PG8_BAR; PG8_SCHED;
            cv.issue(); PG8_LDB(B0, 1, 0); PG8_LDB(B1, 1, 1); PG8_SCHED; PG8_LDA(At, 1, 0); PG8_STAGE_A(PG8_SA(0, 1), a2, 1, s2); cv.reads();
            if (!relaxed) PG8_WAIT_K(); PG8_WAIT_L(0); PG8_BAR; PG8_MMA(0, 0, At, B0); PG8_MMA(0, 1, At, B1); cv.template store<2>(); PG8_BAR; PG8_SCHED;
            cv.issue(); PG8_LDA(At, 1, 1); PG8_STAGE(PG8_SB(1, 0), b30, voffB); PG8_STAGE(PG8_SB(1, 1), b31, voffB); PG8_STAGE_A(PG8_SA(1, 0), a3, 0, s2); cv.reads();
            PG8_WAIT_K(); PG8_WAIT_L(0); PG8_BAR; PG8_MMA(1, 0, At, B0); PG8_MMA(1, 1, At, B1); cv.template store<3>(); PG8_BAR; PG8_SCHED;
            } else {
            PG8_LDB(B0, 0, 0); PG8_SCHED; PG8_LDA(At, 0, 0); PG8_STAGE_A(PG8_SA(1, 1), a1, 1, oA);
            PG8_WAIT_L(8); PG8_BAR; PG8_WAIT_L(0); PG8_MMA(0, 0, At, B0); PG8_BAR; PG8_SCHED;
            PG8_LDB(B1, 0, 1); PG8_STAGE(PG8_SB(0, 0), b20, voffB);
            PG8_BAR; PG8_WAIT_L(0); PG8_MMA(0, 1, At, B1); PG8_BAR;
            PG8_LDA(At, 0, 1); PG8_STAGE_A(PG8_SA(0, 0), a2, 0, s2);
            PG8_BAR; PG8_WAIT_L(0); PG8_MMA(1, 0, At, B0); PG8_BAR; PG8_SCHED;
            PG8_STAGE(PG8_SB(0, 1), b21, voffB);
            PG8_WAIT_V(6); PG8_BAR; PG8_MMA(1, 1, At, B1); PG8_BAR;
            PG8_LDB(B0, 1, 0); PG8_SCHED; PG8_LDA(At, 1, 0); PG8_STAGE_A(PG8_SA(0, 1), a2, 1, s2);
            PG8_WAIT_L(8); PG8_BAR; PG8_WAIT_L(0); PG8_MMA(0, 0, At, B0); PG8_BAR; PG8_SCHED;
            PG8_LDB(B1, 1, 1); PG8_STAGE(PG8_SB(1, 0), b30, voffB);
            PG8_BAR; PG8_WAIT_L(0); PG8_MMA(0, 1, At, B1); PG8_BAR;
            PG8_LDA(At, 1, 1); PG8_STAGE_A(PG8_SA(1, 0), a3, 0, s2);
            PG8_BAR; PG8_WAIT_L(0); PG8_MMA(1, 0, At, B0); PG8_BAR; PG8_SCHED;
            PG8_STAGE(PG8_SB(1, 1), b31, voffB);
            PG8_WAIT_V(6); PG8_BAR; PG8_MMA(1, 1, At, B1); PG8_BAR;
            }
        }
        if constexpr (RELAX) { if (has_next) PG8_STAGE_A(PG8_SA(1, 1), nA + kstep, 1, oAn); }
        if constexpr (ALIGN_EPI) { if (wr == 0) PG8_BAR; }
        if constexpr (FP8) asm volatile("s_nop 15\n\ts_nop 7" ::: "memory");
        bool chained = false;
        { Unit eu; (void)S.next(ui, eu);
          if constexpr (Epi::CHAIN) { if (eu.kind == 0) { E.mid(acc, eu, wr, wc, fr, fq); chained = true; } else E(acc, eu, wr, wc, fr, fq); }
          else E(acc, eu, wr, wc, fr, fq); }
        if (!has_next) break;
        if (!chained) {
#pragma unroll
        for (int a = 0; a < 2; ++a)
#pragma unroll
            for (int b = 0; b < 2; ++b)
#pragma unroll
                for (int m = 0; m < 4; ++m)
#pragma unroll
                    for (int n = 0; n < 2; ++n) acc[a][b][m][n] = (f32x4){0.f, 0.f, 0.f, 0.f};
        }
        cA = nA; cB0 = nB0; cB1 = nB1; ++ui;
#pragma unroll
        for (int h = 0; h < 2; ++h)
#pragma unroll
            for (int i = 0; i < 2; ++i) oA[h][i] = oAn[h][i];
        if constexpr (ALIGN_EPI) { if (wr == 1) PG8_BAR; }
    }
    PG8_WAIT_V(0);
    if constexpr (!ALIGN_EPI) { if (wr == 0) PG8_BAR; }
    PG8_BAR;
    cv.drain();
#undef PG8_SA
#undef PG8_SB
#undef PG8_STAGE
#undef PG8_LDA
#undef PG8_LDB
#undef PG8_MMA
#undef PG8_WAIT_V
#undef PG8_WAIT_L
#undef PG8_WAIT_K
#undef PG8_BAR
#undef PG8_SCHED
#undef PG8_AOFFS
#undef PG8_NEXT_UNIT
#undef PG8_STAGE_A
}
}
using pg8::Unit;

struct Args { const float* in[18]; float* out; unsigned char* ws; int ph_lo, ph_hi; };
struct Frame {
    LAS unsigned char* lds;
    int tid, lane, wave, vcu, G;
    const float *x, *meta, *g_mix, *w_in, *conv_w, *w_conv_out, *w_attn_out, *w_o, *g_ffn, *w_router, *b_router, *w_gate, *b_gate, *w_up, *b_up, *w_down, *b_down, *g_final;
    float* out; unsigned char* ws; unsigned* ctl;
};
#define WSP(T, off) ((T*)(F.ws + (off)))

__device__ __forceinline__ void p0_item_load(const float* W, int N, int item, int lane, f32x4 (&v)[8], int ldn = 0) {
    const int nblk = N / 32, kb = item / nblk, nb = item % nblk, k0 = 64 * kb, n0 = 32 * nb; const int ld = ldn ? ldn : N;
#pragma unroll
    for (int i = 0; i < 8; ++i) { const int p = 64 * i + lane; v[i] = *(const GAS f32x4*)(W + (size_t)(k0 + (p >> 3)) * ld + n0 + 4 * (p & 7)); }
}
__device__ __forceinline__ void p0_item_finish(const f32x4 (&v)[8], int K, int N, bf16* WT, LAS float* scr, int item, int lane) {
    const int nblk = N / 32, kb = item / nblk, nb = item % nblk, k0 = 64 * kb, n0 = 32 * nb;
#pragma unroll
    for (int i = 0; i < 8; ++i) { const int p = 64 * i + lane; LAS float* d = scr + (p >> 3) * 33 + 4 * (p & 7); d[0] = v[i][0]; d[1] = v[i][1]; d[2] = v[i][2]; d[3] = v[i][3]; }
    LDS_WAIT(); asm volatile("" ::: "memory");
    const int c = lane & 7;
#pragma unroll
    for (int j = 0; j < 4; ++j) { const int n = (lane >> 3) + 8 * j; const LAS float* s = scr + (8 * c) * 33 + n;
        u32x4 o; o.x = pk2(s[0 * 33], s[1 * 33]); o.y = pk2(s[2 * 33], s[3 * 33]); o.z = pk2(s[4 * 33], s[5 * 33]); o.w = pk2(s[6 * 33], s[7 * 33]);
        *(GAS u32x4*)(WT + (size_t)(n0 + n) * K + k0 + 8 * c) = o; }
    LDS_WAIT(); asm volatile("" ::: "memory");
}
__device__ __forceinline__ void p0_item_finish_fp8(const f32x4 (&v)[8], int K, int N, unsigned char* WT8, LAS float* scr, int item, int lane) {
    const int nblk = N / 32, kb = item / nblk, nb = item % nblk, k0 = 64 * kb, n0 = 32 * nb;
#pragma unroll
    for (int i = 0; i < 8; ++i) { const int p = 64 * i + lane; LAS float* d = scr + (p >> 3) * 33 + 4 * (p & 7); d[0] = v[i][0]; d[1] = v[i][1]; d[2] = v[i][2]; d[3] = v[i][3]; }
    LDS_WAIT(); asm volatile("" ::: "memory");
    const int c = lane & 3;
#pragma unroll
    for (int j = 0; j < 2; ++j) { const int n = (lane >> 2) + 16 * j; const LAS float* s = scr + (16 * c) * 33 + n;
        u32x4 o;
        o.x = cvt4_fp8(64.f * s[0 * 33], 64.f * s[1 * 33], 64.f * s[2 * 33], 64.f * s[3 * 33]);   o.y = cvt4_fp8(64.f * s[4 * 33], 64.f * s[5 * 33], 64.f * s[6 * 33], 64.f * s[7 * 33]);
        o.z = cvt4_fp8(64.f * s[8 * 33], 64.f * s[9 * 33], 64.f * s[10 * 33], 64.f * s[11 * 33]); o.w = cvt4_fp8(64.f * s[12 * 33], 64.f * s[13 * 33], 64.f * s[14 * 33], 64.f * s[15 * 33]);
        *(GAS u32x4*)(WT8 + (size_t)(n0 + n) * K + k0 + 16 * c) = o; }
    LDS_WAIT(); asm volatile("" ::: "memory");
}
__device__ __forceinline__ void p0_transpose_item(const float* W, int K, int N, bf16* WT, int row_off, LAS float* scr, int item, int lane) {
    f32x4 v[8]; p0_item_load(W, N, item, lane, v); p0_item_finish(v, K, N, WT + (size_t)row_off * K, scr, item, lane);
}
template <bool FP8>
__device__ __forceinline__ void p0_transpose_stream(const float* W, bf16* WT, int K, int N, int nmat, int gw, int NGW, LAS float* scr, int lane, int ldn = 0) {
    const int ipm = (K / 64) * (N / 32), total = nmat * ipm; const size_t msz = (size_t)K * N;
    for (int it = gw; it < total; it += 3 * NGW) {
        const int i1 = it + NGW, i2 = it + 2 * NGW;
        f32x4 va[8], vb[8], vc[8];
        p0_item_load(W + (size_t)(it / ipm) * msz, N, it % ipm, lane, va, ldn);
        if (i1 < total) p0_item_load(W + (size_t)(i1 / ipm) * msz, N, i1 % ipm, lane, vb, ldn);
        if (i2 < total) p0_item_load(W + (size_t)(i2 / ipm) * msz, N, i2 % ipm, lane, vc, ldn);
        if constexpr (FP8) p0_item_finish_fp8(va, K, N, (unsigned char*)WT + (size_t)(it / ipm) * msz, scr, it % ipm, lane); else p0_item_finish(va, K, N, WT + (size_t)(it / ipm) * msz, scr, it % ipm, lane);
        if (i1 < total) { if constexpr (FP8) p0_item_finish_fp8(vb, K, N, (unsigned char*)WT + (size_t)(i1 / ipm) * msz, scr, i1 % ipm, lane); else p0_item_finish(vb, K, N, WT + (size_t)(i1 / ipm) * msz, scr, i1 % ipm, lane); }
        if (i2 < total) { if constexpr (FP8) p0_item_finish_fp8(vc, K, N, (unsigned char*)WT + (size_t)(i2 / ipm) * msz, scr, i2 % ipm, lane); else p0_item_finish(vc, K, N, WT + (size_t)(i2 / ipm) * msz, scr, i2 % ipm, lane); }
    }
}
__device__ __forceinline__ void rms_row_to_bf16(const float* xrow, const float* g, bf16* orow, int lane, unsigned char* orow8 = nullptr, bf16* xbrow = nullptr) {
    const GAS f32x4* xr = (const GAS f32x4*)xrow + lane; const GAS f32x4* gr = (const GAS f32x4*)g + lane;
    f32x4 v[8]; float s = 0.f;
#pragma unroll
    for (int j = 0; j < 8; ++j) { v[j] = xr[64 * j]; s += (v[j].x * v[j].x + v[j].y * v[j].y) + (v[j].z * v[j].z + v[j].w * v[j].w); }
    if (xbrow) { GAS u32x2* xb8 = (GAS u32x2*)xbrow + lane;
#pragma unroll
        for (int j = 0; j < 8; ++j) { u32x2 w; w.x = pk2(v[j].x, v[j].y); w.y = pk2(v[j].z, v[j].w); xb8[64 * j] = w; } }
    const float rstd = rsqrtf(wave_sum(s) * (1.f / D) + EPS);
    GAS u32x2* o8 = (GAS u32x2*)orow + lane;
#pragma unroll
    for (int j = 0; j < 8; ++j) { const f32x4 gg = gr[64 * j]; const f32x4 y = {v[j].x * rstd * gg.x, v[j].y * rstd * gg.y, v[j].z * rstd * gg.z, v[j].w * rstd * gg.w};
        u32x2 w; w.x = pk2(y.x, y.y); w.y = pk2(y.z, y.w); o8[64 * j] = w;
        if (orow8) ((GAS unsigned*)orow8)[lane + 64 * j] = cvt4_fp8(y.x, y.y, y.z, y.w); }
}
__device__ __forceinline__ void p0_prologue(Frame& F, bool ride) {
    LAS float* scr = (LAS float*)(F.lds + F.wave * 16384);
    const int gw = F.vcu * 8 + F.wave, NGW = F.G * 8;
    if (!ride) {
    p0_transpose_stream<true>(F.w_gate, WSP(bf16, WS_WG), D, DFF, NE, gw, NGW, scr, F.lane);
    p0_transpose_stream<true>(F.w_up, WSP(bf16, WS_WU), D, DFF, NE, gw, NGW, scr, F.lane);
    p0_transpose_stream<true>(F.w_down, WSP(bf16, WS_WD), DFF, D, NE, gw, NGW, scr, F.lane);
    }
    p0_transpose_stream<false>(F.w_in, WSP(bf16, WS_WIN), D, O_GC, 1, gw, NGW, scr, F.lane, INW);
    p0_transpose_stream<true>(F.w_in + O_GC, WSP(bf16, WS_WIN8), D, INW - O_GC, 1, gw, NGW, scr, F.lane, INW);
    p0_transpose_stream<false>(F.w_conv_out, WSP(bf16, WS_WCONV), CC, D, 1, gw, NGW, scr, F.lane);
    p0_transpose_stream<false>(F.w_attn_out, WSP(bf16, WS_WATTN), AW, D, 1, gw, NGW, scr, F.lane);
    p0_transpose_stream<false>(F.w_o, WSP(bf16, WS_WO), D, D, 1, gw, NGW, scr, F.lane);
#ifdef PROBE_STREAM
    {
        f32x4 acc4 = {0.f, 0.f, 0.f, 0.f};
        const size_t n4 = (size_t)NE * D * DFF / 4;
        for (int w3 = 0; w3 < 3; ++w3) { const GAS f32x4* p = (const GAS f32x4*)(w3 == 0 ? F.w_gate : w3 == 1 ? F.w_up : F.w_down);
            for (size_t i = (size_t)gw * 64 + F.lane; i < n4; i += (size_t)NGW * 64 * 32) {
#pragma unroll
                for (int u = 0; u < 32; ++u) { const size_t j = i + (size_t)u * NGW * 64; if (j < n4) acc4 += p[j]; } } }
        if (acc4[0] + acc4[1] + acc4[2] + acc4[3] == 123456.789f) WSP(float, WS_HM)[1024 * 1024 / 4 - 1] = 1.f;
    }
#endif
    for (int m = gw; m < MR; m += NGW) rms_row_to_bf16(F.x + (size_t)m * D, F.g_mix, WSP(bf16, WS_HN) + (size_t)m * D, F.lane, WSP(unsigned char, WS_HN8) + (size_t)m * D, WSP(bf16, WS_XB) + (size_t)m * D);
    if (gw < NMETA) rms_row_to_bf16(F.meta + (size_t)gw * D, F.g_mix, WSP(bf16, WS_HM) + (size_t)gw * D, F.lane);
    for (int c = blockIdx.x * 512 + F.tid; c < 64 * 2 * 64; c += F.G * 512) {
        const int ln = c & 63, eb = (c >> 6) & 1, ks = c >> 7; const float* w = F.w_router + (size_t)(32 * ks + 8 * (ln >> 4)) * NE + 16 * eb + (ln & 15);
        u32x4 o; o.x = pk2(w[0], w[NE]); o.y = pk2(w[2 * NE], w[3 * NE]); o.z = pk2(w[4 * NE], w[5 * NE]); o.w = pk2(w[6 * NE], w[7 * NE]);
        *(WSP(u32x4, WS_WRF) + c) = o;
    }
}

template <class S> __device__ __forceinline__ void build_units(const S& sch, LAS int* ut) {
    const int lt = (int)__builtin_amdgcn_mbcnt_hi(~0u, __builtin_amdgcn_mbcnt_lo(~0u, 0u));
    if (__builtin_amdgcn_readfirstlane((int)threadIdx.x) < 64) { int f[8]; f[7] = 0; sch.coords(lt, f);
#pragma unroll
        for (int k = 0; k < 8; ++k) ut[8 * lt + k] = f[k]; }
    __syncthreads();
}
__device__ __forceinline__ bool read_unit(const LAS int* ut, int i, Unit& u) {
    if (i >= 64) return false;
    const LAS int* p = ut + 8 * i;
    if (__builtin_amdgcn_readfirstlane(p[0]) == 0) return false;
    u.pm = __builtin_amdgcn_readfirstlane(p[1]); u.pn = __builtin_amdgcn_readfirstlane(p[2]); u.kind = __builtin_amdgcn_readfirstlane(p[3]);
    u.e = __builtin_amdgcn_readfirstlane(p[4]); u.aux = __builtin_amdgcn_readfirstlane(p[5]); u.nrow = __builtin_amdgcn_readfirstlane(p[6]);
    return true;
}

template <int NB>
struct ConvW {
    static_assert(NB == 8, "one batch size");
    static constexpr int MODE = 1;
    const float* wg; const float* wu; const float* wd; unsigned char* w8; LAS unsigned char* ring; int gw, s_iss, s_con, s_end; unsigned voff, rdoff, dstoff; float x[4]; unsigned d[NB];
    __device__ __forceinline__ void one() {
        const int strip = (s_iss >> 7) * 2048 + gw, kg = s_iss & 127, mat = strip >> 7, nb = strip & 127;
        const float* W = (mat < 32 ? wg : mat < 64 ? wu : wd) + (size_t)(mat & 31) * D * DFF;
        const char* src = (const char*)W + (size_t)kg * (16 * 8192) + nb * 64;
        __builtin_amdgcn_global_load_lds((const unsigned*)(src + voff), (LAS unsigned*)(ring + (s_iss % 3) * 1024), 16, 0, 0);
        ++s_iss;
    }
    __device__ __forceinline__ void prime() { if (s_iss < s_end) one(); if (s_iss < s_end) one(); }
    __device__ __forceinline__ void issue() { if (s_iss < s_end) one(); }
    __device__ __forceinline__ void reads() { if (s_con < s_end) { const LAS float* p = (const LAS float*)(ring + (s_con % 3) * 1024 + rdoff); x[0] = p[0]; x[1] = p[64]; x[2] = p[128]; x[3] = p[192]; } }
    template <int J> __device__ __forceinline__ void store() { if (s_con < s_end) {
        const unsigned v = cvt4_fp8(64.f * x[0], 64.f * x[1], 64.f * x[2], 64.f * x[3]);
        const bool par = (s_con >> 2) & 1;
        if (par) d[4 + J] = v; else d[J] = v;
        if (J == 3 && par) {
            const int s0 = s_con - 7, strip = (s0 >> 7) * 2048 + gw, kg = s0 & 127, mat = strip >> 7, nb = strip & 127;
            unsigned char* dst = w8 + (size_t)(mat >> 5) * (256 * MiB) + (size_t)(mat & 31) * D * DFF + (size_t)nb * 16 * 2048 + kg * 16;
            const auto a0 = __builtin_amdgcn_permlane32_swap(d[0], d[2], false, false), a1 = __builtin_amdgcn_permlane32_swap(d[1], d[3], false, false);
            const auto a2 = __builtin_amdgcn_permlane32_swap(d[4], d[6], false, false), a3 = __builtin_amdgcn_permlane32_swap(d[5], d[7], false, false);
            const auto va0 = __builtin_amdgcn_permlane16_swap(a0[0], a1[0], false, false), vb0 = __builtin_amdgcn_permlane16_swap(a0[1], a1[1], false, false);
            const auto va1 = __builtin_amdgcn_permlane16_swap(a2[0], a3[0], false, false), vb1 = __builtin_amdgcn_permlane16_swap(a2[1], a3[1], false, false);
            u32x4 o0, o1; o0.x = va0[0]; o0.y = va0[1]; o0.z = vb0[0]; o0.w = vb0[1]; o1.x = va1[0]; o1.y = va1[1]; o1.z = vb1[0]; o1.w = vb1[1];
            *(GAS u32x4*)(dst + dstoff) = o0; *(GAS u32x4*)(dst + dstoff + 64) = o1; }
        ++s_con; } }
    __device__ __forceinline__ void drain() {}
};

struct ConvProbe {
    static constexpr int MODE = 1;
    const float* wg; const float* wu; const float* wd; LAS unsigned char* ring; int gw; unsigned voff; int s;
    __device__ __forceinline__ void one() {
        const int strip = gw * 3 + (s >> 8), kg = s & 255, mat = strip >> 6, nb = strip & 63;
        const float* W = (mat < 32 ? wg : mat < 64 ? wu : wd) + (size_t)(mat & 31) * D * DFF;
        const char* src = (const char*)W + (size_t)kg * 65536 + nb * 128;
        __builtin_amdgcn_global_load_lds((const unsigned*)(src + voff), (LAS unsigned*)(ring + (s % 3) * 1024), 16, 0, 0);
        ++s;
    }
    __device__ __forceinline__ void prime() { one(); one(); }
    __device__ __forceinline__ void issue() { if (s < 768) one(); else { const char* src = (const char*)wg; __builtin_amdgcn_global_load_lds((const unsigned*)(src + voff), (LAS unsigned*)(ring + (s % 3) * 1024), 16, 0, 0); ++s; } }
    __device__ __forceinline__ void reads() {} __device__ __forceinline__ void pack() {} template <int J> __device__ __forceinline__ void store() {} __device__ __forceinline__ void drain() {}
};

__device__ __forceinline__ void p1_meta(Frame& F) {
    const int fr = F.lane & 15, fq = F.lane >> 4;
    LAS f32x4* part = (LAS f32x4*)F.lds;
    for (int j = blockIdx.x; j < 192; j += F.G) {
        const int cb = j & 63, sp = j >> 6;
        const int c0 = 16 * cb;
        const bf16* hm = WSP(bf16, WS_HM) + (size_t)fr * D + 8 * fq + 256 * F.wave;
        const bf16* w0 = WSP(bf16, WS_WIN) + (size_t)((sp == 0 ? O_U : sp == 1 ? O_K : O_V) + c0 + fr) * D + 8 * fq + 256 * F.wave;
        const bf16* w1 = WSP(bf16, WS_WIN) + (size_t)(O_C + c0 + fr) * D + 8 * fq + 256 * F.wave;
        f32x4 a0 = {0.f, 0.f, 0.f, 0.f}, a1 = {0.f, 0.f, 0.f, 0.f};
        const bf16* w1p = sp == 0 ? w1 : w0;
        bf16x8 af[8], b0[8], b1[8];
#pragma unroll
        for (int s = 0; s < 8; ++s) { af[s] = *(const bf16x8*)(hm + 32 * s); b0[s] = *(const bf16x8*)(w0 + 32 * s); b1[s] = *(const bf16x8*)(w1p + 32 * s); }
#pragma unroll
        for (int s = 0; s < 8; ++s) { a0 = __builtin_amdgcn_mfma_f32_16x16x32_bf16(af[s], b0[s], a0, 0, 0, 0); a1 = __builtin_amdgcn_mfma_f32_16x16x32_bf16(af[s], b1[s], a1, 0, 0, 0); }
        part[(F.wave * 2 + 0) * 64 + F.lane] = a0; part[(F.wave * 2 + 1) * 64 + F.lane] = a1;
        __syncthreads();
        if (F.wave == 0) {
            a0 = part[F.lane]; a1 = part[64 + F.lane];
#pragma unroll
            for (int w = 1; w < 8; ++w) { a0 += part[(w * 2 + 0) * 64 + F.lane]; a1 += part[(w * 2 + 1) * 64 + F.lane]; }
            bf16* dst = WSP(bf16, sp == 0 ? WS_CU : sp == 1 ? WS_K : WS_V);
#pragma unroll
            for (int jj = 0; jj < 4; ++jj) { const int tok = 4 * fq + jj; const float v = sp == 0 ? a0[jj] * a1[jj] : a0[jj];
#pragma unroll
                for (int b = 0; b < BATCH; ++b) dst[(size_t)(b * LTOT + tok) * 1024 + c0 + fr] = (bf16)f2bf(v); }
        }
        __syncthreads();
    }
}
struct Sched1 {
    static constexpr bool AROW_LOADS = false;
    int G, c; unsigned char* ws; const LAS int* ut;
    __device__ __forceinline__ void coords(int i, int (&f)[8]) const { int pm = 0, pn = 0; f[0] = pg8::static_tile(i * G + c, MR / 256, 24, pm, pn) ? 1 : 0; f[1] = pm; f[2] = pn; f[3] = 0; f[4] = 0; f[5] = 0; f[6] = 256; }
    __device__ __forceinline__ bool next(int i, Unit& u) const {
        if (!read_unit(ut, i, u)) return false;
        const char* W = (const char*)(ws + WS_WIN);
        u.A = (const char*)(ws + WS_HN) + (size_t)u.pm * 256 * D * 2; u.e = 0; u.nrow = 256; u.aux = 0;
        if (u.pn < 8) { u.kind = 0; u.B0 = W + (size_t)(O_U + 128 * u.pn) * D * 2; u.B1 = W + (size_t)(O_C + 128 * u.pn) * D * 2; u.dst = (char*)(ws + WS_CU) + 256 * u.pn; u.ld = 1024; u.aux = 1; }
        else {
            const int col0 = u.pn < 12 ? O_B + (u.pn - 8) * 256 : O_Q + (u.pn - 12) * 256;
            u.B0 = W + (size_t)col0 * D * 2; u.B1 = u.B0 + (size_t)128 * D * 2; u.kind = 1;
            if (col0 < O_C) { u.dst = (char*)(ws + WS_BP) + (col0 - O_B) * 2; u.ld = 1024; }
            else if (col0 < O_K) { u.dst = (char*)(ws + WS_Q) + (col0 - O_Q) * 2; u.ld = 1024; u.kind = 2; }
            else if (col0 < O_V) { u.dst = (char*)(ws + WS_K) + (col0 - O_K) * 2; u.ld = 1024; u.aux = 1; }
            else if (col0 < O_GC) { u.dst = (char*)(ws + WS_V) + (col0 - O_V) * 2; u.ld = 1024; u.aux = 1; }
            else if (col0 < O_GA) { u.dst = (char*)(ws + WS_GC) + (col0 - O_GC) * 2; u.ld = 2048; }
            else { u.dst = (char*)(ws + WS_GA) + (col0 - O_GA) * 2; u.ld = 2048; }
        }
        return true;
    }
    __device__ __forceinline__ unsigned arow(const Unit&, int r) const { return (unsigned)r * (unsigned)(D * 2); }
    __device__ __forceinline__ unsigned hstepA() const { return 128u * D * 2u; }
};
struct Sched1g {
    static constexpr bool AROW_LOADS = false;
    int G, c; unsigned char* ws; const LAS int* ut;
    __device__ __forceinline__ void coords(int i, int (&f)[8]) const { int pm = 0, pn = 0; f[0] = pg8::static_tile(i * G + c, MR / 256, 16, pm, pn) ? 1 : 0; f[1] = pm; f[2] = pn; f[3] = 1; f[4] = 0; f[5] = 0; f[6] = 256; }
    __device__ __forceinline__ bool next(int i, Unit& u) const {
        if (!read_unit(ut, i, u)) return false;
        u.A = (const char*)(ws + WS_HN8) + (size_t)u.pm * 256 * D; u.e = 0; u.nrow = 256; u.aux = 0; u.kind = 1;
        u.B0 = (const char*)(ws + WS_WIN8) + (size_t)(128 * u.pn) * D; u.B1 = u.B0 + (size_t)2048 * D;
        u.dst = (char*)(ws + WS_GC) + (size_t)(128 * u.pn) * 2; u.ld = 2048;
        return true;
    }
    __device__ __forceinline__ unsigned arow(const Unit&, int r) const { return (unsigned)r * (unsigned)D; }
    __device__ __forceinline__ unsigned hstepA() const { return 128u * D; }
};
struct Epi1 {
    static constexpr bool PERM = true; static constexpr bool CHAIN = false;
    __device__ __forceinline__ void operator()(const f32x4 (&acc)[2][2][4][2], const Unit& u, int wr, int wc, int fr, int fq) const {
        const int m0 = u.pm * 256 + wr * 64 + fr; const int radd = u.aux ? NMETA * (m0 / SEQ + 1) : 0;
        const float sc = u.kind == 2 ? 0.08838834764831845f : 1.f;
#pragma unroll
        for (int ai = 0; ai < 2; ++ai)
#pragma unroll
            for (int m = 0; m < 4; ++m) {
                bf16* rowp = (bf16*)u.dst + (size_t)(m0 + radd + ai * 128 + m * 16) * u.ld + wc * 32 + 8 * fq;
                if (u.kind == 0) { const f32x4 v0 = acc[ai][0][m][0] * acc[ai][1][m][0], v1 = acc[ai][0][m][1] * acc[ai][1][m][1];
                    u32x4 w; w.x = cvt_pk_bf16(v0[0], v0[1]); w.y = cvt_pk_bf16(v0[2], v0[3]); w.z = cvt_pk_bf16(v1[0], v1[1]); w.w = cvt_pk_bf16(v1[2], v1[3]);
                    *(u32x4*)rowp = w; }
                else {
#pragma unroll
                    for (int bj = 0; bj < 2; ++bj) { const f32x4 v0 = acc[ai][bj][m][0] * sc, v1 = acc[ai][bj][m][1] * sc;
                        u32x4 w; w.x = cvt_pk_bf16(v0[0], v0[1]); w.y = cvt_pk_bf16(v0[2], v0[3]); w.z = cvt_pk_bf16(v1[0], v1[1]); w.w = cvt_pk_bf16(v1[2], v1[3]);
                        *(u32x4*)(rowp + bj * 128) = w; } }
            }
    }
};

struct Epi1g {
    static constexpr bool PERM = true; static constexpr bool CHAIN = false;
    __device__ __forceinline__ void operator()(const f32x4 (&acc)[2][2][4][2], const Unit& u, int wr, int wc, int fr, int fq) const {
        const int m0 = u.pm * 256 + wr * 64 + fr;
#pragma unroll
        for (int ai = 0; ai < 2; ++ai)
#pragma unroll
            for (int m = 0; m < 4; ++m) {
                bf16* rowp = (bf16*)u.dst + (size_t)(m0 + ai * 128 + m * 16) * 2048 + wc * 32 + 8 * fq;
                float r[8], sg[8];
#pragma unroll
                for (int n = 0; n < 2; ++n)
#pragma unroll
                    for (int j = 0; j < 4; ++j) { const float ea = __expf(-acc[ai][1][m][n][j]), ec = __expf(-acc[ai][0][m][n][j]);
                        sg[4 * n + j] = __builtin_amdgcn_rcpf(1.f + ea); r[4 * n + j] = (1.f + ea) * __builtin_amdgcn_rcpf(1.f + ec); }
                u32x4 w; w.x = cvt_pk_bf16(r[0], r[1]); w.y = cvt_pk_bf16(r[2], r[3]); w.z = cvt_pk_bf16(r[4], r[5]); w.w = cvt_pk_bf16(r[6], r[7]);
                *(u32x4*)rowp = w;
                w.x = cvt_pk_bf16(sg[0], sg[1]); w.y = cvt_pk_bf16(sg[2], sg[3]); w.z = cvt_pk_bf16(sg[4], sg[5]); w.w = cvt_pk_bf16(sg[6], sg[7]);
                *(u32x4*)(rowp + (WS_GA - WS_GC) / 2) = w;
            }
    }
};

typedef short v4i16_t __attribute__((ext_vector_type(4)));
__device__ __forceinline__ s16x4 vtr(const LAS unsigned char* p) { return __builtin_bit_cast(s16x4, __builtin_amdgcn_ds_read_tr16_b64_v4i16((LAS v4i16_t*)p)); }
__device__ __forceinline__ int voff_b(int row, int ch) { return 256 * row + 16 * (ch ^ (((row & 3) << 2) | ((row >> 2) & 3))); }
__device__ __forceinline__ void p2_attn(Frame& F) {
    const int gw = F.vcu * 8 + F.wave, NGW = F.G * 8, lane = F.lane, r = lane & 31, hf = lane >> 5;
    LAS unsigned char* vl = F.lds + F.wave * 8192;
    const int gl = lane & 15, tq = gl >> 2, tp = gl & 3, cg = (lane >> 4) & 1;
    for (int item = gw; item < BATCH * NH * (SEQ / 32); item += NGW) {
        const int qb = item & 127, h = (item >> 7) & 7, b = item >> 10;
        const int m0 = b * SEQ + 32 * qb, p0 = NMETA + 32 * qb;
        bf16x8 qf[8];
        { const bf16* qp = WSP(bf16, WS_Q) + (size_t)(m0 + r) * 1024 + h * HD + 8 * hf;
#pragma unroll
          for (int kk = 0; kk < 8; ++kk) qf[kk] = *(const bf16x8*)(qp + 16 * kk); }
        f32x16 O[4];
#pragma unroll
        for (int d = 0; d < 4; ++d)
#pragma unroll
            for (int i = 0; i < 16; ++i) O[d][i] = 0.f;
        float carry = 0.f;
        const bf16* kbase = WSP(bf16, WS_K) + (size_t)(b * LTOT) * 1024 + h * HD;
        const bf16* vbase = WSP(bf16, WS_V) + (size_t)(b * LTOT) * 1024 + h * HD;
        bf16x8 kf[8];
        { int ks = p0 + r; ks = ks > LTOT - 1 ? LTOT - 1 : ks; const bf16* kp = kbase + (size_t)ks * 1024 + 8 * hf;
#pragma unroll
          for (int kk = 0; kk < 8; ++kk) kf[kk] = *(const bf16x8*)(kp + 16 * kk); }
        for (int s0 = p0; s0 > -32; s0 -= 32) {
            f32x16 S;
#pragma unroll
            for (int i = 0; i < 16; ++i) S[i] = 0.f;
#pragma unroll
            for (int kk = 0; kk < 8; ++kk) S = __builtin_amdgcn_mfma_f32_32x32x16_bf16(kf[kk], qf[kk], S, 0, 0, 0);
            __builtin_amdgcn_sched_barrier(0);
            unsigned vadj = 0u; asm volatile("" : "+v"(vadj) : "v"(S[15]));
#pragma unroll
            for (int i = 0; i < 8; ++i) { const int p = i * 64 + lane, row = p >> 4, ch = (p & 15) ^ (((row & 3) << 2) | ((row >> 2) & 3)); int vs = s0 + row; vs = vs < 0 ? 0 : (vs > LTOT - 1 ? LTOT - 1 : vs);
                __builtin_amdgcn_global_load_lds((const unsigned*)(vbase + (size_t)vs * 1024 + ch * 8 + vadj), (LAS unsigned*)(vl + i * 1024), 16, 0, 0); }
            { int ks = s0 - 32 + r; ks = ks < 0 ? 0 : (ks > LTOT - 1 ? LTOT - 1 : ks); const bf16* kp = kbase + (size_t)ks * 1024 + 8 * hf;
#pragma unroll
              for (int kk = 0; kk < 8; ++kk) kf[kk] = *(const bf16x8*)(kp + 16 * kk); }
            __builtin_amdgcn_sched_barrier(0);
            float lr[16], lb[16];
#pragma unroll
            for (int i = 0; i < 16; ++i) { const int s = s0 + (i & 3) + 8 * (i >> 2) + 4 * hf; const bool valid = (s < p0 + r) && (s >= 0); const float z = S[i];
                const float l = fminf(z, 0.f) - __logf(1.f + __expf(-fabsf(z)));
                lb[i] = valid ? l : -1e30f; lr[i] = valid ? l - z : 0.f; }
            float own[4], oth[4], suf[4];
#pragma unroll
            for (int c = 0; c < 4; ++c) { own[c] = (lr[4 * c] + lr[4 * c + 1]) + (lr[4 * c + 2] + lr[4 * c + 3]); oth[c] = __shfl_xor(own[c], 32); }
            float tail = 0.f;
#pragma unroll
            for (int c = 3; c >= 0; --c) { suf[c] = tail + (hf == 0 ? oth[c] : 0.f); tail += own[c] + oth[c]; }
            float w[16];
#pragma unroll
            for (int c = 0; c < 4; ++c) { float in = carry + suf[c];
#pragma unroll
                for (int j = 3; j >= 0; --j) { w[4 * c + j] = __expf(lb[4 * c + j] + in); in += lr[4 * c + j]; } }
            carry += tail;
            bf16x8 pf[2];
#pragma unroll
            for (int s = 0; s < 2; ++s) { u32x4 t; t.x = cvt_pk_bf16(w[8 * s], w[8 * s + 1]); t.y = cvt_pk_bf16(w[8 * s + 2], w[8 * s + 3]); t.z = cvt_pk_bf16(w[8 * s + 4], w[8 * s + 5]); t.w = cvt_pk_bf16(w[8 * s + 6], w[8 * s + 7]);
                pf[s] = __builtin_bit_cast(bf16x8, t); }
            asm volatile("s_waitcnt vmcnt(8)" ::: "memory");
            __builtin_amdgcn_sched_barrier(0);
#pragma unroll
            for (int db = 0; db < 4; ++db)
#pragma unroll
                for (int s = 0; s < 2; ++s) {
                    const int r0 = 16 * s + 4 * hf, c0 = 4 * db + 2 * cg;
                    const s16x4 lo = vtr(vl + voff_b(r0 + tq, c0 + (tp >> 1)) + 8 * (tp & 1));
                    const s16x4 hi = vtr(vl + voff_b(r0 + 8 + tq, c0 + (tp >> 1)) + 8 * (tp & 1));
                    bf16x8 vf; vf[0] = lo[0]; vf[1] = lo[1]; vf[2] = lo[2]; vf[3] = lo[3]; vf[4] = hi[0]; vf[5] = hi[1]; vf[6] = hi[2]; vf[7] = hi[3];
                    O[db] = __builtin_amdgcn_mfma_f32_32x32x16_bf16(vf, pf[s], O[db], 0, 0, 0);
                }
            if (__all(carry < -104.f)) break;
        }
        bf16* op = WSP(bf16, WS_O) + (size_t)(m0 + r) * 1024 + h * HD + 4 * hf;
#pragma unroll
        for (int db = 0; db < 4; ++db)
#pragma unroll
            for (int i4 = 0; i4 < 4; ++i4) { u32x2 t; t.x = cvt_pk_bf16(O[db][4 * i4], O[db][4 * i4 + 1]); t.y = cvt_pk_bf16(O[db][4 * i4 + 2], O[db][4 * i4 + 3]);
                *(u32x2*)(op + 32 * db + 8 * i4) = t; }
    }
}
__device__ __forceinline__ void p2_conv(Frame& F) {
    const int nth = F.G * 512, total = MR * (CC / 8);
    int c = blockIdx.x * 512 + F.tid;
    if (c >= total) return;
    const int c8 = (c & 127) * 8;
    const f32x4 w0a = GLD(f32x4, F.conv_w + c8), w0b = GLD(f32x4, F.conv_w + c8 + 4), w1a = GLD(f32x4, F.conv_w + CC + c8), w1b = GLD(f32x4, F.conv_w + CC + c8 + 4),
                w2a = GLD(f32x4, F.conv_w + 2 * CC + c8), w2b = GLD(f32x4, F.conv_w + 2 * CC + c8 + 4);
    const float W0[8] = {w0a[0], w0a[1], w0a[2], w0a[3], w0b[0], w0b[1], w0b[2], w0b[3]}, W1[8] = {w1a[0], w1a[1], w1a[2], w1a[3], w1b[0], w1b[1], w1b[2], w1b[3]},
                W2[8] = {w2a[0], w2a[1], w2a[2], w2a[3], w2b[0], w2b[1], w2b[2], w2b[3]};
    u32x4 x0, x1, x2, bp;
#define P2C_LD(cc, A0, A1, A2, AB) do { const int m_ = (cc) >> 7, b_ = m_ / SEQ; const size_t row_ = (size_t)m_ + NMETA * (b_ + 1); const bf16* cu_ = WSP(bf16, WS_CU) + row_ * 1024 + c8; \
        A0 = *(const u32x4*)(cu_ - 2048); A1 = *(const u32x4*)(cu_ - 1024); A2 = *(const u32x4*)cu_; AB = *(const u32x4*)(WSP(bf16, WS_BP) + (size_t)m_ * 1024 + c8); } while (0)
    P2C_LD(c, x0, x1, x2, bp);
    for (; c < total; c += nth) {
        u32x4 n0 = x0, n1 = x1, n2 = x2, nb = bp;
        if (c + nth < total) P2C_LD(c + nth, n0, n1, n2, nb);
        const int m = c >> 7;
        const unsigned X0[4] = {x0.x, x0.y, x0.z, x0.w}, X1[4] = {x1.x, x1.y, x1.z, x1.w}, X2[4] = {x2.x, x2.y, x2.z, x2.w}, BP[4] = {bp.x, bp.y, bp.z, bp.w};
        unsigned ow[4];
#pragma unroll
        for (int q = 0; q < 4; ++q) {
            const float lo = bf_lo(BP[q]) * (W0[2 * q] * bf_lo(X0[q]) + W1[2 * q] * bf_lo(X1[q]) + W2[2 * q] * bf_lo(X2[q]));
            const float hi = bf_hi(BP[q]) * (W0[2 * q + 1] * bf_hi(X0[q]) + W1[2 * q + 1] * bf_hi(X1[q]) + W2[2 * q + 1] * bf_hi(X2[q]));
            ow[q] = cvt_pk_bf16(lo, hi); }
        u32x4 o; o.x = ow[0]; o.y = ow[1]; o.z = ow[2]; o.w = ow[3];
        *(u32x4*)(WSP(bf16, WS_YCIN) + (size_t)m * 1024 + c8) = o;
        x0 = n0; x1 = n1; x2 = n2; bp = nb;
    }
#undef P2C_LD
}

struct Sched3 {
    static constexpr bool AROW_LOADS = false;
    int G, c; unsigned char* ws; const LAS int* ut;
    __device__ __forceinline__ void coords(int i, int (&f)[8]) const { int pm = 0, pn = 0; f[0] = pg8::static_tile((i >> 1) * G + c, MR / 256, D / 256, pm, pn) ? 1 : 0; f[1] = pm; f[2] = pn; f[3] = i & 1; f[4] = 0; f[5] = 0; f[6] = 256; }
    __device__ __forceinline__ bool next(int i, Unit& u) const {
        if (!read_unit(ut, i, u)) return false;
        const int sub = u.kind; u.e = 0; u.nrow = 256; u.aux = 0;
        u.A = (const char*)(ws + (sub ? WS_O : WS_YCIN)) + (size_t)u.pm * 256 * 2048;
        u.B0 = (const char*)(ws + (sub ? WS_WATTN : WS_WCONV)) + (size_t)(256 * u.pn) * 1024 * 2; u.B1 = u.B0 + (size_t)128 * 1024 * 2;
        u.dst = (char*)(ws + (sub ? WS_GA : WS_GC)); u.ld = D;
        return true;
    }
    __device__ __forceinline__ unsigned arow(const Unit&, int r) const { return (unsigned)r * 2048u; }
    __device__ __forceinline__ unsigned hstepA() const { return 128u * 2048u; }
};
struct Epi3 {
    static constexpr bool PERM = true; static constexpr bool CHAIN = true;
    const bf16* gr; const bf16* gs; bf16* merged;
    __device__ __forceinline__ void mid(f32x4 (&acc)[2][2][4][2], const Unit& u, int wr, int wc, int fr, int fq) const {
        const int m0 = u.pm * 256 + wr * 64 + fr, col0 = u.pn * 256 + wc * 32 + 8 * fq;
#pragma unroll
        for (int ai = 0; ai < 2; ++ai)
#pragma unroll
            for (int m = 0; m < 4; ++m) { const size_t off = (size_t)(m0 + ai * 128 + m * 16) * D + col0;
#pragma unroll
                for (int bj = 0; bj < 2; ++bj) {
                    const u32x4 g = *(const u32x4*)(gr + off + bj * 128);
                    f32x4& v0 = acc[ai][bj][m][0]; f32x4& v1 = acc[ai][bj][m][1];
                    v0[0] *= bf_lo(g.x); v0[1] *= bf_hi(g.x); v0[2] *= bf_lo(g.y); v0[3] *= bf_hi(g.y);
                    v1[0] *= bf_lo(g.z); v1[1] *= bf_hi(g.z); v1[2] *= bf_lo(g.w); v1[3] *= bf_hi(g.w); } }
    }
    __device__ __forceinline__ void operator()(const f32x4 (&acc)[2][2][4][2], const Unit& u, int wr, int wc, int fr, int fq) const {
        const int m0 = u.pm * 256 + wr * 64 + fr, col0 = u.pn * 256 + wc * 32 + 8 * fq;
        u32x4 gv[8][2];
#define EPI3_LD(g) do { const size_t off_ = (size_t)(m0 + ((g) >> 2) * 128 + ((g) & 3) * 16) * D + col0; gv[g][0] = *(const u32x4*)(gs + off_); gv[g][1] = *(const u32x4*)(gs + off_ + 128); } while (0)
        EPI3_LD(0); EPI3_LD(1); EPI3_LD(2); EPI3_LD(3);
#pragma unroll
        for (int gi = 0; gi < 8; ++gi) { const int ai = gi >> 2, m = gi & 3; const size_t off = (size_t)(m0 + ai * 128 + m * 16) * D + col0;
#pragma unroll
                for (int bj = 0; bj < 2; ++bj) {
                    const u32x4 g = gv[gi][bj];
                    f32x4 v0 = acc[ai][bj][m][0], v1 = acc[ai][bj][m][1];
                    v0[0] *= bf_lo(g.x); v0[1] *= bf_hi(g.x); v0[2] *= bf_lo(g.y); v0[3] *= bf_hi(g.y);
                    v1[0] *= bf_lo(g.z); v1[1] *= bf_hi(g.z); v1[2] *= bf_lo(g.w); v1[3] *= bf_hi(g.w);
                    u32x4 w; w.x = cvt_pk_bf16(v0[0], v0[1]); w.y = cvt_pk_bf16(v0[2], v0[3]); w.z = cvt_pk_bf16(v1[0], v1[1]); w.w = cvt_pk_bf16(v1[2], v1[3]);
                    *(u32x4*)(merged + off + bj * 128) = w; }
            if (gi + 4 < 8) EPI3_LD(gi + 4); }
#undef EPI3_LD
    }
};

struct Sched4 {
    static constexpr bool AROW_LOADS = false;
    int G, c; unsigned char* ws; const LAS int* ut;
    __device__ __forceinline__ void coords(int i, int (&f)[8]) const { int pm = 0, pn = 0; f[0] = pg8::static_tile(i * G + c, MR / 256, D / 256, pm, pn) ? 1 : 0; f[1] = pm; f[2] = pn; f[3] = 0; f[4] = 0; f[5] = 0; f[6] = 256; }
    __device__ __forceinline__ bool next(int i, Unit& u) const {
        if (!read_unit(ut, i, u)) return false;
        u.kind = 0; u.e = 0; u.nrow = 256; u.aux = 0; u.A = (const char*)(ws + WS_MERGED) + (size_t)u.pm * 256 * D * 2;
        u.B0 = (const char*)(ws + WS_WO) + (size_t)(256 * u.pn) * D * 2; u.B1 = u.B0 + (size_t)128 * D * 2; u.dst = nullptr; u.ld = D;
        return true;
    }
    __device__ __forceinline__ unsigned arow(const Unit&, int r) const { return (unsigned)r * (unsigned)(D * 2); }
    __device__ __forceinline__ unsigned hstepA() const { return 128u * D * 2u; }
};
struct Epi4 {
    static constexpr bool PERM = true; static constexpr bool CHAIN = false;
    const bf16* xb; bf16* hres2;
    __device__ __forceinline__ void operator()(const f32x4 (&acc)[2][2][4][2], const Unit& u, int wr, int wc, int fr, int fq) const {
        const int row0 = u.pm * 256 + wr * 64 + fr, col0 = u.pn * 256 + wc * 32 + 8 * fq;
        u32x4 xv[8][2];
#define EPI4_LD(g) do { const size_t off_ = (size_t)(row0 + ((g) >> 2) * 128 + ((g) & 3) * 16) * D + col0; xv[g][0] = GLD(u32x4, xb + off_); xv[g][1] = GLD(u32x4, xb + off_ + 128); } while (0)
        EPI4_LD(0); EPI4_LD(1); EPI4_LD(2); EPI4_LD(3);
#pragma unroll
        for (int g = 0; g < 8; ++g) { const int ai = g >> 2, m = g & 3; const size_t off = (size_t)(row0 + ai * 128 + m * 16) * D + col0;
#pragma unroll
            for (int bj = 0; bj < 2; ++bj) { const u32x4 xw = xv[g][bj];
                const f32x4 v0 = (f32x4){bf_lo(xw.x), bf_hi(xw.x), bf_lo(xw.y), bf_hi(xw.y)} + acc[ai][bj][m][0], v1 = (f32x4){bf_lo(xw.z), bf_hi(xw.z), bf_lo(xw.w), bf_hi(xw.w)} + acc[ai][bj][m][1];
                u32x4 w; w.x = cvt_pk_bf16(v0[0], v0[1]); w.y = cvt_pk_bf16(v0[2], v0[3]); w.z = cvt_pk_bf16(v1[0], v1[1]); w.w = cvt_pk_bf16(v1[2], v1[3]);
                *(u32x4*)(hres2 + off + bj * 128) = w; }
            if (g + 4 < 8) EPI4_LD(g + 4); }
#undef EPI4_LD
    }
};

__device__ __forceinline__ void p5_route(Frame& F) {
    LAS float* part = (LAS float*)F.lds;
    LAS float* ssqp = part + 2 * 64 * 33;
    LAS int* lcnt = (LAS int*)(ssqp + 128);
    LAS int* gbase = lcnt + 32;
    const int lane = F.lane, fr = lane & 15, fq = lane >> 4, tg = F.wave & 3, kh = F.wave >> 2;
    const bf16* hres2 = WSP(bf16, WS_HRES2);
    for (int tb = blockIdx.x; tb < MR / 64; tb += F.G) {
        if (F.tid < 32) lcnt[F.tid] = 0;
        const int tok = tb * 64 + tg * 16 + fr;
        const bf16* xr = hres2 + (size_t)tok * D + kh * 1024 + 8 * fq;
        const float* gr = F.g_ffn + kh * 1024 + 8 * fq;
        unsigned char* hgw = WSP(unsigned char, WS_HG) + (size_t)tok * D + kh * 1024 + 8 * fq;
        const u32x4* wf = WSP(u32x4, WS_WRF) + (size_t)(kh * 32) * 128 + lane;
        f32x4 acc0 = {0.f, 0.f, 0.f, 0.f}, acc1 = {0.f, 0.f, 0.f, 0.f}; float ssq = 0.f;
#pragma unroll 4
        for (int s = 0; s < 32; ++s) {
            const u32x4 xw = *(const u32x4*)(xr + 32 * s);
            f32x4 x0 = {bf_lo(xw.x), bf_hi(xw.x), bf_lo(xw.y), bf_hi(xw.y)}, x1 = {bf_lo(xw.z), bf_hi(xw.z), bf_lo(xw.w), bf_hi(xw.w)};
            const f32x4 g0 = GLD(f32x4, gr + 32 * s), g1 = GLD(f32x4, gr + 32 * s + 4);
            ssq += (x0[0] * x0[0] + x0[1] * x0[1]) + (x0[2] * x0[2] + x0[3] * x0[3]) + (x1[0] * x1[0] + x1[1] * x1[1]) + (x1[2] * x1[2] + x1[3] * x1[3]);
            x0 *= g0; x1 *= g1;
            u32x4 t; t.x = cvt_pk_bf16(x0[0], x0[1]); t.y = cvt_pk_bf16(x0[2], x0[3]); t.z = cvt_pk_bf16(x1[0], x1[1]); t.w = cvt_pk_bf16(x1[2], x1[3]);
            { u32x2 h8; h8.x = cvt4_fp8(x0[0], x0[1], x0[2], x0[3]); h8.y = cvt4_fp8(x1[0], x1[1], x1[2], x1[3]); *(u32x2*)(hgw + 32 * s) = h8; }
            const bf16x8 bfr = __builtin_bit_cast(bf16x8, t);
            const bf16x8 a0 = __builtin_bit_cast(bf16x8, wf[(size_t)(2 * s) * 64]), a1 = __builtin_bit_cast(bf16x8, wf[(size_t)(2 * s + 1) * 64]);
            acc0 = __builtin_amdgcn_mfma_f32_16x16x32_bf16(a0, bfr, acc0, 0, 0, 0);
            acc1 = __builtin_amdgcn_mfma_f32_16x16x32_bf16(a1, bfr, acc1, 0, 0, 0);
        }
        ssq += __shfl_xor(ssq, 16); ssq += __shfl_xor(ssq, 32);
        { LAS float* pp = part + (kh * 64 + tg * 16 + fr) * 33 + 4 * fq;
#pragma unroll
          for (int j = 0; j < 4; ++j) { pp[j] = acc0[j]; pp[16 + j] = acc1[j]; }
          if (fq == 0) ssqp[kh * 64 + tg * 16 + fr] = ssq; }
        __syncthreads();
        if (F.wave == 0) {
            const int t = tb * 64 + lane;
            const float rstd = rsqrtf((ssqp[lane] + ssqp[64 + lane]) * (1.f / D) + EPS);
            float lg[NE];
#pragma unroll
            for (int e = 0; e < NE; ++e) lg[e] = rstd * (part[lane * 33 + e] + part[(64 + lane) * 33 + e]) + GLD(float, F.b_router + e);
            int ti[TOPK]; float tv[TOPK]; unsigned used = 0u;
#pragma unroll
            for (int k = 0; k < TOPK; ++k) { int bi = -1; float bv = 0.f;
#pragma unroll
                for (int e = 0; e < NE; ++e) { const bool take = !((used >> e) & 1u) && (bi < 0 || lg[e] > bv); bi = take ? e : bi; bv = take ? lg[e] : bv; }
                used |= 1u << bi; ti[k] = bi; tv[k] = bv; }
            float ex[TOPK], den = 0.f;
#pragma unroll
            for (int k = 0; k < TOPK; ++k) { ex[k] = __expf(tv[k] - tv[0]); den += ex[k]; }
            const float rden = 1.f / den;
            int lrk[TOPK];
#pragma unroll
            for (int k = 0; k < TOPK; ++k) lrk[k] = __hip_atomic_fetch_add(&lcnt[ti[k]], 1, __ATOMIC_RELAXED, __HIP_MEMORY_SCOPE_WORKGROUP);
            LDS_WAIT();
            if (lane < 32) { const int c = lcnt[lane]; int gb = 0; if (c) gb = (int)atomicAdd(F.ctl + CW_CNT + 64 * lane, (unsigned)c); gbase[lane] = gb; }
            LDS_WAIT();
#pragma unroll
            for (int k = 0; k < TOPK; ++k) { const int e = ti[k], sid = e * SLOT_CAP + gbase[e] + lrk[k];
                WSP(int, WS_TOKOF)[sid] = t; WSP(float, WS_RSTDOF)[sid] = rstd; WSP(float, WS_CWOF)[sid] = ex[k] * rden; WSP(int, WS_TOKSLOT)[t * TOPK + k] = sid; }
        }
        __syncthreads();
    }
}

__device__ __forceinline__ void moe_tables(Frame& F) {
    LAS int* tb = (LAS int*)(F.lds + LDS_TBL);
    if (F.wave == 0) {
        const int c = F.lane < NE ? (int)__hip_atomic_load(F.ctl + CW_CNT + 64 * (F.lane & 31), __ATOMIC_RELAXED, __HIP_MEMORY_SCOPE_AGENT) : 0;
        int t = (c + 255) >> 8, inc = t;
#pragma unroll
        for (int o = 1; o < 32; o <<= 1) { const int v = __shfl_up(inc, o); if ((F.lane & 31) >= o) inc += v; }
        if (F.lane < NE) { tb[F.lane] = c; tb[32 + F.lane + 1] = inc; }
        if (F.lane == 0) tb[32] = 0;
    }
    __syncthreads();
}
constexpr int ROT_UNITS = 24;
__device__ __forceinline__ void build_rowoffs(const LAS int* ut, LAS unsigned* rot, const unsigned char* ws, int wave) {
    int lt = (int)__builtin_amdgcn_mbcnt_hi(~0u, __builtin_amdgcn_mbcnt_lo(~0u, 0u)); asm volatile("" : "+v"(lt));
    const int tid = wave * 64 + lt;
    for (int idx = tid; idx < ROT_UNITS * 256; idx += 512) {
        const int i = idx >> 8, r = idx & 255; const LAS int* p = ut + 8 * i;
        unsigned off = 0u;
        if (p[0] != 0 && r < p[6]) off = (unsigned)((const GAS int*)(ws + WS_TOKOF))[p[4] * SLOT_CAP + p[5] * 256 + r] * (unsigned)D;
        rot[idx] = off;
    }
    __syncthreads();
}
template <bool SECOND> struct SchedMoe {
    static constexpr bool AROW_LOADS = !SECOND;
    static constexpr int second = SECOND ? 1 : 0;
    int G, c, nN; unsigned char* ws; const LAS int* tb; const LAS int* ut;
    __device__ __forceinline__ void coords(int i, int (&f)[8]) const {
        const int Mt = tb[32 + NE]; int gm = 0, pn = 0; f[0] = pg8::static_tile(i * G + c, Mt, nN, gm, pn, 8) ? 1 : 0;
        int e = 0;
        for (int j = 0; j < NE - 1; ++j) e += (tb[32 + j + 1] <= gm) ? 1 : 0;
        const int mt = gm - tb[32 + e], cnt = tb[e];
        f[1] = gm; f[2] = pn; f[3] = 0; f[4] = e; f[5] = mt; f[6] = (cnt - mt * 256) < 256 ? (cnt - mt * 256) : 256;
    }
    __device__ __forceinline__ bool next(int i, Unit& u) const {
        if (!read_unit(ut, i, u)) return false;
        const int gm = u.pm, pn = u.pn, e = u.e; u.ld = i; u.dst = nullptr;
        if (!second) { u.A = (const char*)(ws + WS_HG); u.B0 = (const char*)(ws + WS_WG) + ((size_t)e * DFF + 128 * pn) * D; u.B1 = (const char*)(ws + WS_WU) + ((size_t)e * DFF + 128 * pn) * D; }
        else { u.A = (const char*)(ws + WS_ACT) + (size_t)gm * 256 * DFF; u.B0 = (const char*)(ws + WS_WD) + ((size_t)e * D + 256 * pn) * DFF; u.B1 = u.B0 + (size_t)128 * DFF; }
        return true;
    }
    __device__ __forceinline__ unsigned arow(const Unit& u, int r) const {
        if (second) return (unsigned)r * (unsigned)DFF;
        const LAS unsigned* rot = (const LAS unsigned*)((const LAS unsigned char*)tb + (LDS_CVRING - LDS_TBL));
        return rot[u.ld * 256 + r];
    }
    __device__ __forceinline__ unsigned hstepA() const { return 128u * DFF; }
};
struct Epi6 {
    static constexpr bool PERM = true; static constexpr bool CHAIN = false; static constexpr bool WIDE = true; static constexpr bool RELAX = true;
    const float* b_gate; const float* b_up; const float* rstd_of; unsigned char* act;
    __device__ __forceinline__ void operator()(const f32x4 (&acc)[2][2][4][2], const Unit& u, int wr, int wc, int fr, int fq) const {
        const int colw = u.pn * 128 + wc * 32 + 16 * (fq & 1), col0 = colw + 8 * (fq >> 1), hi = fq >> 1;
        const f32x4 bg0 = GLD(f32x4, b_gate + u.e * DFF + col0), bg1 = GLD(f32x4, b_gate + u.e * DFF + col0 + 4), bu0 = GLD(f32x4, b_up + u.e * DFF + col0), bu1 = GLD(f32x4, b_up + u.e * DFF + col0 + 4);
        float rsv[8];
#pragma unroll
        for (int i = 0; i < 8; ++i) rsv[i] = rstd_of[u.e * SLOT_CAP + u.aux * 256 + (i >> 2) * 128 + wr * 64 + (i & 3) * 16 + fr];
        asm volatile("s_waitcnt vmcnt(0)" ::: "memory");
#pragma unroll
        for (int ai = 0; ai < 2; ++ai)
#pragma unroll
            for (int mp = 0; mp < 2; ++mp) { const int rl0 = ai * 128 + wr * 64 + mp * 32 + fr;
                u32x2 w[2];
#pragma unroll
                for (int q = 0; q < 2; ++q) { const int m = 2 * mp + q;
                    const float rs = rsv[ai * 4 + m];
                    f32x4 o[2];
#pragma unroll
                    for (int n = 0; n < 2; ++n) {
                        const f32x4 ag = acc[ai][0][m][n], au = acc[ai][1][m][n], bg = n ? bg1 : bg0, bu = n ? bu1 : bu0;
#pragma unroll
                        for (int jp = 0; jp < 2; ++jp) {
                            const f32x2_t rs2 = {rs, rs};
                            f32x2_t g = __builtin_elementwise_fma((f32x2_t){ag[2 * jp], ag[2 * jp + 1]}, rs2, (f32x2_t){bg[2 * jp], bg[2 * jp + 1]});
                            f32x2_t up = __builtin_elementwise_fma((f32x2_t){au[2 * jp], au[2 * jp + 1]}, rs2, (f32x2_t){bu[2 * jp], bu[2 * jp + 1]});
                            const f32x2_t gt = {fminf(g[0], 7.f), fminf(g[1], 7.f)}, uu = {__builtin_amdgcn_fmed3f(up[0], -7.f, 7.f), __builtin_amdgcn_fmed3f(up[1], -7.f, 7.f)};
                            const f32x2_t t = gt * (f32x2_t){-2.455466959592976f, -2.455466959592976f};
                            const f32x2_t den = (f32x2_t){__builtin_amdgcn_exp2f(t[0]), __builtin_amdgcn_exp2f(t[1])} + (f32x2_t){1.f, 1.f};
                            const f32x2_t num = __builtin_elementwise_fma(uu, gt, gt);
                            const f32x2_t r = num * (f32x2_t){__builtin_amdgcn_rcpf(den[0]), __builtin_amdgcn_rcpf(den[1])};
                            o[n][2 * jp] = r[0]; o[n][2 * jp + 1] = r[1]; } }
                    w[q].x = cvt4_fp8(o[0][0], o[0][1], o[0][2], o[0][3]); w[q].y = cvt4_fp8(o[1][0], o[1][1], o[1][2], o[1][3]); }
                const auto rx = __builtin_amdgcn_permlane32_swap(w[0].x, w[1].x, false, false), ry = __builtin_amdgcn_permlane32_swap(w[0].y, w[1].y, false, false);
                const int rl = rl0 + 16 * hi;
                if (rl < u.nrow) { u32x4 v; v.x = rx[0]; v.y = ry[0]; v.z = rx[1]; v.w = ry[1];
                    *(u32x4*)(act + (size_t)(u.pm * 256 + rl) * DFF + colw) = v; } }
    }
};
struct Epi7 {
    static constexpr bool PERM = true; static constexpr bool CHAIN = false; static constexpr bool WIDE = true; static constexpr bool RELAX = true;
    const float* b_down; const float* cw_of; unsigned char* Y;
    __device__ __forceinline__ void operator()(const f32x4 (&acc)[2][2][4][2], const Unit& u, int wr, int wc, int fr, int fq) const {
        const int colw = u.pn * 256 + wc * 32 + 16 * (fq & 1), col0 = colw + 8 * (fq >> 1), hi = fq >> 1;
        f32x4 bv[2][2];
#pragma unroll
        for (int bj = 0; bj < 2; ++bj)
#pragma unroll
            for (int n = 0; n < 2; ++n) bv[bj][n] = GLD(f32x4, b_down + u.e * D + col0 + bj * 128 + 4 * n);
        float cwv[8];
#pragma unroll
        for (int i = 0; i < 8; ++i) cwv[i] = cw_of[u.e * SLOT_CAP + u.aux * 256 + (i >> 2) * 128 + wr * 64 + (i & 3) * 16 + fr];
        asm volatile("s_waitcnt vmcnt(0)" ::: "memory");
#pragma unroll
        for (int ai = 0; ai < 2; ++ai)
#pragma unroll
            for (int mp = 0; mp < 2; ++mp) { const int rl0 = ai * 128 + wr * 64 + mp * 32 + fr, rl = rl0 + 16 * hi;
                const float cw0 = cwv[ai * 4 + 2 * mp], cw1 = cwv[ai * 4 + 2 * mp + 1];
#pragma unroll
                for (int bj = 0; bj < 2; ++bj) { u32x2 w[2];
#pragma unroll
                    for (int q = 0; q < 2; ++q) { const float cw = q ? cw1 : cw0; const f32x4 v0 = (acc[ai][bj][2 * mp + q][0] + bv[bj][0]) * cw, v1 = (acc[ai][bj][2 * mp + q][1] + bv[bj][1]) * cw;
                        w[q].x = cvt4_fp8(v0[0], v0[1], v0[2], v0[3]); w[q].y = cvt4_fp8(v1[0], v1[1], v1[2], v1[3]); }
                    const auto rx = __builtin_amdgcn_permlane32_swap(w[0].x, w[1].x, false, false), ry = __builtin_amdgcn_permlane32_swap(w[0].y, w[1].y, false, false);
                    if (rl < u.nrow) { u32x4 v; v.x = rx[0]; v.y = ry[0]; v.z = rx[1]; v.w = ry[1];
                        *(u32x4*)(Y + (size_t)(u.pm * 256 + rl) * D + colw + bj * 128) = v; } } }
    }
};

struct EpiNull { static constexpr bool PERM = true; static constexpr bool CHAIN = false;
    __device__ __forceinline__ void operator()(const f32x4 (&acc)[2][2][4][2], const Unit& u, int, int, int, int) const {
        float s = 0.f;
#pragma unroll
        for (int a = 0; a < 2; ++a)
#pragma unroll
            for (int b = 0; b < 2; ++b)
#pragma unroll
                for (int m = 0; m < 4; ++m)
#pragma unroll
                    for (int n = 0; n < 2; ++n) s += acc[a][b][m][n][0] + acc[a][b][m][n][3];
        if (s == 1.2345e30f) ((float*)u.A)[0] = s; } };
__device__ __forceinline__ void p8_final(Frame& F) {
    const LAS int* tb = (const LAS int*)(F.lds + LDS_TBL);
    const int gw = F.vcu * 8 + F.wave, NGW = F.G * 8, lane = F.lane;
    const bf16* hres2 = WSP(bf16, WS_HRES2); const unsigned char* Y = WSP(unsigned char, WS_Y);
    for (int t = gw; t < MR; t += NGW) {
        const int* ts = WSP(int, WS_TOKSLOT) + t * TOPK;
        const unsigned char* yr[TOPK];
#pragma unroll
        for (int k = 0; k < TOPK; ++k) { const int sid = __builtin_amdgcn_readfirstlane(ts[k]); const int e = sid >> 14, r = sid & (SLOT_CAP - 1); yr[k] = Y + (size_t)(tb[32 + e] * 256 + r) * D + 16 * lane; }
        const bf16* xr = hres2 + (size_t)t * D + 16 * lane;
        float v[2][16]; float s = 0.f;
#pragma unroll
        for (int j = 0; j < 2; ++j) {
            const u32x4 xa = *(const u32x4*)(xr + 1024 * j), xb = *(const u32x4*)(xr + 1024 * j + 8);
            const unsigned xw[8] = {xa.x, xa.y, xa.z, xa.w, xb.x, xb.y, xb.z, xb.w};
#pragma unroll
            for (int q = 0; q < 8; ++q) { v[j][2 * q] = bf_lo(xw[q]); v[j][2 * q + 1] = bf_hi(xw[q]); }
#pragma unroll
            for (int k = 0; k < TOPK; ++k) { const u32x4 y = *(const u32x4*)(yr[k] + 1024 * j); const unsigned yw[4] = {y.x, y.y, y.z, y.w};
#pragma unroll
                for (int q = 0; q < 4; ++q) { const f32x2_t lo = __builtin_amdgcn_cvt_pk_f32_fp8((int)yw[q], false), hi = __builtin_amdgcn_cvt_pk_f32_fp8((int)yw[q], true);
                    v[j][4 * q] += lo[0]; v[j][4 * q + 1] += lo[1]; v[j][4 * q + 2] += hi[0]; v[j][4 * q + 3] += hi[1]; } }
#pragma unroll
            for (int q = 0; q < 16; ++q) s += v[j][q] * v[j][q];
        }
        const float rstd = rsqrtf(wave_sum(s) * (1.f / D) + EPS);
#pragma unroll
        for (int j = 0; j < 2; ++j) { f32x4* op = (f32x4*)(F.out + (size_t)t * D + 16 * lane + 1024 * j); const GAS f32x4* gp = (const GAS f32x4*)(F.g_final + 16 * lane + 1024 * j);
#pragma unroll
            for (int q = 0; q < 4; ++q) { const f32x4 g = gp[q]; f32x4 o; o[0] = v[j][4 * q] * rstd * g[0]; o[1] = v[j][4 * q + 1] * rstd * g[1]; o[2] = v[j][4 * q + 2] * rstd * g[2]; o[3] = v[j][4 * q + 3] * rstd * g[3]; op[q] = o; } }
    }
}

#ifndef DUP_PHASE
#define DUP_PHASE -1
#endif
#ifdef CV_DUMMY
constexpr size_t CV_DST = WS_Y;
#else
constexpr size_t CV_DST = WS_WG;
#endif
__global__ void __launch_bounds__(512, 2) mk_fwd(Args args) {
    extern __shared__ __attribute__((aligned(16))) unsigned char lds[];
    Frame F;
    F.lds = (LAS unsigned char*)lds;
    F.tid = threadIdx.x; F.lane = F.tid & 63; F.wave = __builtin_amdgcn_readfirstlane(F.tid >> 6);
    F.G = gridDim.x; { const int bx = blockIdx.x; F.vcu = (F.G % 8 == 0) ? (bx % 8) * (F.G / 8) + bx / 8 : bx; }
    F.x = args.in[0]; F.meta = args.in[1]; F.g_mix = args.in[2]; F.w_in = args.in[3]; F.conv_w = args.in[4]; F.w_conv_out = args.in[5]; F.w_attn_out = args.in[6]; F.w_o = args.in[7];
    F.g_ffn = args.in[8]; F.w_router = args.in[9]; F.b_router = args.in[10]; F.w_gate = args.in[11]; F.b_gate = args.in[12]; F.w_up = args.in[13]; F.b_up = args.in[14];
    F.w_down = args.in[15]; F.b_down = args.in[16]; F.g_final = args.in[17];
    F.out = args.out; F.ws = args.ws; F.ctl = (unsigned*)(args.ws + WS_CTL);
    for (int u = F.tid; u < (LDS_BYTES - RING_BYTES) / 4; u += 512) ((LAS unsigned*)(F.lds + RING_BYTES))[u] = 0u;
    __syncthreads();
    const int lo = args.ph_lo, hi = args.ph_hi;
    const bool multi = (hi - lo) > 1;
    XcdBarrier bar; bar.bar = F.ctl + CW_BAR; bar.x = 0; bar.st = nullptr;
    if (multi) bar = xcd_barrier_post(F.ctl + CW_BAR, (volatile LAS unsigned*)(F.lds + LDS_MISC));
#ifdef ONLY_PHASE
#define IN(k) ((k) == ONLY_PHASE)
#else
#define IN(k) (lo <= (k) && (k) < hi)
#endif
#define ARG(i) ([&]() { const float* p_ = args.in[i]; asm volatile("" : "+s"(p_)); return p_; }())
#define SEAM(k) do { if (IN(k) && IN((k) + 1)) xcd_barrier(bar); } while (0)
#ifdef CV_DUMMY
    const bool ride = false; const bool cvon = true;
#else
    const bool ride = (F.G == 256); const bool cvon = ride;
#endif
    if (IN(0)) { p0_prologue(F, ride); if (DUP_PHASE == 0) p0_prologue(F, ride); SEAM(0); }
    if (IN(1)) {
        F.w_gate = ARG(11); F.w_up = ARG(13); F.w_down = ARG(15);
        p1_meta(F);
        LAS int* ut = (LAS int*)(F.lds + LDS_UNITS);
        Sched1 S{F.G, (int)blockIdx.x, F.ws, ut}; Epi1 E; build_units(S, ut);
#define CVW(NB_, lo_, hi_) int cl_ = (int)__builtin_amdgcn_mbcnt_hi(~0u, __builtin_amdgcn_mbcnt_lo(~0u, 0u)); asm volatile("" : "+v"(cl_));     \
        ConvW<NB_> cvw{F.w_gate, F.w_up, F.w_down, F.ws + CV_DST, F.lds + LDS_CVRING + F.wave * 3072, F.vcu * 8 + F.wave, cvon ? (lo_) : 0, cvon ? (lo_) : 0, cvon ? (hi_) : 0, \
                    (unsigned)((4 * ((cl_ >> 2) & 3) + (cl_ >> 4)) * 8192 + (cl_ & 3) * 16), (unsigned)((cl_ >> 4) * 64 + (cl_ & 15) * 4), (unsigned)((cl_ & 15) * 2048 + (cl_ >> 4) * 16), {0.f, 0.f, 0.f, 0.f}, {}}
        { CVW(8, 0, 384); pg8::gemm_phase<Epi1, Sched1, true, true, false, ConvW<8>>(F.lds, D, S, E, cvw); }
        { Sched1g Sg{F.G, (int)blockIdx.x, F.ws, ut}; build_units(Sg, ut);
          CVW(8, 384, 512); Epi1g Eg; pg8::gemm_phase<Epi1g, Sched1g, true, true, true, ConvW<8>>(F.lds, D, Sg, Eg, cvw); }
        SEAM(1);
    }
    if (IN(2)) { F.conv_w = ARG(4); p2_attn(F); p2_conv(F); if (DUP_PHASE == 2) { p2_attn(F); p2_conv(F); } SEAM(2); }
    if (IN(3)) {
        F.w_gate = ARG(11); F.w_up = ARG(13); F.w_down = ARG(15);
        LAS int* ut = (LAS int*)(F.lds + LDS_UNITS);
        Sched3 S{F.G, (int)blockIdx.x, F.ws, ut}; Epi3 E{WSP(bf16, WS_GC), WSP(bf16, WS_GA), WSP(bf16, WS_MERGED)}; build_units(S, ut);
        { CVW(8, 512, 640); pg8::gemm_phase<Epi3, Sched3, true, true, false, ConvW<8>>(F.lds, 1024, S, E, cvw); }
        SEAM(3);
    }
    if (IN(4)) {
        F.w_gate = ARG(11); F.w_up = ARG(13); F.w_down = ARG(15); F.x = ARG(0);
        LAS int* ut = (LAS int*)(F.lds + LDS_UNITS);
        Sched4 S{F.G, (int)blockIdx.x, F.ws, ut}; Epi4 E{WSP(bf16, WS_XB), WSP(bf16, WS_HRES2)}; build_units(S, ut);
        { CVW(8, 640, 768); pg8::gemm_phase<Epi4, Sched4, true, true, false, ConvW<8>>(F.lds, D, S, E, cvw); }
        if (DUP_PHASE == 4) pg8::gemm_phase<Epi4, Sched4, true, true>(F.lds, D, S, E);
        if (DUP_PHASE == 14) { EpiNull EN; pg8::gemm_phase<EpiNull, Sched4, true, true>(F.lds, D, S, EN); }
        SEAM(4);
    }
    if (IN(5)) { F.g_ffn = ARG(8); F.b_router = ARG(10); p5_route(F); SEAM(5); }
    if (IN(6)) {
        F.b_gate = ARG(12); F.b_up = ARG(14);
        moe_tables(F);
        LAS int* ut = (LAS int*)(F.lds + LDS_UNITS);
        SchedMoe<false> S{F.G, (int)blockIdx.x, DFF / 128, F.ws, (const LAS int*)(F.lds + LDS_TBL), ut}; build_units(S, ut);
        build_rowoffs(ut, (LAS unsigned*)(F.lds + LDS_CVRING), F.ws, F.wave);
        Epi6 E{F.b_gate, F.b_up, WSP(float, WS_RSTDOF), WSP(unsigned char, WS_ACT)};
        pg8::gemm_phase<Epi6, SchedMoe<false>, true, true, true>(F.lds, D, S, E);
        if (DUP_PHASE == 6) pg8::gemm_phase<Epi6, SchedMoe<false>, true, true, true>(F.lds, D, S, E);
        if (DUP_PHASE == 16) { EpiNull EN; pg8::gemm_phase<EpiNull, SchedMoe<false>, true, true, true>(F.lds, D, S, EN); }
                SEAM(6);
    }
    if (IN(7)) {
        F.b_down = ARG(16);
        moe_tables(F);
        LAS int* ut = (LAS int*)(F.lds + LDS_UNITS);
        SchedMoe<true> S{F.G, (int)blockIdx.x, D / 256, F.ws, (const LAS int*)(F.lds + LDS_TBL), ut}; build_units(S, ut);
        Epi7 E{F.b_down, WSP(float, WS_CWOF), WSP(unsigned char, WS_Y)};
        pg8::gemm_phase<Epi7, SchedMoe<true>, true, true, true>(F.lds, DFF, S, E);
        if (DUP_PHASE == 7) pg8::gemm_phase<Epi7, SchedMoe<true>, true, true, true>(F.lds, DFF, S, E);
        if (DUP_PHASE == 17) { EpiNull EN; pg8::gemm_phase<EpiNull, SchedMoe<true>, true, true, true>(F.lds, DFF, S, EN); }
        SEAM(7);
    }
    if (IN(8)) { F.g_final = ARG(17); moe_tables(F); p8_final(F); if (DUP_PHASE == 8) p8_final(F); }
#undef IN
#undef SEAM
}

#ifndef DEBUG_HYBRID
#ifndef MK_ONE_LAUNCH
#define MK_ONE_LAUNCH 1
#endif
extern "C" void kernel_launch(void* const* d_in, const int* in_sizes, int n_in, void* d_out, int out_size, void* d_ws, size_t ws_size, hipStream_t stream) {
    static int grid = 0;
    if (grid == 0) {
        if (n_in != 18 || out_size != MR * D || ws_size < WS_END) { fprintf(stderr, "kernel_launch: unexpected problem (n_in %d, out %d, ws %zu, need %zu)\n", n_in, out_size, ws_size, (size_t)WS_END); grid = -1; return; }
        int dev = 0, cus = 0, per_cu = 0;
        if (hipGetDevice(&dev) != hipSuccess || hipDeviceGetAttribute(&cus, hipDeviceAttributeMultiprocessorCount, dev) != hipSuccess) { grid = -1; return; }
        if (hipFuncSetAttribute((const void*)mk_fwd, hipFuncAttributeMaxDynamicSharedMemorySize, LDS_BYTES) != hipSuccess) { fprintf(stderr, "kernel_launch: hipFuncSetAttribute failed\n"); grid = -1; return; }
        if (hipOccupancyMaxActiveBlocksPerMultiprocessor(&per_cu, (const void*)mk_fwd, 512, LDS_BYTES) != hipSuccess || per_cu < 1) { fprintf(stderr, "kernel_launch: occupancy query says %d\n", per_cu); }
        (void)hipGetLastError();
        grid = cus;
    }
    if (grid < 0) return;
    if (hipMemsetAsync((char*)d_ws + WS_CTL, 0, CTL_ZERO_BYTES, stream) != hipSuccess) return;
    Args a{};
    for (int i = 0; i < 18; ++i) a.in[i] = (const float*)d_in[i];
    a.out = (float*)d_out; a.ws = (unsigned char*)d_ws;
#if MK_ONE_LAUNCH
    a.ph_lo = 0; a.ph_hi = NPH;
    hipLaunchKernelGGL(mk_fwd, dim3(grid), dim3(512), LDS_BYTES, stream, a);
#else
    for (int p = 0; p < NPH; ++p) { a.ph_lo = p; a.ph_hi = p + 1; hipLaunchKernelGGL(mk_fwd, dim3(grid), dim3(512), LDS_BYTES, stream, a); }
#endif
}
#endif
```
